# Optimizing an MI355X kernel written in HIP

```python
import math
import jax, jax.numpy as jnp
from jax import lax
import numpy as np

D_MODEL = 1024
BATCH = 16
SEQ = 256
DEPTH = 1
DEC_BATCH = 8
DEC_SEQ = 1024
PAST_LEN = 256

GRID_W = 64
N_HEADS = 8
HEAD_DIM = 64
V_DIM = 2 * HEAD_DIM
ATTN_WIDTH = N_HEADS * V_DIM
D_HYENA = D_MODEL // 2
HYENA_ORDER = 2
FILTER_EMB = 33
FILTER_HIDDEN = 64
D_FF = 4 * D_MODEL
ROPE_THETA = 10000.0
EPS = 1e-6
Q_BLOCK = 128
DECAY_TARGET = 1e-2
FAST_DECAY_PCT = 0.3
SLOW_DECAY_PCT = 1.5

Q_COLS = N_HEADS * 2 * HEAD_DIM
K_COLS = N_HEADS * 2 * HEAD_DIM
V_COLS = N_HEADS * V_DIM
HY_COLS = 3 * D_HYENA
GATE_COLS = 2 * D_MODEL
IN_COLS = Q_COLS + K_COLS + V_COLS + HY_COLS + GATE_COLS
SPLITS = (Q_COLS, Q_COLS + K_COLS, Q_COLS + K_COLS + V_COLS, Q_COLS + K_COLS + V_COLS + HY_COLS)

kernel_name = "diff_hyena_prefix_dit_step"


def _rmsnorm(x, g):
    xf = x.astype(jnp.float32)
    y = xf * lax.rsqrt(jnp.mean(xf * xf, axis=-1, keepdims=True) + EPS)
    return (y * g.astype(jnp.float32)).astype(x.dtype)


def _rope_half(x, pos):
    n = x.shape[-1] // 2
    inv = ROPE_THETA ** (-jnp.arange(n, dtype=jnp.float32) / n)
    ang = pos.astype(jnp.float32)[:, None] * inv[None, :]
    cos = jnp.cos(ang)[None, :, None, None, :]
    sin = jnp.sin(ang)[None, :, None, None, :]
    x1 = x[..., :n].astype(jnp.float32)
    x2 = x[..., n:].astype(jnp.float32)
    return jnp.concatenate([x1 * cos - x2 * sin, x2 * cos + x1 * sin], axis=-1).astype(x.dtype)


def _rope2d(x, n_tokens):
    rows = n_tokens // GRID_W
    row = jnp.repeat(jnp.arange(rows), GRID_W)
    col = jnp.tile(jnp.arange(GRID_W), rows)
    half = HEAD_DIM // 2
    return jnp.concatenate([_rope_half(x[..., :half], row), _rope_half(x[..., half:], col)], axis=-1)


def _diff_attention(q, k, v, lam, lam_init, subln_g):
    B, Lq = q.shape[0], q.shape[1]
    nblk = Lq // Q_BLOCK
    qb = jnp.moveaxis(q.reshape(B, nblk, Q_BLOCK, N_HEADS, 2, HEAD_DIM), 1, 0)

    def one_block(qi):
        s = jnp.einsum('bqhmd,bkhmd->bhmqk', qi, k, preferred_element_type=jnp.float32) * (HEAD_DIM ** -0.5)
        p = jax.nn.softmax(s, axis=-1)
        a = p[:, :, 0] - lam * p[:, :, 1]
        return jnp.einsum('bhqk,bkhe->bqhe', a.astype(v.dtype), v)

    o = lax.map(one_block, qb)
    o = jnp.moveaxis(o, 0, 1).reshape(B, Lq, N_HEADS, V_DIM)
    o = _rmsnorm(o, subln_g) * (1.0 - lam_init)
    return o.reshape(B, Lq, ATTN_WIDTH)


def _short_conv(x, w, b):
    xp = jnp.pad(x, ((0, 0), (1, 1), (0, 0)))
    return xp[:, :-2] * w[0] + xp[:, 1:-1] * w[1] + xp[:, 2:] * w[2] + b


def _hyena_filters(L, w1, b1, w2, b2, w3, freq):
    bands = (FILTER_EMB - 1) // 2
    t = jnp.linspace(0.0, 1.0, L, dtype=jnp.float32)[:, None]
    wpos = 2.0 * math.pi * jnp.arange(L, dtype=jnp.float32)[:, None] / L
    f = jnp.linspace(1e-4, bands - 1, bands, dtype=jnp.float32)[None, :]
    emb = jnp.concatenate([t, jnp.cos(f * wpos), -jnp.sin(f * wpos)], axis=-1)
    fr = freq.astype(jnp.float32)
    h = jnp.sin(fr * (emb @ w1.astype(jnp.float32) + b1.astype(jnp.float32)))
    h = jnp.sin(fr * (h @ w2.astype(jnp.float32) + b2.astype(jnp.float32)))
    h = (h @ w3.astype(jnp.float32)).reshape(L, 2, HYENA_ORDER, D_HYENA)
    deltas = jnp.linspace(math.log(DECAY_TARGET) / FAST_DECAY_PCT,
                          math.log(DECAY_TARGET) / SLOW_DECAY_PCT, D_HYENA, dtype=jnp.float32)
    h = h * jnp.exp(-t * jnp.abs(deltas))[:, None, None, :]
    fwd, bwd = h[:, 0], h[:, 1]
    two_sided = jnp.concatenate([fwd[:1] + bwd[:1], fwd[1:],
                                 jnp.zeros((1, HYENA_ORDER, D_HYENA), jnp.float32),
                                 bwd[1:][::-1]], axis=0)
    return jnp.fft.rfft(two_sided, axis=0)


def _fftconv(u, hf, bias):
    L = u.shape[1]
    uf = u.astype(jnp.float32)
    U = jnp.fft.rfft(uf, n=2 * L, axis=1)
    y = jnp.fft.irfft(U * hf[None], n=2 * L, axis=1)[:, :L]
    return (y + uf * bias.astype(jnp.float32)).astype(u.dtype)


def _hyena(u, conv_w, conv_b, w1, b1, w2, b2, w3, freq, hy_bias):
    L = u.shape[1]
    u = _short_conv(u, conv_w, conv_b)
    v, x1, x2 = jnp.split(u, 3, axis=-1)
    hf = _hyena_filters(L, w1, b1, w2, b2, w3, freq)
    z = x1 * _fftconv(v, hf[:, 0], hy_bias[0])
    return x2 * _fftconv(z, hf[:, 1], hy_bias[1])


def _layer(x, mod, ctx_kv, lam_init, p):
    (norm1_g, norm2_g, w_in, lam_q1, lam_k1, lam_q2, lam_k2, attn_subln_g, conv_w, conv_b,
     filt_w1, filt_b1, filt_w2, filt_b2, filt_w3, filt_freq, hy_bias,
     w_br_attn, w_br_hy, w_out, w_up, w_down) = p
    B, L, _ = x.shape
    shift1, scale1, gate1, shift2, scale2, gate2 = [m[:, None, :] for m in jnp.split(mod, 6, axis=-1)]
    h = _rmsnorm(x, norm1_g) * (1.0 + scale1) + shift1
    proj = h @ w_in
    q, k, v, u_hy, gates = jnp.split(proj, SPLITS, axis=-1)
    q = q.reshape(B, L, N_HEADS, 2, HEAD_DIM)
    k = k.reshape(B, L, N_HEADS, 2, HEAD_DIM)
    v = v.reshape(B, L, N_HEADS, V_DIM)
    if ctx_kv is None:
        q_att, k_all, v_all = q, k, v
    else:
        q_att = _rope2d(q, L)
        k_all = jnp.concatenate([ctx_kv[0], _rope2d(k, L)], axis=1)
        v_all = jnp.concatenate([ctx_kv[1], v], axis=1)
    lam = (jnp.exp(jnp.sum(lam_q1.astype(jnp.float32) * lam_k1.astype(jnp.float32)))
           - jnp.exp(jnp.sum(lam_q2.astype(jnp.float32) * lam_k2.astype(jnp.float32))) + lam_init)
    o_attn = _diff_attention(q_att, k_all, v_all, lam, lam_init, attn_subln_g)
    o_hy = _hyena(u_hy, conv_w, conv_b, filt_w1, filt_b1, filt_w2, filt_b2, filt_w3, filt_freq, hy_bias)
    g_attn, g_hy = jnp.split(jax.nn.sigmoid(gates), 2, axis=-1)
    merged = g_attn * (o_attn @ w_br_attn) + g_hy * (o_hy @ w_br_hy)
    x = x + gate1 * (merged @ w_out)
    h2 = _rmsnorm(x, norm2_g) * (1.0 + scale2) + shift2
    x = x + gate2 * (jnp.square(jax.nn.relu(h2 @ w_up)) @ w_down)
    return x, k, v


def setup_inputs(seed: int = 0) -> dict:
    key = jax.random.key(seed)
    ks = jax.random.split(key, 31)
    f32 = jnp.float32

    def nrm(k, shape, scale):
        return jax.random.normal(k, shape, f32) * scale

    return {
        "x_prompt": nrm(ks[0], (BATCH, SEQ, D_MODEL), 1.0),
        "x_sample": nrm(ks[1], (DEC_BATCH, DEC_SEQ, D_MODEL), 1.0),
        "cache_k": nrm(ks[2], (DEC_BATCH, DEPTH, PAST_LEN, N_HEADS, 2, HEAD_DIM), 1.0),
        "cache_v": nrm(ks[3], (DEC_BATCH, DEPTH, PAST_LEN, N_HEADS, V_DIM), 1.0),
        "c": nrm(ks[4], (DEC_BATCH, D_MODEL), 1.0),
        "c_ctx": nrm(ks[5], (D_MODEL,), 1.0),
        "w_ada": nrm(ks[6], (DEPTH, D_MODEL, 6 * D_MODEL), 0.5 * D_MODEL ** -0.5),
        "b_ada": nrm(ks[7], (DEPTH, 6 * D_MODEL), 0.01),
        "norm1_g": 1.0 + nrm(ks[8], (DEPTH, D_MODEL), 0.02),
        "norm2_g": 1.0 + nrm(ks[9], (DEPTH, D_MODEL), 0.02),
        "w_in": nrm(ks[10], (DEPTH, D_MODEL, IN_COLS), D_MODEL ** -0.5),
        "lam_q1": nrm(ks[11], (DEPTH, HEAD_DIM), 0.1),
        "lam_k1": nrm(ks[12], (DEPTH, HEAD_DIM), 0.1),
        "lam_q2": nrm(ks[13], (DEPTH, HEAD_DIM), 0.1),
        "lam_k2": nrm(ks[14], (DEPTH, HEAD_DIM), 0.1),
        "attn_subln_g": 1.0 + nrm(ks[15], (DEPTH, V_DIM), 0.02),
        "conv_w": nrm(ks[16], (DEPTH, 3, HY_COLS), 0.5),
        "conv_b": nrm(ks[17], (DEPTH, HY_COLS), 0.01),
        "filt_w1": nrm(ks[18], (DEPTH, FILTER_EMB, FILTER_HIDDEN), FILTER_EMB ** -0.5),
        "filt_b1": nrm(ks[19], (DEPTH, FILTER_HIDDEN), 0.1),
        "filt_w2": nrm(ks[20], (DEPTH, FILTER_HIDDEN, FILTER_HIDDEN), FILTER_HIDDEN ** -0.5),
        "filt_b2": nrm(ks[21], (DEPTH, FILTER_HIDDEN), 0.1),
        "filt_w3": nrm(ks[22], (DEPTH, FILTER_HIDDEN, 2 * HYENA_ORDER * D_HYENA), 0.1 * FILTER_HIDDEN ** -0.5),
        "filt_freq": 1.0 + nrm(ks[23], (DEPTH, FILTER_HIDDEN), 0.1),
        "hy_bias": nrm(ks[24], (DEPTH, HYENA_ORDER, D_HYENA), 0.5),
        "w_br_attn": nrm(ks[25], (DEPTH, ATTN_WIDTH, D_MODEL), ATTN_WIDTH ** -0.5),
        "w_br_hy": nrm(ks[26], (DEPTH, D_HYENA, D_MODEL), D_HYENA ** -0.5),
        "w_out": nrm(ks[27], (DEPTH, D_MODEL, D_MODEL), D_MODEL ** -0.5),
        "w_up": nrm(ks[28], (DEPTH, D_MODEL, D_FF), D_MODEL ** -0.5),
        "w_down": nrm(ks[29], (DEPTH, D_FF, D_MODEL), D_FF ** -0.5),
        "final_g": 1.0 + nrm(ks[30], (D_MODEL,), 0.02),
    }


def reference(x_prompt, x_sample, cache_k, cache_v, c, c_ctx, w_ada, b_ada, norm1_g, norm2_g, w_in,
              lam_q1, lam_k1, lam_q2, lam_k2, attn_subln_g, conv_w, conv_b, filt_w1, filt_b1,
              filt_w2, filt_b2, filt_w3, filt_freq, hy_bias, w_br_attn, w_br_hy, w_out, w_up,
              w_down, final_g):
    y_p = x_prompt
    y_s = x_sample
    new_k = []
    new_v = []
    for l in range(DEPTH):
        p = (norm1_g[l], norm2_g[l], w_in[l], lam_q1[l], lam_k1[l], lam_q2[l], lam_k2[l],
             attn_subln_g[l], conv_w[l], conv_b[l], filt_w1[l], filt_b1[l], filt_w2[l],
             filt_b2[l], filt_w3[l], filt_freq[l], hy_bias[l], w_br_attn[l], w_br_hy[l],
             w_out[l], w_up[l], w_down[l])
        lam_init = 0.8 - 0.6 * math.exp(-0.3 * l)
        mod_ctx = (jax.nn.silu(c_ctx) @ w_ada[l] + b_ada[l])[None, :]
        mod_lat = jax.nn.silu(c) @ w_ada[l] + b_ada[l]
        y_p, k_ctx, v_ctx = _layer(y_p, mod_ctx, None, lam_init, p)
        new_k.append(k_ctx)
        new_v.append(v_ctx)
        y_s, _, _ = _layer(y_s, mod_lat, (cache_k[:, l], cache_v[:, l]), lam_init, p)
    y_prompt = _rmsnorm(y_p, final_g)
    y_sample = _rmsnorm(y_s, final_g)
    new_cache_k = jnp.stack(new_k, axis=1)
    new_cache_v = jnp.stack(new_v, axis=1)
    return (y_prompt, y_sample, new_cache_k, new_cache_v)
```

```cpp
#include <hip/hip_runtime.h>
#define HD __host__ __device__
#include <math.h>
namespace nv {
constexpr int D = 1024, INC = 6656, FF = 4096, NH = 8, HD_ = 64, VD = 128, DH = 512, HYC = 1536;
constexpr int NCTX = 16, LCTX = 256, NLAT = 8, LLAT = 1024, PAST = 256;
constexpr float EPSN = 1e-6f;
constexpr float LAM_INIT = 0.2f;

struct ModF { const float* c; const float* cctx; const float* w_ada; const float* b_ada; float* mod;
    HD void operator()(int gid) const { const int r = gid / 6144, col = gid % 6144; const float* cv = (r == 0) ? cctx : c + (r - 1) * D;
        float acc = 0.f; for (int k = 0; k < D; ++k) { const float x = cv[k]; const float s = x / (1.f + expf(-x)); acc += s * w_ada[(size_t)k * 6144 + col]; }
        mod[gid] = acc + b_ada[col]; } };
struct RstdF { const float* x; float* rstd; long long ncols;
    HD void operator()(int row) const { const float* p = x + (size_t)row * ncols; float s = 0.f; for (int i = 0; i < ncols; ++i) s += p[i] * p[i]; rstd[row] = 1.f / sqrtf(s / ncols + EPSN); } };
struct ModNormF { const float* x; const float* rstd; const float* g; const float* shift; const float* scale; float* h;
    HD void operator()(int gid) const { const int row = gid / D, c = gid % D; h[gid] = x[gid] * rstd[row] * g[c] * (1.f + scale[c]) + shift[c]; } };
struct GemmF { const float* A; const float* B; float* C; long long M, N, K, lda, ldb, ldc;
    HD void operator()(int gid) const { const int nb = N / 4; const int rb = gid / nb, cb = gid % nb; const int r0 = rb * 4, c0 = cb * 4;
        float a00=0,a01=0,a02=0,a03=0,a10=0,a11=0,a12=0,a13=0,a20=0,a21=0,a22=0,a23=0,a30=0,a31=0,a32=0,a33=0;
        const float* A0 = A + (size_t)r0 * lda; const float* A1 = A0 + lda; const float* A2 = A1 + lda; const float* A3 = A2 + lda;
        for (int k = 0; k < K; ++k) { const float* b = B + (size_t)k * ldb + c0; const float b0 = b[0], b1 = b[1], b2 = b[2], b3 = b[3];
            const float x0 = A0[k], x1 = A1[k], x2 = A2[k], x3 = A3[k];
            a00 += x0*b0; a01 += x0*b1; a02 += x0*b2; a03 += x0*b3; a10 += x1*b0; a11 += x1*b1; a12 += x1*b2; a13 += x1*b3;
            a20 += x2*b0; a21 += x2*b1; a22 += x2*b2; a23 += x2*b3; a30 += x3*b0; a31 += x3*b1; a32 += x3*b2; a33 += x3*b3; }
        float* c = C + (size_t)r0 * ldc + c0; c[0]=a00; c[1]=a01; c[2]=a02; c[3]=a03; c += ldc; c[0]=a10; c[1]=a11; c[2]=a12; c[3]=a13;
        c += ldc; c[0]=a20; c[1]=a21; c[2]=a22; c[3]=a23; c += ldc; c[0]=a30; c[1]=a31; c[2]=a32; c[3]=a33; } };
struct RopeF { float* proj;
    HD void operator()(int gid) const { const int i = gid & 15, axis = (gid >> 4) & 1, map = (gid >> 5) & 1, head = (gid >> 6) & 7, which = (gid >> 9) & 1, t = gid >> 10;
        const int pos = axis == 0 ? (t / 64) : (t % 64);
        const float inv = powf(10000.0f, -(float)i / 16.0f); const float ang = (float)pos * inv; const float cs = cosf(ang), sn = sinf(ang);
        float* p = proj + (size_t)t * INC + which * 1024 + head * 128 + map * 64 + axis * 32; const float x1 = p[i], x2 = p[i + 16];
        p[i] = x1 * cs - x2 * sn; p[i + 16] = x2 * cs + x1 * sn; } };
struct ConcatF { const float* proj; const float* cache_k; const float* cache_v; float* kall; float* vall;
    HD void operator()(int gid) const { const int r = gid / D, c = gid % D;
        if (r < PAST) { kall[gid] = cache_k[gid]; vall[gid] = cache_v[gid]; }
        else { kall[gid] = proj[(size_t)(r - PAST) * INC + 1024 + c]; vall[gid] = proj[(size_t)(r - PAST) * INC + 2048 + c]; } } };
struct CacheOutF { const float* proj; float* nk; float* nv;
    HD void operator()(int gid) const { const int r = gid / D, c = gid % D; nk[gid] = proj[(size_t)r * INC + 1024 + c]; nv[gid] = proj[(size_t)r * INC + 2048 + c]; } };
struct AttnF { const float* q; long long ldq; const float* k; long long ldk; const float* v; long long ldv; long long Lq, Lk; long long kseq_stride_rows;
    const float* lq1; const float* lk1; const float* lq2; const float* lk2; float* o;
    HD void operator()(int gid) const { const int ec = gid & 3, head = (gid >> 2) & 7, rt = gid >> 5; const int seq = rt / Lq;
        float s1 = 0.f, s2 = 0.f; for (int i = 0; i < 64; ++i) { s1 += lq1[i] * lk1[i]; s2 += lq2[i] * lk2[i]; }
        const float lam = expf(s1) - expf(s2) + LAM_INIT;
        const float* qp = q + (size_t)rt * ldq + head * 128;
        float m1 = -1e30f, m2 = -1e30f, l1 = 0.f, l2 = 0.f; float a1[32], a2[32];
#pragma unroll
        for (int e = 0; e < 32; ++e) { a1[e] = 0.f; a2[e] = 0.f; }
        for (int j = 0; j < Lk; ++j) { const float* kp = k + (size_t)(seq * kseq_stride_rows + j) * ldk + head * 128; const float* vp = v + (size_t)(seq * kseq_stride_rows + j) * ldv + head * 128 + ec * 32;
            float d1 = 0.f, d2 = 0.f;
            for (int i = 0; i < 64; ++i) { d1 += qp[i] * kp[i]; d2 += qp[64 + i] * kp[64 + i]; }
            d1 *= 0.125f; d2 *= 0.125f;
            const float n1 = fmaxf(m1, d1), n2 = fmaxf(m2, d2); const float c1 = expf(m1 - n1), c2 = expf(m2 - n2), p1 = expf(d1 - n1), p2 = expf(d2 - n2);
            l1 = l1 * c1 + p1; l2 = l2 * c2 + p2; m1 = n1; m2 = n2;
#pragma unroll
            for (int e = 0; e < 32; ++e) { const float vv = vp[e]; a1[e] = a1[e] * c1 + p1 * vv; a2[e] = a2[e] * c2 + p2 * vv; } }
        float* op = o + (size_t)rt * D + head * 128 + ec * 32; const float i1 = 1.f / l1, i2 = lam / l2;
#pragma unroll
        for (int e = 0; e < 32; ++e) op[e] = a1[e] * i1 - a2[e] * i2; } };
struct SubLnF { float* o; const float* g;
    HD void operator()(int gid) const { float* p = o + (size_t)gid * 128; float s = 0.f; for (int i = 0; i < 128; ++i) s += p[i] * p[i];
        const float r = 1.f / sqrtf(s / 128.f + EPSN) * (1.f - LAM_INIT); for (int i = 0; i < 128; ++i) p[i] = p[i] * r * g[i]; } };
struct ShortConvF { const float* proj; const float* w; const float* b; float* uc; long long L;
    HD void operator()(int gid) const { const int row = gid / HYC, c = gid % HYC; const int t = row % L;
        const float* p = proj + (size_t)row * INC + 3072 + c; const float xm = t > 0 ? p[-INC] : 0.f, x0 = p[0], xp = t < L - 1 ? p[INC] : 0.f;
        uc[gid] = xm * w[c] + x0 * w[HYC + c] + xp * w[2 * HYC + c] + b[c]; } };
struct Filt1F { const float* w1; const float* b1; const float* freq; float* h1; long long L;
    HD void operator()(int gid) const { const int t = gid / 64, j = gid % 64; const float tt = (L > 1) ? (float)t / (float)(L - 1) : 0.f;
        const float wpos = 2.0f * 3.14159265358979323846f * (float)t / (float)L; float acc = tt * w1[j];
        for (int bnd = 0; bnd < 16; ++bnd) { const float f = 1e-4f + (float)bnd * ((15.0f - 1e-4f) / 15.0f); const float a = f * wpos;
            acc += cosf(a) * w1[(1 + bnd) * 64 + j] - sinf(a) * w1[(17 + bnd) * 64 + j]; }
        h1[gid] = sinf(freq[j] * (acc + b1[j])); } };
struct Filt2F { const float* h1; const float* w2; const float* b2; const float* freq; float* h2;
    HD void operator()(int gid) const { const int t = gid / 64, j = gid % 64; float acc = 0.f; for (int i = 0; i < 64; ++i) acc += h1[t * 64 + i] * w2[i * 64 + j];
        h2[gid] = sinf(freq[j] * (acc + b2[j])); } };
struct Filt3F { const float* h2; const float* w3; float* hf; long long L;
    HD void operator()(int gid) const { const int t = gid / 2048, col = gid % 2048, ch = col % 512; float acc = 0.f; for (int i = 0; i < 64; ++i) acc += h2[t * 64 + i] * w3[i * 2048 + col];
        const float tt = (L > 1) ? (float)t / (float)(L - 1) : 0.f; const float d0 = logf(1e-2f) / 0.3f, d1 = logf(1e-2f) / 1.5f; const float delta = d0 + (d1 - d0) * (float)ch / 511.0f;
        hf[gid] = acc * expf(-tt * fabsf(delta)); } };
struct LongConvF { const float* u; long long ldu; const float* gate; long long ldg; const float* hf; long long ord; const float* bias; float* out; long long ldo; long long L;
    HD void operator()(int gid) const { const int row = gid / DH, c = gid % DH; const int t = row % L, row0 = row - t;
        float acc = 0.f;
        for (int s = 0; s < L; ++s) { const int d = t - s; float kf;
            if (d > 0) kf = hf[((size_t)d * 2 + 0) * 1024 + ord * 512 + c]; else if (d < 0) kf = hf[((size_t)(-d) * 2 + 1) * 1024 + ord * 512 + c];
            else kf = hf[ord * 512 + c] + hf[1024 + ord * 512 + c];
            acc += kf * u[(size_t)(row0 + s) * ldu + c]; }
        const float ut = u[(size_t)row * ldu + c];
        out[(size_t)row * ldo + c] = gate[(size_t)row * ldg + c] * (acc + ut * bias[c]); } };
struct MergeF { const float* t1; const float* t2; const float* proj; float* merged;
    HD void operator()(int gid) const { const int row = gid / D, c = gid % D; const float ga = proj[(size_t)row * INC + 4608 + c], gh = proj[(size_t)row * INC + 5632 + c];
        merged[gid] = t1[gid] / (1.f + expf(-ga)) + t2[gid] / (1.f + expf(-gh)); } };
struct ResF { const float* x; const float* gate; const float* t; float* y;
    HD void operator()(int gid) const { const int c = gid % D; y[gid] = x[gid] + gate[c] * t[gid]; } };
struct Relu2F { float* u; HD void operator()(int gid) const { const float v = u[gid] > 0.f ? u[gid] : 0.f; u[gid] = v * v; } };
struct FinalF { const float* x; const float* rstd; const float* g; float* y;
    HD void operator()(int gid) const { const int row = gid / D, c = gid % D; y[gid] = x[gid] * rstd[row] * g[c]; } };

struct Inputs { const float *x_prompt, *x_sample, *cache_k, *cache_v, *c, *c_ctx, *w_ada, *b_ada, *norm1_g, *norm2_g, *w_in, *lam_q1, *lam_k1, *lam_q2, *lam_k2,
    *attn_subln_g, *conv_w, *conv_b, *filt_w1, *filt_b1, *filt_w2, *filt_b2, *filt_w3, *filt_freq, *hy_bias, *w_br_attn, *w_br_hy, *w_out, *w_up, *w_down, *final_g; };

struct Scratch { float *mod, *hf256, *hf1024, *h1, *h2f, *rstd, *h, *proj, *kall, *vall, *oattn, *uc, *z, *ohy, *t1, *t2, *merged, *t3, *x1, *hn, *up, *t4, *x2; };
inline size_t carve(Scratch& S, float* base) { size_t o = 0; auto take = [&](size_t n) { float* p = base + o; o += (n + 63) / 64 * 64; return p; };
    S.mod = take(9 * 6144); S.hf256 = take(256 * 2048); S.hf1024 = take(1024 * 2048); S.h1 = take(1024 * 64); S.h2f = take(1024 * 64); S.rstd = take(1024);
    S.h = take(1024 * 1024); S.proj = take((size_t)1024 * INC); S.kall = take(1280 * 1024); S.vall = take(1280 * 1024); S.oattn = take(1024 * 1024);
    S.uc = take(1024 * HYC); S.z = take(1024 * DH); S.ohy = take(1024 * DH); S.t1 = take(1024 * 1024); S.t2 = take(1024 * 1024); S.merged = take(1024 * 1024);
    S.t3 = take(1024 * 1024); S.x1 = take(1024 * 1024); S.hn = take(1024 * 1024); S.up = take((size_t)1024 * FF); S.t4 = take(1024 * 1024); S.x2 = take(1024 * 1024); return o; }

template <class LA> void run_naive(LA& la, const Inputs& I, float* out, float* scratch) {
    Scratch S; carve(S, scratch);
    float* y = out;
    float* nk = out + (size_t)12288 * D;
    float* nvv = nk + (size_t)4096 * D;
    la.run(ModF{I.c, I.c_ctx, I.w_ada, I.b_ada, S.mod}, 9 * 6144);
    for (int li = 0; li < 2; ++li) { const int L = li ? 1024 : 256; float* hf = li ? S.hf1024 : S.hf256;
        la.run(Filt1F{I.filt_w1, I.filt_b1, I.filt_freq, S.h1, L}, L * 64);
        la.run(Filt2F{S.h1, I.filt_w2, I.filt_b2, I.filt_freq, S.h2f}, L * 64);
        la.run(Filt3F{S.h2f, I.filt_w3, hf, L}, L * 2048); }
    for (int g = 0; g < 12; ++g) {
        const bool lat = g >= 4; const int b = lat ? g - 4 : 0; const int L = lat ? 1024 : 256, nseq = lat ? 1 : 4;
        const float* x = lat ? I.x_sample + (size_t)b * 1024 * D : I.x_prompt + (size_t)g * 1024 * D;
        const float* mod = S.mod + (lat ? (1 + b) : 0) * 6144;
        float* yg = y + (size_t)g * 1024 * D;
        la.run(RstdF{x, S.rstd, D}, 1024);
        la.run(ModNormF{x, S.rstd, I.norm1_g, mod + 0, mod + 1024, S.h}, 1024 * D);
        la.run(GemmF{S.h, I.w_in, S.proj, 1024, INC, D, D, INC, INC}, 256 * (INC / 4));
        if (lat) {
            la.run(RopeF{S.proj}, 1024 * 1024);
            la.run(ConcatF{S.proj, I.cache_k + (size_t)b * PAST * D, I.cache_v + (size_t)b * PAST * D, S.kall, S.vall}, 1280 * D);
            la.run(AttnF{S.proj, INC, S.kall, D, S.vall, D, 1024, 1280, 0, I.lam_q1, I.lam_k1, I.lam_q2, I.lam_k2, S.oattn}, 1024 * 32);
        } else {
            la.run(CacheOutF{S.proj, nk + (size_t)g * 1024 * D, nvv + (size_t)g * 1024 * D}, 1024 * D);
            la.run(AttnF{S.proj, INC, S.proj + 1024, INC, S.proj + 2048, INC, 256, 256, 256, I.lam_q1, I.lam_k1, I.lam_q2, I.lam_k2, S.oattn}, 1024 * 32);
        }
        la.run(SubLnF{S.oattn, I.attn_subln_g}, 1024 * 8);
        la.run(ShortConvF{S.proj, I.conv_w, I.conv_b, S.uc, L}, 1024 * HYC);
        const float* hf = lat ? S.hf1024 : S.hf256;
        la.run(LongConvF{S.uc, HYC, S.uc + 512, HYC, hf, 0, I.hy_bias, S.z, DH, L}, 1024 * DH);
        la.run(LongConvF{S.z, DH, S.uc + 1024, HYC, hf, 1, I.hy_bias + 512, S.ohy, DH, L}, 1024 * DH);
        la.run(GemmF{S.oattn, I.w_br_attn, S.t1, 1024, D, D, D, D, D}, 256 * 256);
        la.run(GemmF{S.ohy, I.w_br_hy, S.t2, 1024, D, DH, DH, D, D}, 256 * 256);
        la.run(MergeF{S.t1, S.t2, S.proj, S.merged}, 1024 * D);
        la.run(GemmF{S.merged, I.w_out, S.t3, 1024, D, D, D, D, D}, 256 * 256);
        la.run(ResF{x, mod + 2048, S.t3, S.x1}, 1024 * D);
        la.run(RstdF{S.x1, S.rstd, D}, 1024);
        la.run(ModNormF{S.x1, S.rstd, I.norm2_g, mod + 3072, mod + 4096, S.hn}, 1024 * D);
        la.run(GemmF{S.hn, I.w_up, S.up, 1024, FF, D, D, FF, FF}, 256 * 1024);
        la.run(Relu2F{S.up}, 1024 * FF);
        la.run(GemmF{S.up, I.w_down, S.t4, 1024, D, FF, FF, D, D}, 256 * 256);
        la.run(ResF{S.x1, mod + 5120, S.t4, S.x2}, 1024 * D);
        la.run(RstdF{S.x2, S.rstd, D}, 1024);
        la.run(FinalF{S.x2, S.rstd, I.final_g, yg}, 1024 * D);
    }
}
}
template <class F> __global__ void __launch_bounds__(256) nv_gk(F f, int n) { const int i = blockIdx.x * 256 + threadIdx.x; if (i < n) f(i); }
struct DevLauncher { hipStream_t s; template <class F> void run(const F& f, int n) { hipLaunchKernelGGL(nv_gk<F>, dim3((n + 255) / 256), dim3(256), 0, s, f, n); } };
extern "C" void kernel_launch(void* const* d_in, const int* in_sizes, int n_in, void* d_out, int out_size, void* d_ws, size_t ws_size, hipStream_t stream) {
    if (n_in != 31) return;
    nv::Inputs I; const float** pp = (const float**)&I; for (int i = 0; i < 31; ++i) pp[i] = (const float*)d_in[i];
    DevLauncher la{stream};
    nv::run_naive(la, I, (float*)d_out, (float*)d_ws);
}
```

```cpp
#include <hip/hip_runtime.h>
#include <cstdio>
#include <cstdint>

#define MK_DEBUG 0
#define MK_STOP -1

namespace pg8 {
#define PG8_LAS __attribute__((address_space(3)))
typedef unsigned short bf16_t;
typedef short bf16x8 __attribute__((ext_vector_type(8)));
typedef float f32x4 __attribute__((ext_vector_type(4)));
typedef unsigned u32x4 __attribute__((ext_vector_type(4)));
constexpr int BM = 256, BK = 64, HALF = 128, HTB = HALF * BK * 2  , STAGE_BYTES = 8 * HTB, NXCD = 8, WGM = 8;

__host__ __device__ __forceinline__ int lds_byte(int r, int c) { const int st = (r >> 4) * 2 + (c >> 5), rr = r & 15, cc = c & 31, ob = rr * 64 + cc * 2; return st * 1024 + (ob ^ (((ob >> 9) & 1) << 5)); }
__host__ __device__ __forceinline__ void stage_rc(int b, int& R, int& C) { const int st = b / 1024, sb = b % 1024, swz = sb ^ (((sb >> 9) & 1) << 5); R = (st >> 1) * 16 + swz / 64; C = (st & 1) * 32 + (swz % 64) / 2; }
__host__ __device__ __forceinline__ int perm32(int rho) { const int n = rho >> 4, i = rho & 15; return 8 * (i >> 2) + 4 * n + (i & 3); }

struct Unit { int pm, pn; };
struct Gemm { const bf16_t* A; const bf16_t* Bt; int M, N, K; };

struct StaticOrder {
    int nM, nN, nwg, G, c;
    __host__ __device__ void init(int M, int N, int G_, int c_) { nM = M / BM; nN = N / BM; nwg = nM * nN; G = G_; c = c_; }
    __host__ __device__ bool next(int i, Unit& u) const {
        const long L = (long)i * G + c; if (L >= nwg) return false;
        int wgid = (int)L; { const int q = nwg / NXCD, r = nwg % NXCD, xcd = wgid % NXCD, off = wgid / NXCD; wgid = (xcd < r ? xcd * (q + 1) : r * (q + 1) + (xcd - r) * q) + off; }
        const int nig = WGM * nN, gid = wgid / nig, fm = gid * WGM, gsz = (nM - fm) < WGM ? (nM - fm) : WGM;
        u.pm = fm + ((wgid % nig) % gsz); u.pn = (wgid % nig) / gsz; return true;
    }
    __device__ __forceinline__ void a_ready(const Unit&) const {}
    __device__ __forceinline__ void done(const Unit&) const {}
};

__device__ __forceinline__ unsigned cvt_pk_bf16(float lo, float hi) { unsigned r; asm volatile("v_cvt_pk_bf16_f32 %0, %1, %2" : "=v"(r) : "v"(lo), "v"(hi)); return r; }
typedef float f32x2 __attribute__((ext_vector_type(2)));

template <class Epi, class Sched, bool ALIGN_EPI = false, bool SP2 = false>
__device__ __forceinline__ void gemm_phase(PG8_LAS unsigned char* lds, const Gemm g, const Sched& S, const Epi& E) {
    int tid_ = threadIdx.x; asm volatile("" : "+v"(tid_));
    const int tid = tid_, wid = __builtin_amdgcn_readfirstlane(tid >> 6), lane = tid & 63, wr = wid >> 2, wc = wid & 3, fr = lane & 15, fq = lane >> 4;
    const int K = g.K, nt = K / BK;
    unsigned voffA[2], voffB[2];
#pragma unroll
    for (int i = 0; i < 2; ++i) { int R, C; stage_rc(tid * 16 + i * 8192, R, C); const int Rb = Epi::PERM ? ((R & ~31) + perm32(R & 31)) : R;
        voffA[i] = (unsigned)(R * K + C) * 2u; voffB[i] = (unsigned)(Rb * K + C) * 2u; }
    const size_t kstep = (size_t)(BK * 2);
    const size_t hstep = (size_t)HALF * K * 2;
    const size_t tstep = 2 * hstep;
    const unsigned ldsw = (unsigned)wid * 1024u;
    const int aoff = lds_byte(wr * 64 + fr, fq * 8), boff = lds_byte(wc * 32 + fr, fq * 8);
#define PG8_SA(b, h) (((b) * 2 + (h)) * HTB)
#define PG8_SB(b, h) ((4 + (b) * 2 + (h)) * HTB)
#define PG8_STAGE(bufoff, gbase, voff) do { _Pragma("unroll") for (int _i = 0; _i < 2; ++_i) \
        __builtin_amdgcn_global_load_lds((const unsigned*)((const char*)(gbase) + (voff)[_i]), (PG8_LAS unsigned*)(lds + (bufoff) + ldsw + _i * 8192), 16, 0, 0); } while (0)
#define PG8_LDA(dst, b, h) do { _Pragma("unroll") for (int m = 0; m < 4; ++m) _Pragma("unroll") for (int k = 0; k < 2; ++k) dst[m][k] = *(const PG8_LAS bf16x8*)(lds + PG8_SA(b, h) + aoff + m * 2048 + k * 1024); } while (0)
#define PG8_LDB(dst, b, h) do { _Pragma("unroll") for (int n = 0; n < 2; ++n) _Pragma("unroll") for (int k = 0; k < 2; ++k) dst[n][k] = *(const PG8_LAS bf16x8*)(lds + PG8_SB(b, h) + boff + n * 2048 + k * 1024); } while (0)
#define PG8_MMA(ai, bj, At, Bt) do { __builtin_amdgcn_s_setprio(1); _Pragma("unroll") for (int m = 0; m < 4; ++m) _Pragma("unroll") for (int n = 0; n < 2; ++n) _Pragma("unroll") for (int k = 0; k < 2; ++k) \
        acc[ai][bj][m][n] = __builtin_amdgcn_mfma_f32_16x16x32_bf16(Bt[n][k], At[m][k], acc[ai][bj][m][n], 0, 0, 0); __builtin_amdgcn_s_setprio(0); } while (0)
#define PG8_WAIT_V(n) asm volatile("s_waitcnt vmcnt(" #n ")" ::: "memory")
#define PG8_WAIT_L(n) asm volatile("s_waitcnt lgkmcnt(" #n ")" ::: "memory")
#define PG8_BAR __builtin_amdgcn_s_barrier()
#define PG8_SCHED __builtin_amdgcn_sched_barrier(0)
    Unit cur, nxt; int ui = 0;
    if (!S.next(0, cur)) return;
    f32x4 acc[2][2][4][2];
#pragma unroll
    for (int a = 0; a < 2; ++a)
#pragma unroll
        for (int b = 0; b < 2; ++b)
#pragma unroll
            for (int m = 0; m < 4; ++m)
#pragma unroll
                for (int n = 0; n < 2; ++n) acc[a][b][m][n] = (f32x4){0.f, 0.f, 0.f, 0.f};
    bf16x8 At[4][2], B0[2][2], B1[2][2];
    const char* cA = (const char*)g.A + (size_t)cur.pm * tstep; const char* cB = (const char*)g.Bt + (size_t)cur.pn * tstep;
    S.a_ready(cur);
    if constexpr (SP2) {
        PG8_STAGE(PG8_SB(0, 0), cB, voffB); PG8_STAGE(PG8_SB(0, 1), cB + hstep, voffB); PG8_STAGE(PG8_SA(0, 0), cA, voffA); PG8_STAGE(PG8_SA(0, 1), cA + hstep, voffA);
        if (wr == 1) PG8_BAR;
        PG8_WAIT_V(2); PG8_BAR;
        PG8_STAGE(PG8_SB(1, 0), cB + kstep, voffB); PG8_STAGE(PG8_SA(1, 0), cA + kstep, voffA); PG8_STAGE(PG8_SB(1, 1), cB + hstep + kstep, voffB);
        PG8_WAIT_V(6); PG8_BAR;
    } else {
        PG8_STAGE(PG8_SB(0, 0), cB, voffB); PG8_STAGE(PG8_SA(0, 0), cA, voffA); PG8_STAGE(PG8_SB(0, 1), cB + hstep, voffB); PG8_STAGE(PG8_SA(0, 1), cA + hstep, voffA);
        if (wr == 1) PG8_BAR;
        PG8_WAIT_V(4); PG8_BAR;
        PG8_STAGE(PG8_SB(1, 0), cB + kstep, voffB); PG8_STAGE(PG8_SA(1, 0), cA + kstep, voffA); PG8_STAGE(PG8_SB(1, 1), cB + hstep + kstep, voffB);
        PG8_WAIT_V(6); PG8_BAR;
    }
    for (;;) {
        const bool has_next = S.next(ui + 1, nxt);
        const char* nA = has_next ? (const char*)g.A + (size_t)nxt.pm * tstep : cA; const char* nB = has_next ? (const char*)g.Bt + (size_t)nxt.pn * tstep : cB;
        for (int t = 0; t < nt; t += 2) {
            const bool last = (t == nt - 2);
            const char* a1 = cA + (size_t)(t + 1) * kstep;
            const char* a2 = last ? nA : cA + (size_t)(t + 2) * kstep; const char* b2 = last ? nB : cB + (size_t)(t + 2) * kstep;
            const char* a3 = a2 + kstep; const char* b3 = b2 + kstep;
            if (last && has_next) S.a_ready(nxt);
            if constexpr (SP2) {
            PG8_LDB(B0, 0, 0); PG8_LDB(B1, 0, 1); PG8_SCHED; PG8_LDA(At, 0, 0); PG8_STAGE(PG8_SA(1, 1), a1 + hstep, voffA);
            PG8_WAIT_V(8); PG8_WAIT_L(0); PG8_BAR; PG8_MMA(0, 0, At, B0); PG8_MMA(0, 1, At, B1); PG8_BAR; PG8_SCHED;
            PG8_LDA(At, 0, 1); PG8_STAGE(PG8_SB(0, 0), b2, voffB); PG8_STAGE(PG8_SB(0, 1), b2 + hstep, voffB); PG8_STAGE(PG8_SA(0, 0), a2, voffA);
            PG8_WAIT_V(8); PG8_WAIT_L(0); PG8_BAR; PG8_MMA(1, 0, At, B0); PG8_MMA(1, 1, At, B1); PG8_BAR; PG8_SCHED;
            PG8_LDB(B0, 1, 0); PG8_LDB(B1, 1, 1); PG8_SCHED; PG8_LDA(At, 1, 0); PG8_STAGE(PG8_SA(0, 1), a2 + hstep, voffA);
            PG8_WAIT_V(8); PG8_WAIT_L(0); PG8_BAR; PG8_MMA(0, 0, At, B0); PG8_MMA(0, 1, At, B1); PG8_BAR; PG8_SCHED;
            PG8_LDA(At, 1, 1); PG8_STAGE(PG8_SB(1, 0), b3, voffB); PG8_STAGE(PG8_SB(1, 1), b3 + hstep, voffB); PG8_STAGE(PG8_SA(1, 0), a3, voffA);
            PG8_WAIT_V(8); PG8_WAIT_L(0); PG8_BAR; PG8_MMA(1, 0, At, B0); PG8_MMA(1, 1, At, B1); PG8_BAR; PG8_SCHED;
            } else {
            PG8_LDB(B0, 0, 0); PG8_SCHED; PG8_LDA(At, 0, 0); PG8_STAGE(PG8_SA(1, 1), a1 + hstep, voffA);
            PG8_WAIT_L(8); PG8_BAR; PG8_WAIT_L(0); PG8_MMA(0, 0, At, B0); PG8_BAR; PG8_SCHED;
            PG8_LDB(B1, 0, 1); PG8_STAGE(PG8_SB(0, 0), b2, voffB);
            PG8_BAR; PG8_WAIT_L(0); PG8_MMA(0, 1, At, B1); PG8_BAR;
            PG8_LDA(At, 0, 1); PG8_STAGE(PG8_SA(0, 0), a2, voffA);
            PG8_BAR; PG8_WAIT_L(0); PG8_MMA(1, 0, At, B0); PG8_BAR; PG8_SCHED;
            PG8_STAGE(PG8_SB(0, 1), b2 + hstep, voffB);
            PG8_WAIT_V(6); PG8_BAR; PG8_MMA(1, 1, At, B1); PG8_BAR;
            PG8_LDB(B0, 1, 0); PG8_SCHED; PG8_LDA(At, 1, 0); PG8_STAGE(PG8_SA(0, 1), a2 + hstep, voffA);
            PG8_WAIT_L(8); PG8_BAR; PG8_WAIT_L(0); PG8_MMA(0, 0, At, B0); PG8_BAR; PG8_SCHED;
            PG8_LDB(B1, 1, 1); PG8_STAGE(PG8_SB(1, 0), b3, voffB);
            PG8_BAR; PG8_WAIT_L(0); PG8_MMA(0, 1, At, B1); PG8_BAR;
            PG8_LDA(At, 1, 1); PG8_STAGE(PG8_SA(1, 0), a3, voffA);
            PG8_BAR; PG8_WAIT_L(0); PG8_MMA(1, 0, At, B0); PG8_BAR; PG8_SCHED;
            PG8_STAGE(PG8_SB(1, 1), b3 + hstep, voffB);
            PG8_WAIT_V(6); PG8_BAR; PG8_MMA(1, 1, At, B1); PG8_BAR;
            }
        }
        if constexpr (ALIGN_EPI) { if (wr == 0) PG8_BAR; }
        if constexpr (!Epi::AFTER_DRAIN) { E(acc, cur, wr, wc, fr, fq); S.done(cur); }
        if (!has_next) break;
#pragma unroll
        for (int a = 0; a < 2; ++a)
#pragma unroll
            for (int b = 0; b < 2; ++b)
#pragma unroll
                for (int m = 0; m < 4; ++m)
#pragma unroll
                    for (int n = 0; n < 2; ++n) acc[a][b][m][n] = (f32x4){0.f, 0.f, 0.f, 0.f};
        cur = nxt; cA = nA; cB = nB; ++ui;
        if constexpr (ALIGN_EPI) { if (wr == 1) PG8_BAR; }
    }
    PG8_WAIT_V(0);
    if constexpr (!ALIGN_EPI) { if (wr == 0) PG8_BAR; }
    PG8_BAR;
    if constexpr (Epi::AFTER_DRAIN) { E.fused(acc, cur, wr, wc, fr, fq, lds, wid, lane); S.done(cur); }
#undef PG8_SA
#undef PG8_SB
#undef PG8_STAGE
#undef PG8_LDA
#undef PG8_LDB
#undef PG8_MMA
#undef PG8_WAIT_V
#undef PG8_WAIT_L
#undef PG8_BAR
#undef PG8_SCHED
}
}

constexpr bool PG8_SP2 = true, PG8_ALIGN = true;

#define GAS __attribute__((address_space(1)))
#define LAS __attribute__((address_space(3)))
typedef unsigned short bf16;
typedef unsigned v4u __attribute__((ext_vector_type(4)));
typedef float f32x4 __attribute__((ext_vector_type(4)));
typedef short bf16x8 __attribute__((ext_vector_type(8)));
typedef GAS unsigned gu32;
typedef GAS unsigned long long gu64;
#define RLX_AGENT __ATOMIC_RELAXED, __HIP_MEMORY_SCOPE_AGENT
#define LDS_WAIT() asm volatile("s_waitcnt lgkmcnt(0)" ::: "memory")
#define VM_WAIT() asm volatile("s_waitcnt vmcnt(0)" ::: "memory")
__device__ __forceinline__ unsigned long long rt() { return __builtin_amdgcn_s_memrealtime(); }
__device__ __forceinline__ unsigned f2bf(float f) { unsigned u = __builtin_bit_cast(unsigned, f); return (u + 0x7fffu + ((u >> 16) & 1u)) >> 16; }
__device__ __forceinline__ unsigned pk2(float lo, float hi) { return f2bf(lo) | (f2bf(hi) << 16); }

#define XB_TMO      128
#define XB_XCNT(j)  (256  + 64 * (j))
#define XB_XSUB(j)  (1280 + 64 * (j))
#define XB_XGEN(j)  (2304 + 64 * (j))
#define XB_TOP      3328
#define XB_TOPGEN   3392
#define XCD_BAR_WORDS 3456
#define XB_SPIN_CAP (1u << 18)

__device__ __forceinline__ unsigned xb_ld(unsigned* p)              { return __hip_atomic_load(p, __ATOMIC_RELAXED, __HIP_MEMORY_SCOPE_AGENT); }
__device__ __forceinline__ unsigned xb_add(unsigned* p, unsigned v) { return __hip_atomic_fetch_add(p, v, __ATOMIC_RELAXED, __HIP_MEMORY_SCOPE_AGENT); }
__device__ __forceinline__ unsigned xb_xcc_id() { return (unsigned)__builtin_amdgcn_s_getreg((3 << 11) | 20) & 0xFu; }
#define XB_SPIN(cond, bar) do { unsigned _sp = 0; while (cond) { __builtin_amdgcn_s_sleep(1); \
    if ((++_sp & 255u) == 0u) { if (xb_ld(&(bar)[XB_TMO])) break; if (_sp > XB_SPIN_CAP) { atomicAdd(&(bar)[XB_TMO], 1u); break; } } } } while (0)

struct XcdBarrier {
    unsigned* bar; unsigned x;
    volatile LAS unsigned* st;
};

__device__ __forceinline__ XcdBarrier xcd_barrier_post(unsigned* bar, volatile LAS unsigned* st) {
    XcdBarrier b; b.bar = bar; b.x = xb_xcc_id(); b.st = st;
    if (threadIdx.x == 0) (void)xb_add(&bar[XB_XCNT(b.x)], 1u);
    return b;
}
__device__ __forceinline__ void xcd_barrier_complete(unsigned* bar, unsigned x, unsigned& nloc, unsigned& nx) {
    const unsigned G = gridDim.x * gridDim.y * gridDim.z;
    unsigned sum, cnt, mine, sp = 0u;
    for (;;) {
        sum = 0u; cnt = 0u; mine = 0u;
#pragma unroll
        for (unsigned j = 0; j < 16; ++j) { const unsigned c = xb_ld(&bar[XB_XCNT(j)]); sum += c; cnt += (c > 0u) ? 1u : 0u; mine = (j == x) ? c : mine; }
        if (sum == G) break;
        __builtin_amdgcn_s_sleep(1);
        if ((++sp & 255u) == 0u) { if (xb_ld(&bar[XB_TMO])) break; if (sp > XB_SPIN_CAP) { atomicAdd(&bar[XB_TMO], 1u); break; } }
    }
    nloc = mine > 0u ? mine : 1u; nx = cnt > 0u ? cnt : 1u;
}

__device__ __forceinline__ void xcd_barrier(const XcdBarrier& b) {
    asm volatile("s_waitcnt vmcnt(0)" ::: "memory");
    __syncthreads();
    if (threadIdx.x == 0) {
        unsigned* bar = b.bar;
        __builtin_amdgcn_s_waitcnt(0);
        unsigned nloc = b.st[0], nx = b.st[1];
        if (nloc == 0u) { xcd_barrier_complete(bar, b.x, nloc, nx); b.st[0] = nloc; b.st[1] = nx; }
        const unsigned old = xb_add(&bar[XB_XSUB(b.x)], 1u);
        const unsigned gen = old / nloc;
        if (old + 1u == (gen + 1u) * nloc) {
            __builtin_amdgcn_fence(__ATOMIC_RELEASE, "agent");
            asm volatile("s_waitcnt vmcnt(0)" ::: "memory");
            const unsigned og = xb_add(&bar[XB_TOP], 1u);
            const unsigned tg = og / nx;
            if (og + 1u == (tg + 1u) * nx) xb_add(&bar[XB_TOPGEN], 1u);
            else XB_SPIN(xb_ld(&bar[XB_TOPGEN]) == tg, bar);
            __builtin_amdgcn_fence(__ATOMIC_ACQUIRE, "agent");
            xb_add(&bar[XB_XGEN(b.x)], 1u);
            asm volatile("s_waitcnt vmcnt(0)" ::: "memory");
        } else {
            XB_SPIN(xb_ld(&bar[XB_XGEN(b.x)]) == gen, bar);
            __builtin_amdgcn_fence(__ATOMIC_ACQUIRE, "agent");
            asm volatile("s_waitcnt vmcnt(0)" ::: "memory");
        }
    }
    __syncthreads();
}

__device__ __forceinline__ float wave_sum(float v) {
#pragma unroll
    for (int o = 1; o < 64; o <<= 1) v += __shfl_xor(v, o);
    return v;
}
__device__ __forceinline__ void p0_transpose_item(const float* W, int K, int N, bf16* WT, int row_off, LAS float* scr, int item, int lane) {
    const int nblk = N / 32, kb = item / nblk, nb = item % nblk, k0 = 64 * kb, n0 = 32 * nb;
#pragma unroll 8
    for (int i = 0; i < 32; ++i) { const int kk = 2 * i + (lane >> 5); scr[kk * 33 + (lane & 31)] = W[(size_t)(k0 + kk) * N + n0 + (lane & 31)]; }
    LDS_WAIT(); asm volatile("" ::: "memory");
    const int c = lane & 7;
#pragma unroll
    for (int j = 0; j < 4; ++j) { const int n = (lane >> 3) + 8 * j; const LAS float* s = scr + (8 * c) * 33 + n;
        v4u o; o.x = pk2(s[0 * 33], s[1 * 33]); o.y = pk2(s[2 * 33], s[3 * 33]); o.z = pk2(s[4 * 33], s[5 * 33]); o.w = pk2(s[6 * 33], s[7 * 33]);
        *(GAS v4u*)(WT + (size_t)(row_off + n0 + n) * K + k0 + 8 * c) = o; }
    LDS_WAIT(); asm volatile("" ::: "memory");
}

constexpr int NWAVES = 8;
constexpr int D = 1024, M_CTX = 4096, M_LAT = 8192, MROWS = 12288, INC = 6656, FF = 4096, DH = 512, HYC = 1536;
constexpr int LCTX = 256, LLAT = 1024, PAST = 256, LKLAT = 1280, KROWS = M_CTX + 8 * LKLAT;
constexpr float EPSN = 1e-6f, LAM_INIT = 0.2f;
constexpr float QSCALE = 0.125f * 1.4426950408889634f;
constexpr size_t MiB = 1u << 20;
constexpr size_t WS_CTL = 0, CTL_ZERO_BYTES = 1 * MiB;
constexpr size_t WS_WIN = 1 * MiB, WS_WA = 14 * MiB, WS_WH = 16 * MiB, WS_WO = 17 * MiB, WS_WUP = 19 * MiB, WS_WDN = 27 * MiB;
constexpr size_t WS_MODP = 35 * MiB;
constexpr size_t WS_MODF = 37 * MiB;
constexpr size_t WS_ROPE = 38 * MiB;
constexpr size_t WS_H2 = 38 * MiB + 65536;
constexpr size_t WS_FILT = 39 * MiB;
constexpr size_t WS_XN = 44 * MiB;
constexpr size_t WS_Q = 68 * MiB;
constexpr size_t WS_K = 92 * MiB;
constexpr size_t WS_V = 120 * MiB;
constexpr size_t WS_UT = 148 * MiB;
constexpr size_t WS_G = 184 * MiB;
constexpr size_t WS_UP = 68 * MiB;
constexpr size_t WS_END = 232 * MiB;
constexpr int CW_TMO = 0, CW_CODE = 1, CW_QUEUE = 64, CW_BAR = 4096;
constexpr int DBG_WORDS = 8192;
constexpr int RING_OFF = 0, RING_BYTES = 131072, LDSCTL_OFF = RING_BYTES, MISC_OFF = LDSCTL_OFF + 320, LDS_BYTES = 147456;

struct Args { const float* in[31]; float* out; unsigned char* ws; int stop_after; int pad; };
struct Frame {
    LAS unsigned char* lds; volatile LAS unsigned* MISC; gu32* ctl;
    int tid, lane, wave, vcu, G;
    float* out; unsigned char* ws;
};
#define WSP(T, off) ((T*)(F.ws + (off)))
__device__ __forceinline__ float bf2f(bf16 h) { return __uint_as_float((unsigned)h << 16); }
__device__ __forceinline__ const float* xrow_ptr(const Frame& F, const Args& A, int row) { return row < M_CTX ? A.in[0] + (size_t)row * D : A.in[1] + (size_t)(row - M_CTX) * D; }
__device__ __forceinline__ int mod_row(int row) { return row < M_CTX ? 0 : 1 + ((row - M_CTX) >> 10); }

__device__ __forceinline__ void p0_mod_item(const Frame& F, const Args& A, LAS float* scr, int item) {
    const int cb = item >> 3, kc = item & 7, lane = F.lane, col = cb * 64 + lane, k0 = kc * 128;
#pragma unroll
    for (int r = 0; r < 9; ++r) { const float* cv = (r == 0) ? A.in[5] : A.in[4] + (r - 1) * D;
#pragma unroll
        for (int h = 0; h < 2; ++h) { const float x = cv[k0 + h * 64 + lane]; scr[r * 128 + h * 64 + lane] = x / (1.f + expf(-x)); } }
    LDS_WAIT(); asm volatile("" ::: "memory");
    float acc[9];
#pragma unroll
    for (int r = 0; r < 9; ++r) acc[r] = 0.f;
    const float* wp = A.in[6] + (size_t)k0 * 6144 + col;
#pragma unroll 4
    for (int k = 0; k < 128; ++k) { const float w = wp[(size_t)k * 6144];
#pragma unroll
        for (int r = 0; r < 9; ++r) acc[r] += scr[r * 128 + k] * w; }
    float* mp = WSP(float, WS_MODP) + (size_t)kc * 9 * 6144 + col;
#pragma unroll
    for (int r = 0; r < 9; ++r) mp[r * 6144] = acc[r];
    LDS_WAIT(); asm volatile("" ::: "memory");
}
__device__ __forceinline__ void p0_cache_item(const Frame& F, const Args& A, int r) {
    const int b = r >> 8, j = r & 255; const size_t drow = (size_t)(M_CTX + b * LKLAT + j) * D;
    const GAS f32x4* sk = (const GAS f32x4*)(A.in[2] + (size_t)r * D) + F.lane; const GAS f32x4* sv = (const GAS f32x4*)(A.in[3] + (size_t)r * D) + F.lane;
    GAS unsigned long long* dk = (GAS unsigned long long*)(WSP(bf16, WS_K) + drow) + F.lane; GAS unsigned long long* dv = (GAS unsigned long long*)(WSP(bf16, WS_V) + drow) + F.lane;
#pragma unroll
    for (int q = 0; q < 4; ++q) { const f32x4 a = sk[64 * q], c = sv[64 * q];
        dk[64 * q] = (unsigned long long)pk2(a.x, a.y) | ((unsigned long long)pk2(a.z, a.w) << 32);
        dv[64 * q] = (unsigned long long)pk2(c.x, c.y) | ((unsigned long long)pk2(c.z, c.w) << 32); }
}
__device__ __forceinline__ void p0_rope_item(const Frame& F, const Args& A) {
    float* tb = WSP(float, WS_ROPE);
    for (int e = F.lane; e < 1024; e += 64) { const int pos = e >> 4, i = e & 15; const float inv = powf(10000.0f, -(float)i / 16.0f); const float ang = (float)pos * inv;
        tb[2 * e] = cosf(ang); tb[2 * e + 1] = sinf(ang); }
}
__device__ __forceinline__ void p0_filter_item(const Frame& F, const Args& A, LAS float* scr, int item) {
    const int lane = F.lane; const bool big = item >= 256; const int L = big ? 1024 : 256, t = big ? item - 256 : item;
    const float tt = (float)t / (float)(L - 1);
    if (lane < 33) { float e;
        if (lane == 0) e = tt;
        else { const int bnd = (lane - 1) & 15; const float f = 1e-4f + (float)bnd * ((15.0f - 1e-4f) / 15.0f); const float wpos = 2.0f * 3.14159265358979323846f * (float)t / (float)L; const float a = f * wpos;
            e = (lane <= 16) ? cosf(a) : -sinf(a); }
        scr[lane] = e; }
    LDS_WAIT(); asm volatile("" ::: "memory");
    const float fr = A.in[23][lane];
    float acc = A.in[19][lane];
    for (int i = 0; i < 33; ++i) acc += scr[i] * A.in[18][i * 64 + lane];
    const float h1 = sinf(fr * acc);
    scr[64 + lane] = h1;
    LDS_WAIT(); asm volatile("" ::: "memory");
    float acc2 = A.in[21][lane];
    for (int i = 0; i < 64; ++i) acc2 += scr[64 + i] * A.in[20][i * 64 + lane];
    const float h2 = sinf(fr * acc2);
    scr[128 + lane] = h2;
    WSP(float, WS_H2)[(size_t)item * 64 + lane] = h2;
    LDS_WAIT(); asm volatile("" ::: "memory");
    bf16* R = WSP(bf16, WS_FILT) + (big ? (size_t)(1 * MiB / 2) : 0);
    const float d0 = logf(1e-2f) / 0.3f, d1 = logf(1e-2f) / 1.5f;
    for (int jj = 0; jj < 16; ++jj) { const int col = jj * 64 + lane;
        float af = 0.f, ab = 0.f;
#pragma unroll 8
        for (int i = 0; i < 64; ++i) { const float h = scr[128 + i]; af += h * A.in[22][i * 2048 + col]; ab += h * A.in[22][i * 2048 + 1024 + col]; }
        const int ch = col & 511, ord = col >> 9; const float delta = d0 + (d1 - d0) * (float)ch / 511.0f; const float dec = expf(-tt * fabsf(delta));
        af *= dec; ab *= dec;
        bf16* Rc = R + ((size_t)ord * 512 + ch) * (2 * L);
        if (t == 0) { Rc[L] = (bf16)f2bf(af + ab); Rc[0] = 0; } else { Rc[L - t] = (bf16)f2bf(af); Rc[L + t] = (bf16)f2bf(ab); } }
    LDS_WAIT(); asm volatile("" ::: "memory");
}
__device__ __forceinline__ void p0_prologue(const Frame& F, const Args& A) {
    LAS float* scr = (LAS float*)(F.lds + RING_OFF + F.wave * 16384);
    const int gw = F.vcu * NWAVES + F.wave, NGW = F.G * NWAVES;
    constexpr int I_IN = (D / 64) * (INC / 32), I_A = (D / 64) * (D / 32), I_H = (DH / 64) * (D / 32), I_O = I_A, I_UP = (D / 64) * (FF / 32), I_DN = (FF / 64) * (D / 32);
    constexpr int NT = I_IN + I_A + I_H + I_O + I_UP + I_DN;
    constexpr int N_MOD = 768, N_CACHE = 2048, N_FILT = 1280;
    for (int it = gw; it < N_FILT; it += NGW) p0_filter_item(F, A, scr, it);
    for (int it = gw; it < N_MOD; it += NGW) p0_mod_item(F, A, scr, (it + 1280) % N_MOD);
    if (gw == NGW - 1) p0_rope_item(F, A);
    for (int it = gw; it < N_CACHE; it += NGW) p0_cache_item(F, A, it);
    for (int it = gw; it < NT; it += NGW) {
        int r = it;
        if (r < I_IN) { p0_transpose_item(A.in[10], D, INC, WSP(bf16, WS_WIN), 0, scr, r, F.lane); continue; } r -= I_IN;
        if (r < I_A) { p0_transpose_item(A.in[25], D, D, WSP(bf16, WS_WA), 0, scr, r, F.lane); continue; } r -= I_A;
        if (r < I_H) { p0_transpose_item(A.in[26], DH, D, WSP(bf16, WS_WH), 0, scr, r, F.lane); continue; } r -= I_H;
        if (r < I_O) { p0_transpose_item(A.in[27], D, D, WSP(bf16, WS_WO), 0, scr, r, F.lane); continue; } r -= I_O;
        if (r < I_UP) { p0_transpose_item(A.in[28], D, FF, WSP(bf16, WS_WUP), 0, scr, r, F.lane); continue; } r -= I_UP;
        p0_transpose_item(A.in[29], FF, D, WSP(bf16, WS_WDN), 0, scr, r, F.lane);
    }
}
__device__ __forceinline__ void modnorm_rows(const Frame& F, const Args& A, int which) {
    const int gw = F.vcu * NWAVES + F.wave, NGW = F.G * NWAVES, lane = F.lane;
    const float* gvec = which ? A.in[9] : A.in[8]; const int shoff = which ? 3072 : 0, scoff = which ? 4096 : 1024;
    for (int ch = gw; ch < MROWS / 6; ch += NGW) {
        int cur = -1; f32x4 av[4], sv[4];
        for (int rr = 0; rr < 6; ++rr) { const int row = ch * 6 + rr; const int mr = mod_row(row);
            if (mr != cur) { cur = mr;
#pragma unroll
                for (int j = 0; j < 4; ++j) { const int c = 4 * lane + 256 * j; f32x4 sh, sc;
                    if (which == 0) { sh = *(const GAS f32x4*)(A.in[7] + c); sc = *(const GAS f32x4*)(A.in[7] + 1024 + c);
                        for (int kc = 0; kc < 8; ++kc) { const float* mp = WSP(float, WS_MODP) + ((size_t)kc * 9 + mr) * 6144; sh += *(const GAS f32x4*)(mp + c); sc += *(const GAS f32x4*)(mp + 1024 + c); } }
                    else { const float* mf = WSP(float, WS_MODF) + (size_t)mr * 6144; sh = *(const GAS f32x4*)(mf + shoff + c); sc = *(const GAS f32x4*)(mf + scoff + c); }
                    const f32x4 g = *(const GAS f32x4*)(gvec + c); av[j] = g * (sc + 1.0f); sv[j] = sh; } }
            const float* xr = which ? F.out + (size_t)row * D : xrow_ptr(F, A, row);
            f32x4 v[4]; float s = 0.f;
#pragma unroll
            for (int j = 0; j < 4; ++j) { v[j] = *(const GAS f32x4*)(xr + 4 * lane + 256 * j); s += (v[j].x * v[j].x + v[j].y * v[j].y) + (v[j].z * v[j].z + v[j].w * v[j].w); }
            const float rstd = 1.f / sqrtf(wave_sum(s) * (1.f / D) + EPSN);
            GAS unsigned long long* o8 = (GAS unsigned long long*)(WSP(bf16, WS_XN) + (size_t)row * D) + lane;
#pragma unroll
            for (int j = 0; j < 4; ++j) { const f32x4 y = v[j] * rstd * av[j] + sv[j]; o8[64 * j] = (unsigned long long)pk2(y.x, y.y) | ((unsigned long long)pk2(y.z, y.w) << 32); } }
    }
    if (which == 0) {
        for (int it = gw; it < 9 * 6144 / 64; it += NGW) { const int idx = it * 64 + lane, r = idx / 6144, col = idx % 6144; float a = A.in[7][col];
            for (int kc = 0; kc < 8; ++kc) a += WSP(float, WS_MODP)[((size_t)kc * 9 + r) * 6144 + col];
            WSP(float, WS_MODF)[idx] = a; } }
}
struct EpiIn {
    static constexpr bool PERM = true, AFTER_DRAIN = false;
    bf16 *Q, *Kb, *Vb, *UT, *G; float *nk, *nv; const float* rope;
    __device__ __forceinline__ void operator()(const pg8::f32x4 (&acc)[2][2][4][2], const pg8::Unit& u, int wr, int wc, int fr, int fq) const {
        using pg8::f32x4; using pg8::u32x4;
        const int pn = u.pn, pm = u.pm; const bool lat = pm >= 16;
        const int rowt = pm * 256 + wr * 64 + fr;
        if (pn < 12) {
            const int typ = pn >> 2, cb = (pn & 3) * 256 + wc * 32 + 8 * fq;
            const int lb = (pm - 16) >> 2, t0 = ((pm - 16) & 3) * 256 + wr * 64 + fr;
#pragma unroll
            for (int ai = 0; ai < 2; ++ai)
#pragma unroll
                for (int m = 0; m < 4; ++m) {
                    const int row = rowt + ai * 128 + m * 16, t = t0 + ai * 128 + m * 16;
#pragma unroll
                    for (int bj = 0; bj < 2; ++bj) {
                        f32x4 v0 = acc[ai][bj][m][0], v1 = acc[ai][bj][m][1];
                        if (lat && typ < 2) {
                            const int pos = (wc & 1) ? (t & 63) : (t >> 6);
                            const float* tb = rope + (size_t)pos * 32 + (8 * (fq & 1)) * 2;
                            const f32x4 c0 = *(const f32x4*)(tb), c1 = *(const f32x4*)(tb + 4), c2 = *(const f32x4*)(tb + 8), c3 = *(const f32x4*)(tb + 12);
                            f32x4 p0, p1;
                            p0.x = __shfl_xor(v0.x, 32); p0.y = __shfl_xor(v0.y, 32); p0.z = __shfl_xor(v0.z, 32); p0.w = __shfl_xor(v0.w, 32);
                            p1.x = __shfl_xor(v1.x, 32); p1.y = __shfl_xor(v1.y, 32); p1.z = __shfl_xor(v1.z, 32); p1.w = __shfl_xor(v1.w, 32);
                            const float sg = (fq < 2) ? -1.f : 1.f;
                            v0.x = v0.x * c0.x + sg * p0.x * c0.y; v0.y = v0.y * c0.z + sg * p0.y * c0.w; v0.z = v0.z * c1.x + sg * p0.z * c1.y; v0.w = v0.w * c1.z + sg * p0.w * c1.w;
                            v1.x = v1.x * c2.x + sg * p1.x * c2.y; v1.y = v1.y * c2.z + sg * p1.y * c2.w; v1.z = v1.z * c3.x + sg * p1.z * c3.y; v1.w = v1.w * c3.z + sg * p1.w * c3.w;
                        }
                        const int col = cb + bj * 128;
                        if (!lat && typ > 0) { float* op = (typ == 1 ? nk : nv) + (size_t)row * D + col; *(f32x4*)op = v0; *(f32x4*)(op + 4) = v1; }
                        if (typ == 0) { v0 = v0 * QSCALE; v1 = v1 * QSCALE; }
                        u32x4 w; w.x = pg8::cvt_pk_bf16(v0[0], v0[1]); w.y = pg8::cvt_pk_bf16(v0[2], v0[3]); w.z = pg8::cvt_pk_bf16(v1[0], v1[1]); w.w = pg8::cvt_pk_bf16(v1[2], v1[3]);
                        bf16* dst;
                        if (typ == 0) dst = Q + (size_t)row * D + col;
                        else { const size_t kr = lat ? (size_t)(M_CTX + lb * LKLAT + PAST + t) : (size_t)row; dst = (typ == 1 ? Kb : Vb) + kr * D + col; }
                        *(u32x4*)dst = w;
                    }
                }
        } else if (pn < 18) {
            const int cb = (pn - 12) * 256 + wc * 32 + 8 * fq;
#pragma unroll
            for (int ai = 0; ai < 2; ++ai)
#pragma unroll
                for (int m = 0; m < 4; ++m) { const int row = rowt + ai * 128 + m * 16;
#pragma unroll
                    for (int bj = 0; bj < 2; ++bj)
#pragma unroll
                        for (int n = 0; n < 2; ++n)
#pragma unroll
                            for (int e = 0; e < 4; ++e) UT[(size_t)(cb + bj * 128 + 4 * n + e) * MROWS + row] = (bf16)f2bf(acc[ai][bj][m][n][e]); }
        } else {
            const int cb = (pn - 18) * 256 + wc * 32 + 8 * fq;
#pragma unroll
            for (int ai = 0; ai < 2; ++ai)
#pragma unroll
                for (int m = 0; m < 4; ++m) { const int row = rowt + ai * 128 + m * 16;
#pragma unroll
                    for (int bj = 0; bj < 2; ++bj) { f32x4 v0 = acc[ai][bj][m][0], v1 = acc[ai][bj][m][1];
#pragma unroll
                        for (int e = 0; e < 4; ++e) { v0[e] = 1.f / (1.f + __expf(-v0[e])); v1[e] = 1.f / (1.f + __expf(-v1[e])); }
                        u32x4 w; w.x = pg8::cvt_pk_bf16(v0[0], v0[1]); w.y = pg8::cvt_pk_bf16(v0[2], v0[3]); w.z = pg8::cvt_pk_bf16(v1[0], v1[1]); w.w = pg8::cvt_pk_bf16(v1[2], v1[3]);
                        *(u32x4*)(G + (size_t)row * 2048 + cb + bj * 128) = w; } }
        }
    }
};

typedef float f32x16 __attribute__((ext_vector_type(16)));
typedef short s16x4 __attribute__((ext_vector_type(4)));
constexpr int AT_K = 0, AT_V = 16384, AT_Q = 32768, AT_QW = 9216, AT_OP = 272;
static_assert(AT_Q + 8 * AT_QW <= RING_BYTES, "attention LDS");
__device__ __forceinline__ unsigned off_b(unsigned row, unsigned ch) { return 256u * row + 16u * (ch ^ (((row & 3u) << 2) | ((row >> 2) & 3u))); }
__device__ __forceinline__ s16x4 tr16(LAS unsigned char* p) { return __builtin_bit_cast(s16x4, __builtin_amdgcn_ds_read_tr16_b64_v4i16((LAS s16x4*)p)); }
__device__ __forceinline__ unsigned pkbf(float lo, float hi) { return pg8::cvt_pk_bf16(lo, hi); }
__device__ __forceinline__ void attn_unit(const Frame& F, const Args& A, bf16* Obuf, int qrow0, int krow0, int nt, int head) {
    int tid = F.tid; asm volatile("" : "+v"(tid));
    const int lane = tid & 63, wave = __builtin_amdgcn_readfirstlane(tid >> 6), r32 = lane & 31, hi = lane >> 5, mp = wave >> 2, qb = wave & 3;
    LAS unsigned char* lk = F.lds + AT_K; LAS unsigned char* lv = F.lds + AT_V; LAS unsigned char* lq = F.lds + AT_Q + wave * AT_QW;
    { const bf16* qg = WSP(const bf16, WS_Q) + (size_t)(qrow0 + qb * 32) * D + head * 128;
#pragma unroll
      for (int i = 0; i < 8; ++i) { const int id = lane + 64 * i, row = id >> 4, ch = id & 15; const v4u x = *(const GAS v4u*)(qg + (size_t)row * D + ch * 8); *(LAS v4u*)(lq + off_b(row, ch)) = x; } }
    const bf16* kg = WSP(const bf16, WS_K) + (size_t)krow0 * D + head * 128; const bf16* vg = WSP(const bf16, WS_V) + (size_t)krow0 * D + head * 128;
    const int srow0 = tid >> 4, sch = tid & 15;
    v4u pk0, pk1, pv0, pv1;
    pk0 = *(const GAS v4u*)(kg + (size_t)srow0 * D + sch * 8); pk1 = *(const GAS v4u*)(kg + (size_t)(srow0 + 32) * D + sch * 8);
    pv0 = *(const GAS v4u*)(vg + (size_t)srow0 * D + sch * 8); pv1 = *(const GAS v4u*)(vg + (size_t)(srow0 + 32) * D + sch * 8);
    f32x16 O[4];
#pragma unroll
    for (int e = 0; e < 4; ++e) O[e] = f32x16{};
    float mrun = -1e30f, lrun = 0.f;
    const int blk = (lane >> 4) & 1, q4 = (lane & 15) >> 2, p4 = lane & 3;
    for (int t = 0; t < nt; ++t) {
        __syncthreads();
        *(LAS v4u*)(lk + off_b(srow0, sch)) = pk0; *(LAS v4u*)(lk + off_b(srow0 + 32, sch)) = pk1;
        *(LAS v4u*)(lv + off_b(srow0, sch)) = pv0; *(LAS v4u*)(lv + off_b(srow0 + 32, sch)) = pv1;
        __syncthreads();
        if (t + 1 < nt) { const size_t o = (size_t)(t + 1) * 64 * D;
            pk0 = *(const GAS v4u*)(kg + o + (size_t)srow0 * D + sch * 8); pk1 = *(const GAS v4u*)(kg + o + (size_t)(srow0 + 32) * D + sch * 8);
            pv0 = *(const GAS v4u*)(vg + o + (size_t)srow0 * D + sch * 8); pv1 = *(const GAS v4u*)(vg + o + (size_t)(srow0 + 32) * D + sch * 8); }
        f32x16 S0 = f32x16{}, S1 = f32x16{};
#pragma unroll
        for (int ds = 0; ds < 4; ++ds) { const unsigned ch = (unsigned)(mp * 8 + ds * 2 + hi);
            const bf16x8 qf = *(const LAS bf16x8*)(lq + off_b(r32, ch));
            const bf16x8 k0 = *(const LAS bf16x8*)(lk + off_b(r32, ch)); const bf16x8 k1 = *(const LAS bf16x8*)(lk + off_b(r32 + 32, ch));
            S0 = __builtin_amdgcn_mfma_f32_32x32x16_bf16(k0, qf, S0, 0, 0, 0); S1 = __builtin_amdgcn_mfma_f32_32x32x16_bf16(k1, qf, S1, 0, 0, 0); }
        float mx = fmaxf(S0[0], S1[0]);
#pragma unroll
        for (int r = 1; r < 16; ++r) mx = fmaxf(mx, fmaxf(S0[r], S1[r]));
        mx = fmaxf(mx, __shfl_xor(mx, 32));
        const float mn = fmaxf(mrun, mx); const float alpha = __builtin_amdgcn_exp2f(mrun - mn);
        float rs = 0.f;
#pragma unroll
        for (int r = 0; r < 16; ++r) { S0[r] = __builtin_amdgcn_exp2f(S0[r] - mn); S1[r] = __builtin_amdgcn_exp2f(S1[r] - mn); rs += S0[r] + S1[r]; }
        mrun = mn; lrun = lrun * alpha + rs;
        if (!__all(alpha == 1.0f)) {
#pragma unroll
            for (int e = 0; e < 4; ++e) O[e] = O[e] * alpha; }
        bf16x8 P[4];
#pragma unroll
        for (int s = 0; s < 2; ++s) {
            v4u a, b;
            a.x = pkbf(S0[8 * s + 0], S0[8 * s + 1]); a.y = pkbf(S0[8 * s + 2], S0[8 * s + 3]); a.z = pkbf(S0[8 * s + 4], S0[8 * s + 5]); a.w = pkbf(S0[8 * s + 6], S0[8 * s + 7]);
            b.x = pkbf(S1[8 * s + 0], S1[8 * s + 1]); b.y = pkbf(S1[8 * s + 2], S1[8 * s + 3]); b.z = pkbf(S1[8 * s + 4], S1[8 * s + 5]); b.w = pkbf(S1[8 * s + 6], S1[8 * s + 7]);
            P[0 * 2 + s] = __builtin_bit_cast(bf16x8, a); P[1 * 2 + s] = __builtin_bit_cast(bf16x8, b); }
#pragma unroll
        for (int eb = 0; eb < 4; ++eb)
#pragma unroll
            for (int kb = 0; kb < 2; ++kb)
#pragma unroll
                for (int s = 0; s < 2; ++s) {
                    const unsigned rowa = (unsigned)(kb * 32 + 16 * s + 4 * hi + q4), chv = (unsigned)(4 * eb + 2 * blk + (p4 >> 1));
                    const s16x4 lo = tr16(lv + off_b(rowa, chv) + 8 * (p4 & 1)); const s16x4 hh = tr16(lv + off_b(rowa + 8, chv) + 8 * (p4 & 1));
                    const bf16x8 vf = (bf16x8){lo[0], lo[1], lo[2], lo[3], hh[0], hh[1], hh[2], hh[3]};
                    O[eb] = __builtin_amdgcn_mfma_f32_32x32x16_bf16(vf, P[kb * 2 + s], O[eb], 0, 0, 0); }
    }
    lrun += __shfl_xor(lrun, 32);
    LAS float* X = (LAS float*)(F.lds + (qb < 2 ? qb * 16384 : AT_Q + 4 * AT_QW + (qb - 2) * 16384));
    __syncthreads();
    if (mp == 1) {
        float s1 = 0.f, s2 = 0.f;
        for (int i = 0; i < 64; ++i) { s1 += A.in[11][i] * A.in[12][i]; s2 += A.in[13][i] * A.in[14][i]; }
        const float lam = expf(s1) - expf(s2) + LAM_INIT; const float sc = lam / lrun;
#pragma unroll
        for (int e = 0; e < 4; ++e)
#pragma unroll
            for (int r = 0; r < 16; ++r) X[(e * 32 + (r & 3) + 8 * (r >> 2) + 4 * hi) * 32 + r32] = O[e][r] * sc;
    }
    __syncthreads();
    if (mp == 0) {
        const float i0 = 1.f / lrun; float ss = 0.f;
#pragma unroll
        for (int e = 0; e < 4; ++e)
#pragma unroll
            for (int r = 0; r < 16; ++r) { const float o = O[e][r] * i0 - X[(e * 32 + (r & 3) + 8 * (r >> 2) + 4 * hi) * 32 + r32]; O[e][r] = o; ss += o * o; }
        ss += __shfl_xor(ss, 32);
        const float rstd = (1.f - LAM_INIT) / sqrtf(ss * (1.f / 128.f) + EPSN);
#pragma unroll
        for (int e = 0; e < 4; ++e)
#pragma unroll
            for (int g4 = 0; g4 < 4; ++g4) { const int e0 = e * 32 + 8 * g4 + 4 * hi; const f32x4 gg = *(const GAS f32x4*)(A.in[15] + e0);
                const unsigned w0 = pkbf(O[e][4 * g4 + 0] * rstd * gg.x, O[e][4 * g4 + 1] * rstd * gg.y), w1 = pkbf(O[e][4 * g4 + 2] * rstd * gg.z, O[e][4 * g4 + 3] * rstd * gg.w);
                *(LAS unsigned long long*)(lq + r32 * AT_OP + e0 * 2) = (unsigned long long)w0 | ((unsigned long long)w1 << 32); }
        LDS_WAIT(); asm volatile("" ::: "memory");
        { bf16* og = Obuf + (size_t)(qrow0 + qb * 32) * D + head * 128;
#pragma unroll
          for (int i = 0; i < 8; ++i) { const int id = lane + 64 * i, row = id >> 4, ch = id & 15; const v4u x = *(const LAS v4u*)(lq + row * AT_OP + ch * 16); *(GAS v4u*)(og + (size_t)row * D + ch * 8) = x; } }
        LDS_WAIT(); asm volatile("" ::: "memory");
    }
}

template <int L, int NB> __device__ __forceinline__ void hyena_unit(const Frame& F, const Args& A, int c) {
    constexpr int ROW0 = (L == LCTX) ? 0 : M_CTX, NTOK = NB * L, PITCH = L + 8, CP = 2 * L + 8, TW = (L / 16) / 8;
    constexpr int OFF_V = 8 * CP * 2, ARR = NB * PITCH * 2, OFF_Z = OFF_V + ARR, OFF_X1 = OFF_Z + ARR, OFF_X2 = OFF_X1 + ARR;
    static_assert(OFF_X2 + ARR <= RING_BYTES, "hyena LDS");
    int tid = F.tid; asm volatile("" : "+v"(tid));
    const int lane = tid & 63, wave = __builtin_amdgcn_readfirstlane(tid >> 6);
    LAS unsigned char* lds = F.lds;
#pragma unroll
    for (int p = 0; p < 3; ++p) {
        const bf16* src = WSP(const bf16, WS_UT) + (size_t)(p * DH + c) * MROWS + ROW0;
        const float w0 = A.in[16][p * DH + c], w1 = A.in[16][HYC + p * DH + c], w2 = A.in[16][2 * HYC + p * DH + c], bb = A.in[17][p * DH + c];
        LAS unsigned char* dst = lds + (p == 0 ? OFF_V : (p == 1 ? OFF_X1 : OFF_X2));
        for (int idx = tid; idx < NTOK / 8; idx += NWAVES * 64) { const int t8 = idx * 8, b = t8 / L, t = t8 % L;
            const v4u raw = *(const GAS v4u*)(src + t8);
            float x[10];
            x[0] = (t == 0) ? 0.f : bf2f(src[t8 - 1]); x[9] = (t + 8 == L) ? 0.f : bf2f(src[t8 + 8]);
            x[1] = __uint_as_float(raw.x << 16); x[2] = __uint_as_float(raw.x & 0xffff0000u); x[3] = __uint_as_float(raw.y << 16); x[4] = __uint_as_float(raw.y & 0xffff0000u);
            x[5] = __uint_as_float(raw.z << 16); x[6] = __uint_as_float(raw.z & 0xffff0000u); x[7] = __uint_as_float(raw.w << 16); x[8] = __uint_as_float(raw.w & 0xffff0000u);
            v4u o;
            o.x = pk2(w0 * x[0] + w1 * x[1] + w2 * x[2] + bb, w0 * x[1] + w1 * x[2] + w2 * x[3] + bb); o.y = pk2(w0 * x[2] + w1 * x[3] + w2 * x[4] + bb, w0 * x[3] + w1 * x[4] + w2 * x[5] + bb);
            o.z = pk2(w0 * x[4] + w1 * x[5] + w2 * x[6] + bb, w0 * x[5] + w1 * x[6] + w2 * x[7] + bb); o.w = pk2(w0 * x[6] + w1 * x[7] + w2 * x[8] + bb, w0 * x[7] + w1 * x[8] + w2 * x[9] + bb);
            *(LAS v4u*)(dst + (b * PITCH + t) * 2) = o; }
    }
    const float bias0 = A.in[24][c], bias1 = A.in[24][DH + c];
    const int tl = lane & 15, kg = lane >> 4, msh = (16 - tl) & 7;
#pragma unroll
    for (int ord = 0; ord < 2; ++ord) {
        { const bf16* R = WSP(const bf16, WS_FILT) + (L == LCTX ? 0 : (size_t)(MiB / 2)) + ((size_t)ord * DH + c) * (2 * L);
          for (int q = tid; q < 2 * L / 8; q += NWAVES * 64) {
              const v4u lo = *(const GAS v4u*)(R + 8 * q); v4u hi4 = (v4u){0u, 0u, 0u, 0u}; if (q + 1 < 2 * L / 8) hi4 = *(const GAS v4u*)(R + 8 * q + 8);
              const unsigned w[8] = {lo.x, lo.y, lo.z, lo.w, hi4.x, hi4.y, hi4.z, hi4.w};
#pragma unroll
              for (int m = 0; m < 8; ++m) { v4u o;
                  if (m & 1) { o.x = __builtin_amdgcn_alignbit(w[m / 2 + 1], w[m / 2], 16); o.y = __builtin_amdgcn_alignbit(w[m / 2 + 2], w[m / 2 + 1], 16); o.z = __builtin_amdgcn_alignbit(w[m / 2 + 3], w[m / 2 + 2], 16); o.w = __builtin_amdgcn_alignbit(w[m / 2 + 4], w[m / 2 + 3], 16); }
                  else { o.x = w[m / 2]; o.y = w[m / 2 + 1]; o.z = w[m / 2 + 2]; o.w = w[m / 2 + 3]; }
                  *(LAS v4u*)(lds + (m * CP + 8 * q) * 2) = o; } } }
        __syncthreads();
        pg8::f32x4 acc[TW];
#pragma unroll
        for (int i = 0; i < TW; ++i) acc[i] = (pg8::f32x4){0.f, 0.f, 0.f, 0.f};
        const LAS unsigned char* ub = lds + (ord == 0 ? OFF_V : OFF_Z) + ((lane & (NB - 1)) * PITCH + 8 * kg) * 2;
        const int tbase = wave * TW * 16;
        const LAS unsigned char* ab = lds + (msh * CP + (L - tbase - tl + 8 * kg - msh)) * 2;
#pragma unroll 2
        for (int ss = 0; ss < L / 32; ++ss) { const bf16x8 bfr = *(const LAS bf16x8*)(ub + ss * 64);
#pragma unroll
            for (int i = 0; i < TW; ++i) { const bf16x8 afr = *(const LAS bf16x8*)(ab + (ss * 32 - 16 * i) * 2);
                acc[i] = __builtin_amdgcn_mfma_f32_16x16x32_bf16(afr, bfr, acc[i], 0, 0, 0); } }
        const int b = tl;
        if (b < NB) {
#pragma unroll
            for (int i = 0; i < TW; ++i) { const int t = tbase + 16 * i + 4 * kg; const int eo = (b * PITCH + t) * 2;
                const unsigned long long uu = *(const LAS unsigned long long*)(lds + (ord == 0 ? OFF_V : OFF_Z) + eo), gg = *(const LAS unsigned long long*)(lds + (ord == 0 ? OFF_X1 : OFF_X2) + eo);
                const float bias = ord == 0 ? bias0 : bias1; float y[4];
#pragma unroll
                for (int r = 0; r < 4; ++r) { const float uv = __uint_as_float((unsigned)((uu >> (16 * r)) & 0xffffull) << 16), gv = __uint_as_float((unsigned)((gg >> (16 * r)) & 0xffffull) << 16);
                    y[r] = gv * (acc[i][r] + uv * bias); }
                if (ord == 0) *(LAS unsigned long long*)(lds + OFF_Z + eo) = (unsigned long long)pk2(y[0], y[1]) | ((unsigned long long)pk2(y[2], y[3]) << 32);
                else { bf16* og = WSP(bf16, WS_XN) + (size_t)(ROW0 + b * L + t) * DH + c;
#pragma unroll
                    for (int r = 0; r < 4; ++r) og[(size_t)r * DH] = (bf16)f2bf(y[r]); } }
        }
        __syncthreads();
    }
}

struct EpiT1 {
    static constexpr bool PERM = true, AFTER_DRAIN = false;
    const bf16* G; bf16* T1;
    __device__ __forceinline__ void operator()(const pg8::f32x4 (&acc)[2][2][4][2], const pg8::Unit& u, int wr, int wc, int fr, int fq) const {
        using pg8::f32x4; using pg8::u32x4;
        const int row0 = u.pm * 256 + wr * 64 + fr, col0 = u.pn * 256 + wc * 32 + 8 * fq;
#pragma unroll
        for (int ai = 0; ai < 2; ++ai)
#pragma unroll
            for (int m = 0; m < 4; ++m) { const int row = row0 + ai * 128 + m * 16;
#pragma unroll
                for (int bj = 0; bj < 2; ++bj) { const int col = col0 + bj * 128; const u32x4 g = *(const u32x4*)(G + (size_t)row * 2048 + col);
                    const f32x4 v0 = acc[ai][bj][m][0], v1 = acc[ai][bj][m][1]; u32x4 w;
                    w.x = pg8::cvt_pk_bf16(v0[0] * __uint_as_float(g.x << 16), v0[1] * __uint_as_float(g.x & 0xffff0000u)); w.y = pg8::cvt_pk_bf16(v0[2] * __uint_as_float(g.y << 16), v0[3] * __uint_as_float(g.y & 0xffff0000u));
                    w.z = pg8::cvt_pk_bf16(v1[0] * __uint_as_float(g.z << 16), v1[1] * __uint_as_float(g.z & 0xffff0000u)); w.w = pg8::cvt_pk_bf16(v1[2] * __uint_as_float(g.w << 16), v1[3] * __uint_as_float(g.w & 0xffff0000u));
                    *(u32x4*)(T1 + (size_t)row * D + col) = w; } }
    }
};
struct EpiMerge {
    static constexpr bool PERM = true, AFTER_DRAIN = false;
    const bf16* G; const bf16* T1; bf16* MG;
    __device__ __forceinline__ void operator()(const pg8::f32x4 (&acc)[2][2][4][2], const pg8::Unit& u, int wr, int wc, int fr, int fq) const {
        using pg8::f32x4; using pg8::u32x4;
        const int row0 = u.pm * 256 + wr * 64 + fr, col0 = u.pn * 256 + wc * 32 + 8 * fq;
#pragma unroll
        for (int ai = 0; ai < 2; ++ai)
#pragma unroll
            for (int m = 0; m < 4; ++m) { const int row = row0 + ai * 128 + m * 16;
#pragma unroll
                for (int bj = 0; bj < 2; ++bj) { const int col = col0 + bj * 128; const u32x4 g = *(const u32x4*)(G + (size_t)row * 2048 + 1024 + col); const u32x4 t = *(const u32x4*)(T1 + (size_t)row * D + col);
                    const f32x4 v0 = acc[ai][bj][m][0], v1 = acc[ai][bj][m][1]; u32x4 w;
                    w.x = pg8::cvt_pk_bf16(__uint_as_float(t.x << 16) + v0[0] * __uint_as_float(g.x << 16), __uint_as_float(t.x & 0xffff0000u) + v0[1] * __uint_as_float(g.x & 0xffff0000u));
                    w.y = pg8::cvt_pk_bf16(__uint_as_float(t.y << 16) + v0[2] * __uint_as_float(g.y << 16), __uint_as_float(t.y & 0xffff0000u) + v0[3] * __uint_as_float(g.y & 0xffff0000u));
                    w.z = pg8::cvt_pk_bf16(__uint_as_float(t.z << 16) + v1[0] * __uint_as_float(g.z << 16), __uint_as_float(t.z & 0xffff0000u) + v1[1] * __uint_as_float(g.z & 0xffff0000u));
                    w.w = pg8::cvt_pk_bf16(__uint_as_float(t.w << 16) + v1[2] * __uint_as_float(g.w << 16), __uint_as_float(t.w & 0xffff0000u) + v1[3] * __uint_as_float(g.w & 0xffff0000u));
                    *(u32x4*)(MG + (size_t)row * D + col) = w; } }
    }
};
struct EpiRes {
    static constexpr bool PERM = false, AFTER_DRAIN = false;
    const float* xa; const float* xb; const float* modf; int goff; float* out;
    __device__ __forceinline__ void operator()(const pg8::f32x4 (&acc)[2][2][4][2], const pg8::Unit& u, int wr, int wc, int fr, int fq) const {
        using pg8::f32x4;
        const int row0 = u.pm * 256 + wr * 64 + fr, col0 = u.pn * 256 + wc * 32 + 4 * fq; const int mr = u.pm < 16 ? 0 : 1 + ((u.pm - 16) >> 2);
        const float* gp = modf + (size_t)mr * 6144 + goff + col0; f32x4 gv[2][2];
#pragma unroll
        for (int bj = 0; bj < 2; ++bj)
#pragma unroll
            for (int n = 0; n < 2; ++n) gv[bj][n] = *(const f32x4*)(gp + bj * 128 + n * 16);
#pragma unroll
        for (int ai = 0; ai < 2; ++ai)
#pragma unroll
            for (int m = 0; m < 4; ++m) { const int row = row0 + ai * 128 + m * 16; const float* bp = (row < M_CTX ? xa + (size_t)row * D : xb + (size_t)(row - M_CTX) * D) + col0; float* op = out + (size_t)row * D + col0;
#pragma unroll
                for (int bj = 0; bj < 2; ++bj)
#pragma unroll
                    for (int n = 0; n < 2; ++n) { const f32x4 bs = *(const f32x4*)(bp + bj * 128 + n * 16); *(f32x4*)(op + bj * 128 + n * 16) = bs + gv[bj][n] * acc[ai][bj][m][n]; } }
    }
};
struct EpiUp {
    static constexpr bool PERM = true, AFTER_DRAIN = false;
    bf16* UP;
    __device__ __forceinline__ void operator()(const pg8::f32x4 (&acc)[2][2][4][2], const pg8::Unit& u, int wr, int wc, int fr, int fq) const {
        using pg8::f32x4; using pg8::u32x4;
        const int row0 = u.pm * 256 + wr * 64 + fr, col0 = u.pn * 256 + wc * 32 + 8 * fq;
#pragma unroll
        for (int ai = 0; ai < 2; ++ai)
#pragma unroll
            for (int m = 0; m < 4; ++m) { const int row = row0 + ai * 128 + m * 16;
#pragma unroll
                for (int bj = 0; bj < 2; ++bj) { f32x4 v0 = acc[ai][bj][m][0], v1 = acc[ai][bj][m][1];
#pragma unroll
                    for (int e = 0; e < 4; ++e) { const float a = fmaxf(v0[e], 0.f), b = fmaxf(v1[e], 0.f); v0[e] = a * a; v1[e] = b * b; }
                    u32x4 w; w.x = pg8::cvt_pk_bf16(v0[0], v0[1]); w.y = pg8::cvt_pk_bf16(v0[2], v0[3]); w.z = pg8::cvt_pk_bf16(v1[0], v1[1]); w.w = pg8::cvt_pk_bf16(v1[2], v1[3]);
                    *(u32x4*)(UP + (size_t)row * FF + col0 + bj * 128) = w; } }
    }
};
__device__ __forceinline__ void final_norm_rows(const Frame& F, const Args& A) {
    const int gw = F.vcu * NWAVES + F.wave, NGW = F.G * NWAVES, lane = F.lane;
    f32x4 gv[4];
#pragma unroll
    for (int j = 0; j < 4; ++j) gv[j] = *(const GAS f32x4*)(A.in[30] + 4 * lane + 256 * j);
    for (int row = gw; row < MROWS; row += NGW) { float* xr = F.out + (size_t)row * D; f32x4 v[4]; float s = 0.f;
#pragma unroll
        for (int j = 0; j < 4; ++j) { v[j] = *(const GAS f32x4*)(xr + 4 * lane + 256 * j); s += (v[j].x * v[j].x + v[j].y * v[j].y) + (v[j].z * v[j].z + v[j].w * v[j].w); }
        const float rstd = 1.f / sqrtf(wave_sum(s) * (1.f / D) + EPSN);
#pragma unroll
        for (int j = 0; j < 4; ++j) *(GAS f32x4*)(xr + 4 * lane + 256 * j) = v[j] * rstd * gv[j]; }
}

#ifndef MK_DEBUG
#define MK_DEBUG 0
#endif
__global__ void __launch_bounds__(NWAVES * 64, 2) mk_fwd(Args args) {
    extern __shared__ __attribute__((aligned(16))) unsigned char lds[];
    Frame F;
    F.lds = (LAS unsigned char*)lds; F.MISC = (volatile LAS unsigned*)(F.lds + MISC_OFF);
    F.tid = threadIdx.x; F.lane = F.tid & 63; F.wave = __builtin_amdgcn_readfirstlane(F.tid >> 6);
    F.G = gridDim.x; { const int bx = blockIdx.x; F.vcu = (F.G % 8 == 0) ? (bx % 8) * (F.G / 8) + bx / 8 : bx; }
    F.ws = args.ws; F.out = args.out; F.ctl = (gu32*)(args.ws + WS_CTL);
    const Args& A = args;
    for (int u = F.tid; u < (LDS_BYTES - LDSCTL_OFF) / 4; u += NWAVES * 64) ((LAS unsigned*)(F.lds + LDSCTL_OFF))[u] = 0u;
    __syncthreads();
    XcdBarrier bar = xcd_barrier_post((unsigned*)(F.ctl + CW_BAR), F.MISC + 8);
    const int stop = args.stop_after;
#define GRID_BAR() xcd_barrier(bar)
#define STOP_IF(k) do { if (MK_DEBUG && stop == (k)) return; } while (0)
#define PHASE_BEGIN() do { int t_ = threadIdx.x; asm volatile("" : "+v"(t_)); F.tid = t_; F.lane = t_ & 63; } while (0)

    PHASE_BEGIN(); p0_prologue(F, A);
    GRID_BAR(); STOP_IF(0);
    PHASE_BEGIN(); modnorm_rows(F, A, 0);
    GRID_BAR(); STOP_IF(1);
    {
        pg8::Gemm g{WSP(const pg8::bf16_t, WS_XN), WSP(const pg8::bf16_t, WS_WIN), MROWS, INC, D}; pg8::StaticOrder S; S.init(MROWS, INC, F.G, (int)blockIdx.x);
        EpiIn E{WSP(bf16, WS_Q), WSP(bf16, WS_K), WSP(bf16, WS_V), WSP(bf16, WS_UT), WSP(bf16, WS_G), F.out + (size_t)MROWS * D, F.out + (size_t)MROWS * D + (size_t)M_CTX * D, WSP(const float, WS_ROPE)};
        pg8::gemm_phase<EpiIn, pg8::StaticOrder, true, true>(F.lds + RING_OFF, g, S, E);
    }
    GRID_BAR(); STOP_IF(2);
    {
        PHASE_BEGIN();
        bf16* Obuf = (MK_DEBUG && stop == 3) ? (bf16*)(F.ws + WS_END) : WSP(bf16, WS_Q);
        volatile LAS unsigned* qslot = (volatile LAS unsigned*)(F.lds + LDSCTL_OFF + 64);
        constexpr int NU = 512 + 512 + 256 + 512;
        for (;;) {
            __syncthreads();
            if (F.tid == 0) *qslot = __hip_atomic_fetch_add((unsigned*)(F.ctl + CW_QUEUE), 1u, __ATOMIC_RELAXED, __HIP_MEMORY_SCOPE_AGENT);
            __syncthreads();
            const int id = __builtin_amdgcn_readfirstlane((int)*qslot);
            if (id >= NU) break;
            if (id < 512) { const int b = id >> 6, head = (id >> 3) & 7, qb = id & 7; attn_unit(F, A, Obuf, M_CTX + b * LLAT + qb * 128, M_CTX + b * LKLAT, LKLAT / 64, head); }
            else if (id < 1024) hyena_unit<LLAT, 8>(F, A, id - 512);
            else if (id < 1280) { const int j = id - 1024, s = j >> 4, head = (j >> 1) & 7, qb = j & 1; attn_unit(F, A, Obuf, s * 256 + qb * 128, s * 256, LCTX / 64, head); }
            else hyena_unit<LCTX, 16>(F, A, id - 1280);
        }
    }
    GRID_BAR(); STOP_IF(3);
    {
        pg8::StaticOrder S; S.init(MROWS, D, F.G, (int)blockIdx.x);
        { pg8::Gemm g{WSP(const pg8::bf16_t, WS_Q), WSP(const pg8::bf16_t, WS_WA), MROWS, D, D}; EpiT1 E{WSP(const bf16, WS_G), WSP(bf16, WS_V)};
          pg8::gemm_phase<EpiT1, pg8::StaticOrder, true, true>(F.lds + RING_OFF, g, S, E); }
        { pg8::Gemm g{WSP(const pg8::bf16_t, WS_XN), WSP(const pg8::bf16_t, WS_WH), MROWS, D, DH}; EpiMerge E{WSP(const bf16, WS_G), WSP(const bf16, WS_V), WSP(bf16, WS_K)};
          pg8::gemm_phase<EpiMerge, pg8::StaticOrder, true, true>(F.lds + RING_OFF, g, S, E); }
    }
    GRID_BAR(); STOP_IF(4);
    {
        pg8::Gemm g{WSP(const pg8::bf16_t, WS_K), WSP(const pg8::bf16_t, WS_WO), MROWS, D, D}; pg8::StaticOrder S; S.init(MROWS, D, F.G, (int)blockIdx.x);
        EpiRes E{A.in[0], A.in[1], WSP(const float, WS_MODF), 2048, F.out};
        pg8::gemm_phase<EpiRes, pg8::StaticOrder, true, true>(F.lds + RING_OFF, g, S, E);
    }
    GRID_BAR(); STOP_IF(5);
    PHASE_BEGIN(); modnorm_rows(F, A, 1);
    GRID_BAR(); STOP_IF(6);
    {
        pg8::Gemm g{WSP(const pg8::bf16_t, WS_XN), WSP(const pg8::bf16_t, WS_WUP), MROWS, FF, D}; pg8::StaticOrder S; S.init(MROWS, FF, F.G, (int)blockIdx.x);
        EpiUp E{WSP(bf16, WS_UP)};
        pg8::gemm_phase<EpiUp, pg8::StaticOrder, true, true>(F.lds + RING_OFF, g, S, E);
    }
    GRID_BAR(); STOP_IF(7);
    {
        pg8::Gemm g{WSP(const pg8::bf16_t, WS_UP), WSP(const pg8::bf16_t, WS_WDN), MROWS, D, FF}; pg8::StaticOrder S; S.init(MROWS, D, F.G, (int)blockIdx.x);
        EpiRes E{F.out, F.out + (size_t)M_CTX * D, WSP(const float, WS_MODF), 5120, F.out};
        pg8::gemm_phase<EpiRes, pg8::StaticOrder, true, true>(F.lds + RING_OFF, g, S, E);
    }
    GRID_BAR(); STOP_IF(8);
    PHASE_BEGIN(); final_norm_rows(F, A);

}

#if MK_DEBUG

#endif
extern "C" void kernel_launch(void* const* d_in, const int* in_sizes, int n_in, void* d_out, int out_size, void* d_ws, size_t ws_size, hipStream_t stream) {
    static int grid = 0;
    if (grid == 0) {
        if (n_in != 31 || out_size != MROWS * D + 2 * M_CTX * D || ws_size < WS_END) { fprintf(stderr, "kernel_launch: unexpected shapes (n_in %d out %d ws %zu)\n", n_in, out_size, ws_size); grid = -1; return; }
        int dev = 0, cus = 0;
        if (hipGetDevice(&dev) != hipSuccess || hipDeviceGetAttribute(&cus, hipDeviceAttributeMultiprocessorCount, dev) != hipSuccess) { grid = -1; return; }
        if (hipFuncSetAttribute((const void*)mk_fwd, hipFuncAttributeMaxDynamicSharedMemorySize, LDS_BYTES) != hipSuccess) { fprintf(stderr, "kernel_launch: hipFuncSetAttribute failed\n"); grid = -1; return; }
        int per_cu = 0;
        if (hipOccupancyMaxActiveBlocksPerMultiprocessor(&per_cu, (const void*)mk_fwd, NWAVES * 64, LDS_BYTES) != hipSuccess || per_cu < 1) { fprintf(stderr, "kernel_launch: occupancy query says %d\n", per_cu); }
        (void)hipGetLastError();
        grid = cus;
    }
    if (grid < 0) return;
    if (hipMemsetAsync((char*)d_ws + WS_CTL, 0, CTL_ZERO_BYTES, stream) != hipSuccess) return;
    Args a{};
    for (int i = 0; i < 31; ++i) a.in[i] = (const float*)d_in[i];
    a.out = (float*)d_out; a.ws = (unsigned char*)d_ws; a.stop_after = MK_STOP; a.pad = 0;
    hipLaunchKernelGGL(mk_fwd, dim3(grid), dim3(NWAVES * 64), LDS_BYTES, stream, a);
#if MK_DEBUG
    dbg_run(a, stream);
#endif
}
```

```cpp
#include <hip/hip_runtime.h>
#include <cstdio>
#include <cstdint>


#define MK_DEBUG 0
#define MK_STOP -1

namespace pg8 {
#define PG8_LAS __attribute__((address_space(3)))
typedef unsigned short bf16_t;
typedef short bf16x8 __attribute__((ext_vector_type(8)));
typedef float f32x4 __attribute__((ext_vector_type(4)));
typedef unsigned u32x4 __attribute__((ext_vector_type(4)));
constexpr int BM = 256, BK = 64, HALF = 128, HTB = HALF * BK * 2  , STAGE_BYTES = 8 * HTB, NXCD = 8, WGM = 8;

__host__ __device__ __forceinline__ int lds_byte(int r, int c) { const int st = (r >> 4) * 2 + (c >> 5), rr = r & 15, cc = c & 31, ob = rr * 64 + cc * 2; return st * 1024 + (ob ^ (((ob >> 9) & 1) << 5)); }
__host__ __device__ __forceinline__ void stage_rc(int b, int& R, int& C) { const int st = b / 1024, sb = b % 1024, swz = sb ^ (((sb >> 9) & 1) << 5); R = (st >> 1) * 16 + swz / 64; C = (st & 1) * 32 + (swz % 64) / 2; }
__host__ __device__ __forceinline__ int perm32(int rho) { const int n = rho >> 4, i = rho & 15; return 8 * (i >> 2) + 4 * n + (i & 3); }

struct Unit { int pm, pn; };
struct Gemm { const bf16_t* A; const bf16_t* Bt; int M, N, K; };

struct StaticOrder {
    int nM, nN, nwg, G, c;
    __host__ __device__ void init(int M, int N, int G_, int c_) { nM = M / BM; nN = N / BM; nwg = nM * nN; G = G_; c = c_; }
    __host__ __device__ bool next(int i, Unit& u) const {
        const long L = (long)i * G + c; if (L >= nwg) return false;
        int wgid = (int)L; { const int q = nwg / NXCD, r = nwg % NXCD, xcd = wgid % NXCD, off = wgid / NXCD; wgid = (xcd < r ? xcd * (q + 1) : r * (q + 1) + (xcd - r) * q) + off; }
        const int nig = WGM * nN, gid = wgid / nig, fm = gid * WGM, gsz = (nM - fm) < WGM ? (nM - fm) : WGM;
        u.pm = fm + ((wgid % nig) % gsz); u.pn = (wgid % nig) / gsz; return true;
    }
    __device__ __forceinline__ void a_ready(const Unit&) const {}
    __device__ __forceinline__ void done(const Unit&) const {}
};

__device__ __forceinline__ unsigned cvt_pk_bf16(float lo, float hi) { unsigned r; asm volatile("v_cvt_pk_bf16_f32 %0, %1, %2" : "=v"(r) : "v"(lo), "v"(hi)); return r; }
typedef float f32x2 __attribute__((ext_vector_type(2)));

template <class Epi, class Sched, bool ALIGN_EPI = false, bool SP2 = false>
__device__ __forceinline__ void gemm_phase(PG8_LAS unsigned char* lds, const Gemm g, const Sched& S, const Epi& E) {
    int tid_ = threadIdx.x; asm volatile("" : "+v"(tid_));
    const int tid = tid_, wid = __builtin_amdgcn_readfirstlane(tid >> 6), lane = tid & 63, wr = wid >> 2, wc = wid & 3, fr = lane & 15, fq = lane >> 4;
    const int K = g.K, nt = K / BK;
    unsigned voffA[2], voffB[2];
#pragma unroll
    for (int i = 0; i < 2; ++i) { int R, C; stage_rc(tid * 16 + i * 8192, R, C); const int Rb = Epi::PERM ? ((R & ~31) + perm32(R & 31)) : R;
        voffA[i] = (unsigned)(R * K + C) * 2u; voffB[i] = (unsigned)(Rb * K + C) * 2u; }
    const size_t kstep = (size_t)(BK * 2);
    const size_t hstep = (size_t)HALF * K * 2;
    const size_t tstep = 2 * hstep;
    const unsigned ldsw = (unsigned)wid * 1024u;
    const int aoff = lds_byte(wr * 64 + fr, fq * 8), boff = lds_byte(wc * 32 + fr, fq * 8);
#define PG8_SA(b, h) (((b) * 2 + (h)) * HTB)
#define PG8_SB(b, h) ((4 + (b) * 2 + (h)) * HTB)
#define PG8_STAGE(bufoff, gbase, voff) do { _Pragma("unroll") for (int _i = 0; _i < 2; ++_i) \
        __builtin_amdgcn_global_load_lds((const unsigned*)((const char*)(gbase) + (voff)[_i]), (PG8_LAS unsigned*)(lds + (bufoff) + ldsw + _i * 8192), 16, 0, 0); } while (0)
#define PG8_LDA(dst, b, h) do { _Pragma("unroll") for (int m = 0; m < 4; ++m) _Pragma("unroll") for (int k = 0; k < 2; ++k) dst[m][k] = *(const PG8_LAS bf16x8*)(lds + PG8_SA(b, h) + aoff + m * 2048 + k * 1024); } while (0)
#define PG8_LDB(dst, b, h) do { _Pragma("unroll") for (int n = 0; n < 2; ++n) _Pragma("unroll") for (int k = 0; k < 2; ++k) dst[n][k] = *(const PG8_LAS bf16x8*)(lds + PG8_SB(b, h) + boff + n * 2048 + k * 1024); } while (0)
#define PG8_MMA(ai, bj, At, Bt) do { __builtin_amdgcn_s_setprio(1); _Pragma("unroll") for (int m = 0; m < 4; ++m) _Pragma("unroll") for (int n = 0; n < 2; ++n) _Pragma("unroll") for (int k = 0; k < 2; ++k) \
        acc[ai][bj][m][n] = __builtin_amdgcn_mfma_f32_16x16x32_bf16(Bt[n][k], At[m][k], acc[ai][bj][m][n], 0, 0, 0); __builtin_amdgcn_s_setprio(0); } while (0)
#define PG8_WAIT_V(n) asm volatile("s_waitcnt vmcnt(" #n ")" ::: "memory")
#define PG8_WAIT_L(n) asm volatile("s_waitcnt lgkmcnt(" #n ")" ::: "memory")
#define PG8_BAR __builtin_amdgcn_s_barrier()
#define PG8_SCHED __builtin_amdgcn_sched_barrier(0)
    Unit cur, nxt; int ui = 0;
    if (!S.next(0, cur)) return;
    f32x4 acc[2][2][4][2];
#pragma unroll
    for (int a = 0; a < 2; ++a)
#pragma unroll
        for (int b = 0; b < 2; ++b)
#pragma unroll
            for (int m = 0; m < 4; ++m)
#pragma unroll
                for (int n = 0; n < 2; ++n) acc[a][b][m][n] = (f32x4){0.f, 0.f, 0.f, 0.f};
    bf16x8 At[4][2], B0[2][2], B1[2][2];
    const char* cA = (const char*)g.A + (size_t)cur.pm * tstep; const char* cB = (const char*)g.Bt + (size_t)cur.pn * tstep;
    S.a_ready(cur);
    if constexpr (SP2) {
        PG8_STAGE(PG8_SB(0, 0), cB, voffB); PG8_STAGE(PG8_SB(0, 1), cB + hstep, voffB); PG8_STAGE(PG8_SA(0, 0), cA, voffA); PG8_STAGE(PG8_SA(0, 1), cA + hstep, voffA);
        if (wr == 1) PG8_BAR;
        PG8_WAIT_V(2); PG8_BAR;
        PG8_STAGE(PG8_SB(1, 0), cB + kstep, voffB); PG8_STAGE(PG8_SA(1, 0), cA + kstep, voffA); PG8_STAGE(PG8_SB(1, 1), cB + hstep + kstep, voffB);
        PG8_WAIT_V(6); PG8_BAR;
    } else {
        PG8_STAGE(PG8_SB(0, 0), cB, voffB); PG8_STAGE(PG8_SA(0, 0), cA, voffA); PG8_STAGE(PG8_SB(0, 1), cB + hstep, voffB); PG8_STAGE(PG8_SA(0, 1), cA + hstep, voffA);
        if (wr == 1) PG8_BAR;
        PG8_WAIT_V(4); PG8_BAR;
        PG8_STAGE(PG8_SB(1, 0), cB + kstep, voffB); PG8_STAGE(PG8_SA(1, 0), cA + kstep, voffA); PG8_STAGE(PG8_SB(1, 1), cB + hstep + kstep, voffB);
        PG8_WAIT_V(6); PG8_BAR;
    }
    for (;;) {
        const bool has_next = S.next(ui + 1, nxt);
        const char* nA = has_next ? (const char*)g.A + (size_t)nxt.pm * tstep : cA; const char* nB = has_next ? (const char*)g.Bt + (size_t)nxt.pn * tstep : cB;
        for (int t = 0; t < nt; t += 2) {
            const bool last = (t == nt - 2);
            const char* a1 = cA + (size_t)(t + 1) * kstep;
            const char* a2 = last ? nA : cA + (size_t)(t + 2) * kstep; const char* b2 = last ? nB : cB + (size_t)(t + 2) * kstep;
            const char* a3 = a2 + kstep; const char* b3 = b2 + kstep;
            if (last && has_next) S.a_ready(nxt);
            if constexpr (SP2) {
            PG8_LDB(B0, 0, 0); PG8_LDB(B1, 0, 1); PG8_SCHED; PG8_LDA(At, 0, 0); PG8_STAGE(PG8_SA(1, 1), a1 + hstep, voffA);
            PG8_WAIT_V(8); PG8_WAIT_L(0); PG8_BAR; PG8_MMA(0, 0, At, B0); PG8_MMA(0, 1, At, B1); PG8_BAR; PG8_SCHED;
            PG8_LDA(At, 0, 1); PG8_STAGE(PG8_SB(0, 0), b2, voffB); PG8_STAGE(PG8_SB(0, 1), b2 + hstep, voffB); PG8_STAGE(PG8_SA(0, 0), a2, voffA);
            PG8_WAIT_V(8); PG8_WAIT_L(0); PG8_BAR; PG8_MMA(1, 0, At, B0); PG8_MMA(1, 1, At, B1); PG8_BAR; PG8_SCHED;
            PG8_LDB(B0, 1, 0); PG8_LDB(B1, 1, 1); PG8_SCHED; PG8_LDA(At, 1, 0); PG8_STAGE(PG8_SA(0, 1), a2 + hstep, voffA);
            PG8_WAIT_V(8); PG8_WAIT_L(0); PG8_BAR; PG8_MMA(0, 0, At, B0); PG8_MMA(0, 1, At, B1); PG8_BAR; PG8_SCHED;
            PG8_LDA(At, 1, 1); PG8_STAGE(PG8_SB(1, 0), b3, voffB); PG8_STAGE(PG8_SB(1, 1), b3 + hstep, voffB); PG8_STAGE(PG8_SA(1, 0), a3, voffA);
            PG8_WAIT_V(8); PG8_WAIT_L(0); PG8_BAR; PG8_MMA(1, 0, At, B0); PG8_MMA(1, 1, At, B1); PG8_BAR; PG8_SCHED;
            } else {
            PG8_LDB(B0, 0, 0); PG8_SCHED; PG8_LDA(At, 0, 0); PG8_STAGE(PG8_SA(1, 1), a1 + hstep, voffA);
            PG8_WAIT_L(8); PG8_BAR; PG8_WAIT_L(0); PG8_MMA(0, 0, At, B0); PG8_BAR; PG8_SCHED;
            PG8_LDB(B1, 0, 1); PG8_STAGE(PG8_SB(0, 0), b2, voffB);
            PG8_BAR; PG8_WAIT_L(0); PG8_MMA(0, 1, At, B1); PG8_BAR;
            PG8_LDA(At, 0, 1); PG8_STAGE(PG8_SA(0, 0), a2, voffA);
            PG8_BAR; PG8_WAIT_L(0); PG8_MMA(1, 0, At, B0); PG8_BAR; PG8_SCHED;
            PG8_STAGE(PG8_SB(0, 1), b2 + hstep, voffB);
            PG8_WAIT_V(6); PG8_BAR; PG8_MMA(1, 1, At, B1); PG8_BAR;
            PG8_LDB(B0, 1, 0); PG8_SCHED; PG8_LDA(At, 1, 0); PG8_STAGE(PG8_SA(0, 1), a2 + hstep, voffA);
            PG8_WAIT_L(8); PG8_BAR; PG8_WAIT_L(0); PG8_MMA(0, 0, At, B0); PG8_BAR; PG8_SCHED;
            PG8_LDB(B1, 1, 1); PG8_STAGE(PG8_SB(1, 0), b3, voffB);
            PG8_BAR; PG8_WAIT_L(0); PG8_MMA(0, 1, At, B1); PG8_BAR;
            PG8_LDA(At, 1, 1); PG8_STAGE(PG8_SA(1, 0), a3, voffA);
            PG8_BAR; PG8_WAIT_L(0); PG8_MMA(1, 0, At, B0); PG8_BAR; PG8_SCHED;
            PG8_STAGE(PG8_SB(1, 1), b3 + hstep, voffB);
            PG8_WAIT_V(6); PG8_BAR; PG8_MMA(1, 1, At, B1); PG8_BAR;
            }
        }
        if constexpr (ALIGN_EPI) { if (wr == 0) PG8_BAR; }
        if constexpr (!Epi::AFTER_DRAIN) { E(acc, cur, wr, wc, fr, fq); S.done(cur); }
        if (!has_next) break;
#pragma unroll
        for (int a = 0; a < 2; ++a)
#pragma unroll
            for (int b = 0; b < 2; ++b)
#pragma unroll
                for (int m = 0; m < 4; ++m)
#pragma unroll
                    for (int n = 0; n < 2; ++n) acc[a][b][m][n] = (f32x4){0.f, 0.f, 0.f, 0.f};
        cur = nxt; cA = nA; cB = nB; ++ui;
        if constexpr (ALIGN_EPI) { if (wr == 1) PG8_BAR; }
    }
    PG8_WAIT_V(0);
    if constexpr (!ALIGN_EPI) { if (wr == 0) PG8_BAR; }
    PG8_BAR;
    if constexpr (Epi::AFTER_DRAIN) { E.fused(acc, cur, wr, wc, fr, fq, lds, wid, lane); S.done(cur); }
#undef PG8_SA
#undef PG8_SB
#undef PG8_STAGE
#undef PG8_LDA
#undef PG8_LDB
#undef PG8_MMA
#undef PG8_WAIT_V
#undef PG8_WAIT_L
#undef PG8_BAR
#undef PG8_SCHED
}
}

constexpr bool PG8_SP2 = true, PG8_ALIGN = true;

#define GAS __attribute__((address_space(1)))
#define LAS __attribute__((address_space(3)))
typedef unsigned short bf16;
typedef unsigned v4u __attribute__((ext_vector_type(4)));
typedef float f32x4 __attribute__((ext_vector_type(4)));
typedef short bf16x8 __attribute__((ext_vector_type(8)));
typedef GAS unsigned gu32;
typedef GAS unsigned long long gu64;
#define RLX_AGENT __ATOMIC_RELAXED, __HIP_MEMORY_SCOPE_AGENT
#define LDS_WAIT() asm volatile("s_waitcnt lgkmcnt(0)" ::: "memory")
#define VM_WAIT() asm volatile("s_waitcnt vmcnt(0)" ::: "memory")
__device__ __forceinline__ unsigned long long rt() { return __builtin_amdgcn_s_memrealtime(); }
__device__ __forceinline__ unsigned f2bf(float f) { unsigned u = __builtin_bit_cast(unsigned, f); return (u + 0x7fffu + ((u >> 16) & 1u)) >> 16; }
__device__ __forceinline__ unsigned pk2(float lo, float hi) { return f2bf(lo) | (f2bf(hi) << 16); }

#define XB_TMO      128
#define XB_XCNT(j)  (256  + 64 * (j))
#define XB_XSUB(j)  (1280 + 64 * (j))
#define XB_XGEN(j)  (2304 + 64 * (j))
#define XB_TOP      3328
#define XB_TOPGEN   3392
#define XCD_BAR_WORDS 3456
#define XB_SPIN_CAP (1u << 18)

__device__ __forceinline__ unsigned xb_ld(unsigned* p)              { return __hip_atomic_load(p, __ATOMIC_RELAXED, __HIP_MEMORY_SCOPE_AGENT); }
__device__ __forceinline__ unsigned xb_add(unsigned* p, unsigned v) { return __hip_atomic_fetch_add(p, v, __ATOMIC_RELAXED, __HIP_MEMORY_SCOPE_AGENT); }
__device__ __forceinline__ unsigned xb_xcc_id() { return (unsigned)__builtin_amdgcn_s_getreg((3 << 11) | 20) & 0xFu; }
#define XB_SPIN(cond, bar) do { unsigned _sp = 0; while (cond) { __builtin_amdgcn_s_sleep(1); \
    if ((++_sp & 255u) == 0u) { if (xb_ld(&(bar)[XB_TMO])) break; if (_sp > XB_SPIN_CAP) { atomicAdd(&(bar)[XB_TMO], 1u); break; } } } } while (0)

struct XcdBarrier {
    unsigned* bar; unsigned x;
    volatile LAS unsigned* st;
};

__device__ __forceinline__ XcdBarrier xcd_barrier_post(unsigned* bar, volatile LAS unsigned* st) {
    XcdBarrier b; b.bar = bar; b.x = xb_xcc_id(); b.st = st;
    if (threadIdx.x == 0) (void)xb_add(&bar[XB_XCNT(b.x)], 1u);
    return b;
}
__device__ __forceinline__ void xcd_barrier_complete(unsigned* bar, unsigned x, unsigned& nloc, unsigned& nx) {
    const unsigned G = gridDim.x * gridDim.y * gridDim.z;
    unsigned sum, cnt, mine, sp = 0u;
    for (;;) {
        sum = 0u; cnt = 0u; mine = 0u;
#pragma unroll
        for (unsigned j = 0; j < 16; ++j) { const unsigned c = xb_ld(&bar[XB_XCNT(j)]); sum += c; cnt += (c > 0u) ? 1u : 0u; mine = (j == x) ? c : mine; }
        if (sum == G) break;
        __builtin_amdgcn_s_sleep(1);
        if ((++sp & 255u) == 0u) { if (xb_ld(&bar[XB_TMO])) break; if (sp > XB_SPIN_CAP) { atomicAdd(&bar[XB_TMO], 1u); break; } }
    }
    nloc = mine > 0u ? mine : 1u; nx = cnt > 0u ? cnt : 1u;
}

__device__ __forceinline__ void xcd_barrier(const XcdBarrier& b) {
    asm volatile("s_waitcnt vmcnt(0)" ::: "memory");
    __syncthreads();
    if (threadIdx.x == 0) {
        unsigned* bar = b.bar;
        __builtin_amdgcn_s_waitcnt(0);
        unsigned nloc = b.st[0], nx = b.st[1];
        if (nloc == 0u) { xcd_barrier_complete(bar, b.x, nloc, nx); b.st[0] = nloc; b.st[1] = nx; }
        const unsigned old = xb_add(&bar[XB_XSUB(b.x)], 1u);
        const unsigned gen = old / nloc;
        if (old + 1u == (gen + 1u) * nloc) {
            __builtin_amdgcn_fence(__ATOMIC_RELEASE, "agent");
            asm volatile("s_waitcnt vmcnt(0)" ::: "memory");
            const unsigned og = xb_add(&bar[XB_TOP], 1u);
            const unsigned tg = og / nx;
            if (og + 1u == (tg + 1u) * nx) xb_add(&bar[XB_TOPGEN], 1u);
            else XB_SPIN(xb_ld(&bar[XB_TOPGEN]) == tg, bar);
            __builtin_amdgcn_fence(__ATOMIC_ACQUIRE, "agent");
            xb_add(&bar[XB_XGEN(b.x)], 1u);
            asm volatile("s_waitcnt vmcnt(0)" ::: "memory");
        } else {
            XB_SPIN(xb_ld(&bar[XB_XGEN(b.x)]) == gen, bar);
            __builtin_amdgcn_fence(__ATOMIC_ACQUIRE, "agent");
            asm volatile("s_waitcnt vmcnt(0)" ::: "memory");
        }
    }
    __syncthreads();
}

__device__ __forceinline__ float wave_sum(float v) {
#pragma unroll
    for (int o = 1; o < 64; o <<= 1) v += __shfl_xor(v, o);
    return v;
}
__device__ __forceinline__ void p0_transpose_item(const float* W, int K, int N, bf16* WT, int row_off, LAS float* scr, int item, int lane) {
    const int nblk = N / 32, kb = item / nblk, nb = item % nblk, k0 = 64 * kb, n0 = 32 * nb;
    float tv[32];
#pragma unroll
    for (int i = 0; i < 32; ++i) tv[i] = W[(size_t)(k0 + 2 * i + (lane >> 5)) * N + n0 + (lane & 31)];
#pragma unroll
    for (int i = 0; i < 32; ++i) scr[(2 * i + (lane >> 5)) * 33 + (lane & 31)] = tv[i];
    LDS_WAIT(); asm volatile("" ::: "memory");
    const int c = lane & 7;
#pragma unroll
    for (int j = 0; j < 4; ++j) { const int n = (lane >> 3) + 8 * j; const LAS float* s = scr + (8 * c) * 33 + n;
        v4u o; o.x = pk2(s[0 * 33], s[1 * 33]); o.y = pk2(s[2 * 33], s[3 * 33]); o.z = pk2(s[4 * 33], s[5 * 33]); o.w = pk2(s[6 * 33], s[7 * 33]);
        *(GAS v4u*)(WT + (size_t)(row_off + n0 + n) * K + k0 + 8 * c) = o; }
    LDS_WAIT(); asm volatile("" ::: "memory");
}

constexpr int NWAVES = 8;
constexpr int D = 1024, M_CTX = 4096, M_LAT = 8192, MROWS = 12288, INC = 6656, FF = 4096, DH = 512, HYC = 1536;
constexpr int LCTX = 256, LLAT = 1024, PAST = 256, LKLAT = 1280, KROWS = M_CTX + 8 * LKLAT;
constexpr float EPSN = 1e-6f, LAM_INIT = 0.2f;
constexpr float QSCALE = 0.125f * 1.4426950408889634f;
constexpr size_t MiB = 1u << 20;
constexpr size_t WS_CTL = 0, CTL_ZERO_BYTES = 1 * MiB;
constexpr size_t WS_WIN = 1 * MiB, WS_WA = 14 * MiB, WS_WH = 16 * MiB, WS_WO = 17 * MiB, WS_WUP = 19 * MiB, WS_WDN = 27 * MiB;
constexpr size_t WS_MODP = 35 * MiB;
constexpr size_t WS_MODF = 37 * MiB;
constexpr size_t WS_ROPE = 38 * MiB;
constexpr size_t WS_H2 = 38 * MiB + 65536;
constexpr size_t WS_FILT = 39 * MiB;
constexpr size_t WS_XN = 44 * MiB;
constexpr size_t WS_Q = 68 * MiB;
constexpr size_t WS_K = 92 * MiB;
constexpr size_t WS_V = 120 * MiB;
constexpr size_t WS_UT = 148 * MiB;
constexpr size_t WS_G = 184 * MiB;
constexpr size_t WS_UP = 68 * MiB;
constexpr size_t WS_O = 232 * MiB;
constexpr size_t WS_END = 256 * MiB;
constexpr int CW_TMO = 0, CW_CODE = 1, CW_QUEUE = 64, CW_BAR = 4096;
constexpr int DBG_WORDS = 8192, TS_WORDS = 12288;
constexpr int RING_OFF = 0, RING_BYTES = 131072, LDSCTL_OFF = RING_BYTES, MISC_OFF = LDSCTL_OFF + 320, LDS_BYTES = 147456;

struct Args { const float* in[31]; float* out; unsigned char* ws; int stop_after; int pad; };
struct Frame {
    LAS unsigned char* lds; volatile LAS unsigned* MISC; gu32* ctl;
    int tid, lane, wave, vcu, G;
    float* out; unsigned char* ws;
};
#define WSP(T, off) ((T*)(F.ws + (off)))
__device__ __forceinline__ float bf2f(bf16 h) { return __uint_as_float((unsigned)h << 16); }
__device__ __forceinline__ const float* xrow_ptr(const Frame& F, const Args& A, int row) { return row < M_CTX ? A.in[0] + (size_t)row * D : A.in[1] + (size_t)(row - M_CTX) * D; }
__device__ __forceinline__ int mod_row(int row) { return row < M_CTX ? 0 : 1 + ((row - M_CTX) >> 10); }

__device__ __forceinline__ void p0_mod_item(const Frame& F, const Args& A, LAS float* scr, int item) {
    const int cb = item >> 3, kc = item & 7, lane = F.lane, col = cb * 64 + lane, k0 = kc * 128;
    float sv0[9], sv1[9];
#pragma unroll
    for (int r = 0; r < 9; ++r) { const float* cv = (r == 0) ? A.in[5] : A.in[4] + (r - 1) * D; const float x0 = cv[k0 + lane], x1 = cv[k0 + 64 + lane];
        sv0[r] = x0 / (1.f + expf(-x0)); sv1[r] = x1 / (1.f + expf(-x1)); }
    float acc[9];
#pragma unroll
    for (int r = 0; r < 9; ++r) acc[r] = 0.f;
    const float* wp = A.in[6] + (size_t)k0 * 6144 + col;
#pragma unroll 1
    for (int kb = 0; kb < 4; ++kb, wp += 32 * 6144) { float w[32];
#pragma unroll
        for (int k = 0; k < 32; ++k) w[k] = wp[(size_t)k * 6144];
        float svr[9];
#pragma unroll
        for (int r = 0; r < 9; ++r) svr[r] = kb < 2 ? sv0[r] : sv1[r];
        const int lb = (kb & 1) * 32;
#pragma unroll
        for (int k = 0; k < 32; ++k)
#pragma unroll
            for (int r = 0; r < 9; ++r) acc[r] += __int_as_float(__builtin_amdgcn_readlane(__float_as_int(svr[r]), lb + k)) * w[k]; }
    float* mp = WSP(float, WS_MODP) + (size_t)kc * 9 * 6144 + col;
#pragma unroll
    for (int r = 0; r < 9; ++r) mp[r * 6144] = acc[r];
    (void)scr;
}
__device__ __forceinline__ void p0_cache_item(const Frame& F, const Args& A, int r) {
    const int b = r >> 8, j = r & 255; const size_t drow = (size_t)(M_CTX + b * LKLAT + j) * D;
    const GAS f32x4* sk = (const GAS f32x4*)(A.in[2] + (size_t)r * D) + F.lane; const GAS f32x4* sv = (const GAS f32x4*)(A.in[3] + (size_t)r * D) + F.lane;
    GAS unsigned long long* dk = (GAS unsigned long long*)(WSP(bf16, WS_K) + drow) + F.lane; GAS unsigned long long* dv = (GAS unsigned long long*)(WSP(bf16, WS_V) + drow) + F.lane;
#pragma unroll
    for (int q = 0; q < 4; ++q) { const f32x4 a = sk[64 * q], c = sv[64 * q];
        dk[64 * q] = (unsigned long long)pk2(a.x, a.y) | ((unsigned long long)pk2(a.z, a.w) << 32);
        dv[64 * q] = (unsigned long long)pk2(c.x, c.y) | ((unsigned long long)pk2(c.z, c.w) << 32); }
}
__device__ __forceinline__ void p0_rope_item(const Frame& F, const Args& A) {
    float* tb = WSP(float, WS_ROPE);
    for (int e = F.lane; e < 1024; e += 64) { const int pos = e >> 4, i = e & 15; const float inv = powf(10000.0f, -(float)i / 16.0f); const float ang = (float)pos * inv;
        tb[2 * e] = cosf(ang); tb[2 * e + 1] = sinf(ang); }
}
__device__ __forceinline__ void p0_filter_item(const Frame& F, const Args& A, LAS float* scr, const LAS float* wsh, int item) {
    const int lane = F.lane, cb = item & 15, pg = item >> 4; const bool big = pg >= 16; const int L = big ? 1024 : 256, tbase = (big ? pg - 16 : pg) * 16;
    const LAS float* w1s = wsh + lane; const LAS float* w2s = wsh + 33 * 64 + lane;
    const float fr = A.in[23][lane], b1 = A.in[19][lane], b2 = A.in[21][lane];
    for (int p = 0; p < 16; ++p) { const int t = tbase + p; const float tt = (float)t / (float)(L - 1);
        if (lane < 33) { float e;
            if (lane == 0) e = tt;
            else { const int bnd = (lane - 1) & 15; const float f = 1e-4f + (float)bnd * ((15.0f - 1e-4f) / 15.0f); const float wpos = 2.0f * 3.14159265358979323846f * (float)t / (float)L; const float a = f * wpos;
                e = (lane <= 16) ? cosf(a) : -sinf(a); }
            scr[lane] = e; }
        LDS_WAIT(); asm volatile("" ::: "memory");
        float acc = b1;
#pragma unroll
        for (int i = 0; i < 33; ++i) acc += scr[i] * w1s[i * 64];
        scr[64 + lane] = sinf(fr * acc);
        LDS_WAIT(); asm volatile("" ::: "memory");
        float acc2 = b2;
#pragma unroll
        for (int i = 0; i < 64; ++i) acc2 += scr[64 + i] * w2s[i * 64];
        const float h2 = sinf(fr * acc2);
        scr[128 + p * 64 + lane] = h2;
        if (cb == 0) WSP(float, WS_H2)[(size_t)((big ? 256 : 0) + t) * 64 + lane] = h2;
        LDS_WAIT(); asm volatile("" ::: "memory"); }
    const int col = cb * 64 + lane;
    float af[16], ab[16];
#pragma unroll
    for (int p = 0; p < 16; ++p) { af[p] = 0.f; ab[p] = 0.f; }
    const float* w3 = A.in[22] + col;
#pragma unroll 8
    for (int i = 0; i < 64; ++i) { const float wf = w3[i * 2048], wb = w3[i * 2048 + 1024];
#pragma unroll
        for (int p = 0; p < 16; ++p) { const float h = scr[128 + p * 64 + i]; af[p] += h * wf; ab[p] += h * wb; } }
    bf16* R = WSP(bf16, WS_FILT) + (big ? (size_t)(1 * MiB / 2) : 0);
    const float d0 = logf(1e-2f) / 0.3f, d1 = logf(1e-2f) / 1.5f;
    const int ch = col & 511, ord = col >> 9; const float adelta = fabsf(d0 + (d1 - d0) * (float)ch / 511.0f);
    bf16* Rc = R + ((size_t)ord * 512 + ch) * (2 * L);
#pragma unroll
    for (int p = 0; p < 16; ++p) { const int t = tbase + p; const float tt = (float)t / (float)(L - 1); const float dec = expf(-tt * adelta);
        if (t == 0) { Rc[L] = (bf16)f2bf((af[p] + ab[p]) * dec); Rc[0] = 0; } else { Rc[L - t] = (bf16)f2bf(af[p] * dec); Rc[L + t] = (bf16)f2bf(ab[p] * dec); } }
    LDS_WAIT(); asm volatile("" ::: "memory");
}
__device__ __forceinline__ void p0_prologue(const Frame& F, const Args& A) {
    LAS float* scr = (LAS float*)(F.lds + RING_OFF + F.wave * 9216);
    LAS float* wsh = (LAS float*)(F.lds + RING_OFF + 8 * 9216);
    for (int i = F.tid; i < 33 * 64 + 64 * 64; i += NWAVES * 64) wsh[i] = i < 33 * 64 ? A.in[18][i] : A.in[20][i - 33 * 64];
    __syncthreads();
    const int gw = F.vcu * NWAVES + F.wave, NGW = F.G * NWAVES;
    constexpr int I_IN = (D / 64) * (INC / 32), I_A = (D / 64) * (D / 32), I_H = (DH / 64) * (D / 32), I_O = I_A, I_UP = (D / 64) * (FF / 32), I_DN = (FF / 64) * (D / 32);
    constexpr int NT = I_IN + I_A + I_H + I_O + I_UP + I_DN;
    constexpr int N_MOD = 768, N_CACHE = 2048, N_FILT = 1280;
    if (NGW == 2048) { if (gw < N_FILT) p0_filter_item(F, A, scr, wsh, gw); else p0_mod_item(F, A, scr, gw - N_FILT); }
    else { for (int it = gw; it < N_FILT; it += NGW) p0_filter_item(F, A, scr, wsh, it); for (int it = gw; it < N_MOD; it += NGW) p0_mod_item(F, A, scr, it); }
    if (gw == NGW - 1) p0_rope_item(F, A);
    for (int it = gw; it < N_CACHE; it += NGW) p0_cache_item(F, A, it);
    for (int it = gw; it < NT; it += NGW) {
        int r = it;
        if (r < I_IN) { p0_transpose_item(A.in[10], D, INC, WSP(bf16, WS_WIN), 0, scr, r, F.lane); continue; } r -= I_IN;
        if (r < I_A) { p0_transpose_item(A.in[25], D, D, WSP(bf16, WS_WA), 0, scr, r, F.lane); continue; } r -= I_A;
        if (r < I_H) { p0_transpose_item(A.in[26], DH, D, WSP(bf16, WS_WH), 0, scr, r, F.lane); continue; } r -= I_H;
        if (r < I_O) { p0_transpose_item(A.in[27], D, D, WSP(bf16, WS_WO), 0, scr, r, F.lane); continue; } r -= I_O;
        if (r < I_UP) { p0_transpose_item(A.in[28], D, FF, WSP(bf16, WS_WUP), 0, scr, r, F.lane); continue; } r -= I_UP;
        p0_transpose_item(A.in[29], FF, D, WSP(bf16, WS_WDN), 0, scr, r, F.lane);
    }
}
__device__ __forceinline__ void modnorm_rows(const Frame& F, const Args& A, int which) {
    const int gw = F.vcu * NWAVES + F.wave, NGW = F.G * NWAVES, lane = F.lane;
    const float* gvec = which ? A.in[9] : A.in[8]; const int shoff = which ? 3072 : 0, scoff = which ? 4096 : 1024;
    for (int ch = gw; ch < MROWS / 6; ch += NGW) {
        int cur = -1; f32x4 av[4], sv[4];
        for (int rr = 0; rr < 6; ++rr) { const int row = ch * 6 + rr; const int mr = mod_row(row);
            if (mr != cur) { cur = mr;
#pragma unroll
                for (int j = 0; j < 4; ++j) { const int c = 4 * lane + 256 * j; f32x4 sh, sc;
                    if (which == 0) { sh = *(const GAS f32x4*)(A.in[7] + c); sc = *(const GAS f32x4*)(A.in[7] + 1024 + c);
                        for (int kc = 0; kc < 8; ++kc) { const float* mp = WSP(float, WS_MODP) + ((size_t)kc * 9 + mr) * 6144; sh += *(const GAS f32x4*)(mp + c); sc += *(const GAS f32x4*)(mp + 1024 + c); } }
                    else { const float* mf = WSP(float, WS_MODF) + (size_t)mr * 6144; sh = *(const GAS f32x4*)(mf + shoff + c); sc = *(const GAS f32x4*)(mf + scoff + c); }
                    const f32x4 g = *(const GAS f32x4*)(gvec + c); av[j] = g * (sc + 1.0f); sv[j] = sh; } }
            const float* xr = which ? F.out + (size_t)row * D : xrow_ptr(F, A, row);
            f32x4 v[4]; float s = 0.f;
#pragma unroll
            for (int j = 0; j < 4; ++j) { v[j] = *(const GAS f32x4*)(xr + 4 * lane + 256 * j); s += (v[j].x * v[j].x + v[j].y * v[j].y) + (v[j].z * v[j].z + v[j].w * v[j].w); }
            const float rstd = 1.f / sqrtf(wave_sum(s) * (1.f / D) + EPSN);
            GAS unsigned long long* o8 = (GAS unsigned long long*)(WSP(bf16, WS_XN) + (size_t)row * D) + lane;
#pragma unroll
            for (int j = 0; j < 4; ++j) { const f32x4 y = v[j] * rstd * av[j] + sv[j]; o8[64 * j] = (unsigned long long)pk2(y.x, y.y) | ((unsigned long long)pk2(y.z, y.w) << 32); } }
    }
    if (which == 0) {
        for (int it = gw; it < 9 * 6144 / 64; it += NGW) { const int idx = it * 64 + lane, r = idx / 6144, col = idx % 6144; float a = A.in[7][col];
            for (int kc = 0; kc < 8; ++kc) a += WSP(float, WS_MODP)[((size_t)kc * 9 + r) * 6144 + col];
            WSP(float, WS_MODF)[idx] = a; } }
}
struct EpiIn {
    static constexpr bool PERM = true, AFTER_DRAIN = false;
    bf16 *Q, *Kb, *Vb, *UT, *G; float *nk, *nv; const float* rope;
    __device__ __forceinline__ void operator()(const pg8::f32x4 (&acc)[2][2][4][2], const pg8::Unit& u, int wr, int wc, int fr, int fq) const {
        using pg8::f32x4; using pg8::u32x4;
        const int pn = u.pn, pm = u.pm; const bool lat = pm >= 16;
        const int rowt = pm * 256 + wr * 64 + fr;
        if (pn < 12) {
            const int typ = pn >> 2, cb = (pn & 3) * 256 + wc * 32 + 8 * fq;
            const int lb = (pm - 16) >> 2, t0 = ((pm - 16) & 3) * 256 + wr * 64 + fr;
#pragma unroll
            for (int ai = 0; ai < 2; ++ai)
#pragma unroll
                for (int m = 0; m < 4; ++m) {
                    const int row = rowt + ai * 128 + m * 16, t = t0 + ai * 128 + m * 16;
#pragma unroll
                    for (int bj = 0; bj < 2; ++bj) {
                        f32x4 v0 = acc[ai][bj][m][0], v1 = acc[ai][bj][m][1];
                        if (lat && typ < 2) {
                            const int pos = (wc & 1) ? (t & 63) : (t >> 6);
                            const float* tb = rope + (size_t)pos * 32 + (8 * (fq & 1)) * 2;
                            const f32x4 c0 = *(const f32x4*)(tb), c1 = *(const f32x4*)(tb + 4), c2 = *(const f32x4*)(tb + 8), c3 = *(const f32x4*)(tb + 12);
                            f32x4 p0, p1;
                            p0.x = __shfl_xor(v0.x, 32); p0.y = __shfl_xor(v0.y, 32); p0.z = __shfl_xor(v0.z, 32); p0.w = __shfl_xor(v0.w, 32);
                            p1.x = __shfl_xor(v1.x, 32); p1.y = __shfl_xor(v1.y, 32); p1.z = __shfl_xor(v1.z, 32); p1.w = __shfl_xor(v1.w, 32);
                            const float sg = (fq < 2) ? -1.f : 1.f;
                            v0.x = v0.x * c0.x + sg * p0.x * c0.y; v0.y = v0.y * c0.z + sg * p0.y * c0.w; v0.z = v0.z * c1.x + sg * p0.z * c1.y; v0.w = v0.w * c1.z + sg * p0.w * c1.w;
                            v1.x = v1.x * c2.x + sg * p1.x * c2.y; v1.y = v1.y * c2.z + sg * p1.y * c2.w; v1.z = v1.z * c3.x + sg * p1.z * c3.y; v1.w = v1.w * c3.z + sg * p1.w * c3.w;
                        }
                        const int col = cb + bj * 128;
                        if (!lat && typ > 0) { float* op = (typ == 1 ? nk : nv) + (size_t)row * D + col; *(f32x4*)op = v0; *(f32x4*)(op + 4) = v1; }
                        if (typ == 0) { v0 = v0 * QSCALE; v1 = v1 * QSCALE; }
                        u32x4 w; w.x = pg8::cvt_pk_bf16(v0[0], v0[1]); w.y = pg8::cvt_pk_bf16(v0[2], v0[3]); w.z = pg8::cvt_pk_bf16(v1[0], v1[1]); w.w = pg8::cvt_pk_bf16(v1[2], v1[3]);
                        bf16* dst;
                        if (typ == 0) dst = Q + (size_t)row * D + col;
                        else { const size_t kr = lat ? (size_t)(M_CTX + lb * LKLAT + PAST + t) : (size_t)row; dst = (typ == 1 ? Kb : Vb) + kr * D + col; }
                        *(u32x4*)dst = w;
                    }
                }
        } else if (pn < 18) {
            const int cb = (pn - 12) * 256 + wc * 32 + 8 * fq;
#pragma unroll
            for (int ai = 0; ai < 2; ++ai)
#pragma unroll
                for (int m = 0; m < 4; ++m) { const int row = rowt + ai * 128 + m * 16;
#pragma unroll
                    for (int bj = 0; bj < 2; ++bj)
#pragma unroll
                        for (int n = 0; n < 2; ++n)
#pragma unroll
                            for (int e = 0; e < 4; ++e) UT[(size_t)(cb + bj * 128 + 4 * n + e) * MROWS + row] = (bf16)f2bf(acc[ai][bj][m][n][e]); }
        } else {
            const int cb = (pn - 18) * 256 + wc * 32 + 8 * fq;
#pragma unroll
            for (int ai = 0; ai < 2; ++ai)
#pragma unroll
                for (int m = 0; m < 4; ++m) { const int row = rowt + ai * 128 + m * 16;
#pragma unroll
                    for (int bj = 0; bj < 2; ++bj) { f32x4 v0 = acc[ai][bj][m][0], v1 = acc[ai][bj][m][1];
#pragma unroll
                        for (int e = 0; e < 4; ++e) { v0[e] = 1.f / (1.f + __expf(-v0[e])); v1[e] = 1.f / (1.f + __expf(-v1[e])); }
                        u32x4 w; w.x = pg8::cvt_pk_bf16(v0[0], v0[1]); w.y = pg8::cvt_pk_bf16(v0[2], v0[3]); w.z = pg8::cvt_pk_bf16(v1[0], v1[1]); w.w = pg8::cvt_pk_bf16(v1[2], v1[3]);
                        *(u32x4*)(G + (size_t)row * 2048 + cb + bj * 128) = w; } }
        }
    }
};

typedef float f32x16 __attribute__((ext_vector_type(16)));
typedef short s16x4 __attribute__((ext_vector_type(4)));
constexpr int AT_K = 0, AT_V = 16384, AT_Q = 32768, AT_QW = 9216, AT_OP = 272;
static_assert(AT_Q + 8 * AT_QW <= RING_BYTES, "attention LDS");
__device__ __forceinline__ unsigned off_b(unsigned row, unsigned ch) { return 256u * row + 16u * (ch ^ (((row & 3u) << 2) | ((row >> 2) & 3u))); }
__device__ __forceinline__ s16x4 tr16(LAS unsigned char* p) { return __builtin_bit_cast(s16x4, __builtin_amdgcn_ds_read_tr16_b64_v4i16((LAS s16x4*)p)); }
__device__ __forceinline__ unsigned pkbf(float lo, float hi) { return pg8::cvt_pk_bf16(lo, hi); }
__device__ __forceinline__ void attn_unit(const Frame& F, const Args& A, bf16* Obuf, int qrow0, int krow0, int nt, int head) {
    int tid = F.tid; asm volatile("" : "+v"(tid));
    const int lane = tid & 63, wave = __builtin_amdgcn_readfirstlane(tid >> 6), r32 = lane & 31, hi = lane >> 5, mp = wave >> 2, qb = wave & 3;
    LAS unsigned char* lk = F.lds + AT_K; LAS unsigned char* lv = F.lds + AT_V; LAS unsigned char* lq = F.lds + AT_Q + wave * AT_QW;
    { const bf16* qg = WSP(const bf16, WS_Q) + (size_t)(qrow0 + qb * 32) * D + head * 128;
#pragma unroll
      for (int i = 0; i < 8; ++i) { const int id = lane + 64 * i, row = id >> 4, ch = id & 15; const v4u x = *(const GAS v4u*)(qg + (size_t)row * D + ch * 8); *(LAS v4u*)(lq + off_b(row, ch)) = x; } }
    const bf16* kg = WSP(const bf16, WS_K) + (size_t)krow0 * D + head * 128; const bf16* vg = WSP(const bf16, WS_V) + (size_t)krow0 * D + head * 128;
    const int srow0 = tid >> 4, sch = tid & 15;
    v4u pk0, pk1, pv0, pv1;
    pk0 = *(const GAS v4u*)(kg + (size_t)srow0 * D + sch * 8); pk1 = *(const GAS v4u*)(kg + (size_t)(srow0 + 32) * D + sch * 8);
    pv0 = *(const GAS v4u*)(vg + (size_t)srow0 * D + sch * 8); pv1 = *(const GAS v4u*)(vg + (size_t)(srow0 + 32) * D + sch * 8);
    f32x16 O[4];
#pragma unroll
    for (int e = 0; e < 4; ++e) O[e] = f32x16{};
    float mrun = -1e30f, lrun = 0.f;
    const int blk = (lane >> 4) & 1, q4 = (lane & 15) >> 2, p4 = lane & 3;
    for (int t = 0; t < nt; ++t) {
        __syncthreads();
        *(LAS v4u*)(lk + off_b(srow0, sch)) = pk0; *(LAS v4u*)(lk + off_b(srow0 + 32, sch)) = pk1;
        *(LAS v4u*)(lv + off_b(srow0, sch)) = pv0; *(LAS v4u*)(lv + off_b(srow0 + 32, sch)) = pv1;
        __syncthreads();
        if (t + 1 < nt) { const size_t o = (size_t)(t + 1) * 64 * D;
            pk0 = *(const GAS v4u*)(kg + o + (size_t)srow0 * D + sch * 8); pk1 = *(const GAS v4u*)(kg + o + (size_t)(srow0 + 32) * D + sch * 8);
            pv0 = *(const GAS v4u*)(vg + o + (size_t)srow0 * D + sch * 8); pv1 = *(const GAS v4u*)(vg + o + (size_t)(srow0 + 32) * D + sch * 8); }
        f32x16 S0 = f32x16{}, S1 = f32x16{};
#pragma unroll
        for (int ds = 0; ds < 4; ++ds) { const unsigned ch = (unsigned)(mp * 8 + ds * 2 + hi);
            const bf16x8 qf = *(const LAS bf16x8*)(lq + off_b(r32, ch));
            const bf16x8 k0 = *(const LAS bf16x8*)(lk + off_b(r32, ch)); const bf16x8 k1 = *(const LAS bf16x8*)(lk + off_b(r32 + 32, ch));
            S0 = __builtin_amdgcn_mfma_f32_32x32x16_bf16(k0, qf, S0, 0, 0, 0); S1 = __builtin_amdgcn_mfma_f32_32x32x16_bf16(k1, qf, S1, 0, 0, 0); }
        float mx = fmaxf(S0[0], S1[0]);
#pragma unroll
        for (int r = 1; r < 16; ++r) mx = fmaxf(mx, fmaxf(S0[r], S1[r]));
        mx = fmaxf(mx, __shfl_xor(mx, 32));
        const float mn = fmaxf(mrun, mx); const float alpha = __builtin_amdgcn_exp2f(mrun - mn);
        float rs = 0.f;
#pragma unroll
        for (int r = 0; r < 16; ++r) { S0[r] = __builtin_amdgcn_exp2f(S0[r] - mn); S1[r] = __builtin_amdgcn_exp2f(S1[r] - mn); rs += S0[r] + S1[r]; }
        mrun = mn; lrun = lrun * alpha + rs;
        if (!__all(alpha == 1.0f)) {
#pragma unroll
            for (int e = 0; e < 4; ++e) O[e] = O[e] * alpha; }
        bf16x8 P[4];
#pragma unroll
        for (int s = 0; s < 2; ++s) {
            v4u a, b;
            a.x = pkbf(S0[8 * s + 0], S0[8 * s + 1]); a.y = pkbf(S0[8 * s + 2], S0[8 * s + 3]); a.z = pkbf(S0[8 * s + 4], S0[8 * s + 5]); a.w = pkbf(S0[8 * s + 6], S0[8 * s + 7]);
            b.x = pkbf(S1[8 * s + 0], S1[8 * s + 1]); b.y = pkbf(S1[8 * s + 2], S1[8 * s + 3]); b.z = pkbf(S1[8 * s + 4], S1[8 * s + 5]); b.w = pkbf(S1[8 * s + 6], S1[8 * s + 7]);
            P[0 * 2 + s] = __builtin_bit_cast(bf16x8, a); P[1 * 2 + s] = __builtin_bit_cast(bf16x8, b); }
#pragma unroll
        for (int eb = 0; eb < 4; ++eb)
#pragma unroll
            for (int kb = 0; kb < 2; ++kb)
#pragma unroll
                for (int s = 0; s < 2; ++s) {
                    const unsigned rowa = (unsigned)(kb * 32 + 16 * s + 4 * hi + q4), chv = (unsigned)(4 * eb + 2 * blk + (p4 >> 1));
                    const s16x4 lo = tr16(lv + off_b(rowa, chv) + 8 * (p4 & 1)); const s16x4 hh = tr16(lv + off_b(rowa + 8, chv) + 8 * (p4 & 1));
                    const bf16x8 vf = (bf16x8){lo[0], lo[1], lo[2], lo[3], hh[0], hh[1], hh[2], hh[3]};
                    O[eb] = __builtin_amdgcn_mfma_f32_32x32x16_bf16(vf, P[kb * 2 + s], O[eb], 0, 0, 0); }
    }
    lrun += __shfl_xor(lrun, 32);
    LAS float* X = (LAS float*)(F.lds + (qb < 2 ? qb * 16384 : AT_Q + 4 * AT_QW + (qb - 2) * 16384));
    __syncthreads();
    if (mp == 1) {
        float s1 = 0.f, s2 = 0.f;
        for (int i = 0; i < 64; ++i) { s1 += A.in[11][i] * A.in[12][i]; s2 += A.in[13][i] * A.in[14][i]; }
        const float lam = expf(s1) - expf(s2) + LAM_INIT; const float sc = lam / lrun;
#pragma unroll
        for (int e = 0; e < 4; ++e)
#pragma unroll
            for (int r = 0; r < 16; ++r) X[(e * 32 + (r & 3) + 8 * (r >> 2) + 4 * hi) * 32 + r32] = O[e][r] * sc;
    }
    __syncthreads();
    if (mp == 0) {
        const float i0 = 1.f / lrun; float ss = 0.f;
#pragma unroll
        for (int e = 0; e < 4; ++e)
#pragma unroll
            for (int r = 0; r < 16; ++r) { const float o = O[e][r] * i0 - X[(e * 32 + (r & 3) + 8 * (r >> 2) + 4 * hi) * 32 + r32]; O[e][r] = o; ss += o * o; }
        ss += __shfl_xor(ss, 32);
        const float rstd = (1.f - LAM_INIT) / sqrtf(ss * (1.f / 128.f) + EPSN);
#pragma unroll
        for (int e = 0; e < 4; ++e)
#pragma unroll
            for (int g4 = 0; g4 < 4; ++g4) { const int e0 = e * 32 + 8 * g4 + 4 * hi; const f32x4 gg = *(const GAS f32x4*)(A.in[15] + e0);
                const unsigned w0 = pkbf(O[e][4 * g4 + 0] * rstd * gg.x, O[e][4 * g4 + 1] * rstd * gg.y), w1 = pkbf(O[e][4 * g4 + 2] * rstd * gg.z, O[e][4 * g4 + 3] * rstd * gg.w);
                *(LAS unsigned long long*)(lq + r32 * AT_OP + e0 * 2) = (unsigned long long)w0 | ((unsigned long long)w1 << 32); }
        LDS_WAIT(); asm volatile("" ::: "memory");
        { bf16* og = Obuf + (size_t)(qrow0 + qb * 32) * D + head * 128;
#pragma unroll
          for (int i = 0; i < 8; ++i) { const int id = lane + 64 * i, row = id >> 4, ch = id & 15; const v4u x = *(const LAS v4u*)(lq + row * AT_OP + ch * 16); *(GAS v4u*)(og + (size_t)row * D + ch * 8) = x; } }
        LDS_WAIT(); asm volatile("" ::: "memory");
    }
}

template <int L, int NB> __device__ __forceinline__ void hyena_unit(const Frame& F, const Args& A, int c) {
    constexpr int ROW0 = (L == LCTX) ? 0 : M_CTX, NTOK = NB * L, PITCH = L + 8, CP = 2 * L + 8, TW = (L / 16) / 8;
    constexpr int OFF_V = 8 * CP * 2, ARR = NB * PITCH * 2, OFF_Z = OFF_V + ARR, OFF_X1 = OFF_Z + ARR, OFF_X2 = OFF_X1 + ARR;
    static_assert(OFF_X2 + ARR <= RING_BYTES, "hyena LDS");
    int tid = F.tid; asm volatile("" : "+v"(tid));
    const int lane = tid & 63, wave = __builtin_amdgcn_readfirstlane(tid >> 6);
    LAS unsigned char* lds = F.lds;
#pragma unroll
    for (int p = 0; p < 3; ++p) {
        const bf16* src = WSP(const bf16, WS_UT) + (size_t)(p * DH + c) * MROWS + ROW0;
        const float w0 = A.in[16][p * DH + c], w1 = A.in[16][HYC + p * DH + c], w2 = A.in[16][2 * HYC + p * DH + c], bb = A.in[17][p * DH + c];
        LAS unsigned char* dst = lds + (p == 0 ? OFF_V : (p == 1 ? OFF_X1 : OFF_X2));
        for (int idx = tid; idx < NTOK / 8; idx += NWAVES * 64) { const int t8 = idx * 8, b = t8 / L, t = t8 % L;
            const v4u raw = *(const GAS v4u*)(src + t8);
            float x[10];
            x[0] = (t == 0) ? 0.f : bf2f(src[t8 - 1]); x[9] = (t + 8 == L) ? 0.f : bf2f(src[t8 + 8]);
            x[1] = __uint_as_float(raw.x << 16); x[2] = __uint_as_float(raw.x & 0xffff0000u); x[3] = __uint_as_float(raw.y << 16); x[4] = __uint_as_float(raw.y & 0xffff0000u);
            x[5] = __uint_as_float(raw.z << 16); x[6] = __uint_as_float(raw.z & 0xffff0000u); x[7] = __uint_as_float(raw.w << 16); x[8] = __uint_as_float(raw.w & 0xffff0000u);
            v4u o;
            o.x = pk2(w0 * x[0] + w1 * x[1] + w2 * x[2] + bb, w0 * x[1] + w1 * x[2] + w2 * x[3] + bb); o.y = pk2(w0 * x[2] + w1 * x[3] + w2 * x[4] + bb, w0 * x[3] + w1 * x[4] + w2 * x[5] + bb);
            o.z = pk2(w0 * x[4] + w1 * x[5] + w2 * x[6] + bb, w0 * x[5] + w1 * x[6] + w2 * x[7] + bb); o.w = pk2(w0 * x[6] + w1 * x[7] + w2 * x[8] + bb, w0 * x[7] + w1 * x[8] + w2 * x[9] + bb);
            *(LAS v4u*)(dst + (b * PITCH + t) * 2) = o; }
    }
    const float bias0 = A.in[24][c], bias1 = A.in[24][DH + c];
    const int tl = lane & 15, kg = lane >> 4, msh = (16 - tl) & 7;
#pragma unroll
    for (int ord = 0; ord < 2; ++ord) {
        { const bf16* R = WSP(const bf16, WS_FILT) + (L == LCTX ? 0 : (size_t)(MiB / 2)) + ((size_t)ord * DH + c) * (2 * L);
          for (int q = tid; q < 2 * L / 8; q += NWAVES * 64) {
              const v4u lo = *(const GAS v4u*)(R + 8 * q); v4u hi4 = (v4u){0u, 0u, 0u, 0u}; if (q + 1 < 2 * L / 8) hi4 = *(const GAS v4u*)(R + 8 * q + 8);
              const unsigned w[8] = {lo.x, lo.y, lo.z, lo.w, hi4.x, hi4.y, hi4.z, hi4.w};
#pragma unroll
              for (int m = 0; m < 8; ++m) { v4u o;
                  if (m & 1) { o.x = __builtin_amdgcn_alignbit(w[m / 2 + 1], w[m / 2], 16); o.y = __builtin_amdgcn_alignbit(w[m / 2 + 2], w[m / 2 + 1], 16); o.z = __builtin_amdgcn_alignbit(w[m / 2 + 3], w[m / 2 + 2], 16); o.w = __builtin_amdgcn_alignbit(w[m / 2 + 4], w[m / 2 + 3], 16); }
                  else { o.x = w[m / 2]; o.y = w[m / 2 + 1]; o.z = w[m / 2 + 2]; o.w = w[m / 2 + 3]; }
                  *(LAS v4u*)(lds + (m * CP + 8 * q) * 2) = o; } } }
        __syncthreads();
        pg8::f32x4 acc[TW];
#pragma unroll
        for (int i = 0; i < TW; ++i) acc[i] = (pg8::f32x4){0.f, 0.f, 0.f, 0.f};
        const LAS unsigned char* ub = lds + (ord == 0 ? OFF_V : OFF_Z) + ((lane & (NB - 1)) * PITCH + 8 * kg) * 2;
        const int tbase = wave * TW * 16;
        const LAS unsigned char* ab = lds + (msh * CP + (L - tbase - tl + 8 * kg - msh)) * 2;
#pragma unroll 2
        for (int ss = 0; ss < L / 32; ++ss) { const bf16x8 bfr = *(const LAS bf16x8*)(ub + ss * 64);
#pragma unroll
            for (int i = 0; i < TW; ++i) { const bf16x8 afr = *(const LAS bf16x8*)(ab + (ss * 32 - 16 * i) * 2);
                acc[i] = __builtin_amdgcn_mfma_f32_16x16x32_bf16(afr, bfr, acc[i], 0, 0, 0); } }
        const int b = tl;
        if (b < NB) {
#pragma unroll
            for (int i = 0; i < TW; ++i) { const int t = tbase + 16 * i + 4 * kg; const int eo = (b * PITCH + t) * 2;
                const unsigned long long uu = *(const LAS unsigned long long*)(lds + (ord == 0 ? OFF_V : OFF_Z) + eo), gg = *(const LAS unsigned long long*)(lds + (ord == 0 ? OFF_X1 : OFF_X2) + eo);
                const float bias = ord == 0 ? bias0 : bias1; float y[4];
#pragma unroll
                for (int r = 0; r < 4; ++r) { const float uv = __uint_as_float((unsigned)((uu >> (16 * r)) & 0xffffull) << 16), gv = __uint_as_float((unsigned)((gg >> (16 * r)) & 0xffffull) << 16);
                    y[r] = gv * (acc[i][r] + uv * bias); }
                if (ord == 0) *(LAS unsigned long long*)(lds + OFF_Z + eo) = (unsigned long long)pk2(y[0], y[1]) | ((unsigned long long)pk2(y[2], y[3]) << 32);
                else { bf16* og = WSP(bf16, WS_XN) + (size_t)(ROW0 + b * L + t) * DH + c;
#pragma unroll
                    for (int r = 0; r < 4; ++r) og[(size_t)r * DH] = (bf16)f2bf(y[r]); } }
        }
        __syncthreads();
    }
}

struct EpiT1 {
    static constexpr bool PERM = true, AFTER_DRAIN = false;
    const bf16* G; bf16* T1;
    __device__ __forceinline__ void operator()(const pg8::f32x4 (&acc)[2][2][4][2], const pg8::Unit& u, int wr, int wc, int fr, int fq) const {
        using pg8::f32x4; using pg8::u32x4;
        const int row0 = u.pm * 256 + wr * 64 + fr, col0 = u.pn * 256 + wc * 32 + 8 * fq;
#pragma unroll
        for (int ai = 0; ai < 2; ++ai)
#pragma unroll
            for (int m = 0; m < 4; ++m) { const int row = row0 + ai * 128 + m * 16;
#pragma unroll
                for (int bj = 0; bj < 2; ++bj) { const int col = col0 + bj * 128; const u32x4 g = *(const u32x4*)(G + (size_t)row * 2048 + col);
                    const f32x4 v0 = acc[ai][bj][m][0], v1 = acc[ai][bj][m][1]; u32x4 w;
                    w.x = pg8::cvt_pk_bf16(v0[0] * __uint_as_float(g.x << 16), v0[1] * __uint_as_float(g.x & 0xffff0000u)); w.y = pg8::cvt_pk_bf16(v0[2] * __uint_as_float(g.y << 16), v0[3] * __uint_as_float(g.y & 0xffff0000u));
                    w.z = pg8::cvt_pk_bf16(v1[0] * __uint_as_float(g.z << 16), v1[1] * __uint_as_float(g.z & 0xffff0000u)); w.w = pg8::cvt_pk_bf16(v1[2] * __uint_as_float(g.w << 16), v1[3] * __uint_as_float(g.w & 0xffff0000u));
                    *(u32x4*)(T1 + (size_t)row * D + col) = w; } }
    }
};
struct EpiMerge {
    static constexpr bool PERM = true, AFTER_DRAIN = false;
    const bf16* G; const bf16* T1; bf16* MG;
    __device__ __forceinline__ void operator()(const pg8::f32x4 (&acc)[2][2][4][2], const pg8::Unit& u, int wr, int wc, int fr, int fq) const {
        using pg8::f32x4; using pg8::u32x4;
        const int row0 = u.pm * 256 + wr * 64 + fr, col0 = u.pn * 256 + wc * 32 + 8 * fq;
#pragma unroll
        for (int ai = 0; ai < 2; ++ai)
#pragma unroll
            for (int m = 0; m < 4; ++m) { const int row = row0 + ai * 128 + m * 16;
#pragma unroll
                for (int bj = 0; bj < 2; ++bj) { const int col = col0 + bj * 128; const u32x4 g = *(const u32x4*)(G + (size_t)row * 2048 + 1024 + col); const u32x4 t = *(const u32x4*)(T1 + (size_t)row * D + col);
                    const f32x4 v0 = acc[ai][bj][m][0], v1 = acc[ai][bj][m][1]; u32x4 w;
                    w.x = pg8::cvt_pk_bf16(__uint_as_float(t.x << 16) + v0[0] * __uint_as_float(g.x << 16), __uint_as_float(t.x & 0xffff0000u) + v0[1] * __uint_as_float(g.x & 0xffff0000u));
                    w.y = pg8::cvt_pk_bf16(__uint_as_float(t.y << 16) + v0[2] * __uint_as_float(g.y << 16), __uint_as_float(t.y & 0xffff0000u) + v0[3] * __uint_as_float(g.y & 0xffff0000u));
                    w.z = pg8::cvt_pk_bf16(__uint_as_float(t.z << 16) + v1[0] * __uint_as_float(g.z << 16), __uint_as_float(t.z & 0xffff0000u) + v1[1] * __uint_as_float(g.z & 0xffff0000u));
                    w.w = pg8::cvt_pk_bf16(__uint_as_float(t.w << 16) + v1[2] * __uint_as_float(g.w << 16), __uint_as_float(t.w & 0xffff0000u) + v1[3] * __uint_as_float(g.w & 0xffff0000u));
                    *(u32x4*)(MG + (size_t)row * D + col) = w; } }
    }
};
struct EpiRes {
    static constexpr bool PERM = false, AFTER_DRAIN = false;
    const float* xa; const float* xb; const float* modf; int goff; float* out;
    __device__ __forceinline__ void operator()(const pg8::f32x4 (&acc)[2][2][4][2], const pg8::Unit& u, int wr, int wc, int fr, int fq) const {
        using pg8::f32x4;
        const int row0 = u.pm * 256 + wr * 64 + fr, col0 = u.pn * 256 + wc * 32 + 4 * fq; const int mr = u.pm < 16 ? 0 : 1 + ((u.pm - 16) >> 2);
        const float* gp = modf + (size_t)mr * 6144 + goff + col0; f32x4 gv[2][2];
#pragma unroll
        for (int bj = 0; bj < 2; ++bj)
#pragma unroll
            for (int n = 0; n < 2; ++n) gv[bj][n] = *(const f32x4*)(gp + bj * 128 + n * 16);
#pragma unroll
        for (int ai = 0; ai < 2; ++ai)
#pragma unroll
            for (int m = 0; m < 4; ++m) { const int row = row0 + ai * 128 + m * 16; const float* bp = (row < M_CTX ? xa + (size_t)row * D : xb + (size_t)(row - M_CTX) * D) + col0; float* op = out + (size_t)row * D + col0;
#pragma unroll
                for (int bj = 0; bj < 2; ++bj)
#pragma unroll
                    for (int n = 0; n < 2; ++n) { const f32x4 bs = *(const f32x4*)(bp + bj * 128 + n * 16); *(f32x4*)(op + bj * 128 + n * 16) = bs + gv[bj][n] * acc[ai][bj][m][n]; } }
    }
};
struct EpiUp {
    static constexpr bool PERM = true, AFTER_DRAIN = false;
    bf16* UP;
    __device__ __forceinline__ void operator()(const pg8::f32x4 (&acc)[2][2][4][2], const pg8::Unit& u, int wr, int wc, int fr, int fq) const {
        using pg8::f32x4; using pg8::u32x4;
        const int row0 = u.pm * 256 + wr * 64 + fr, col0 = u.pn * 256 + wc * 32 + 8 * fq;
#pragma unroll
        for (int ai = 0; ai < 2; ++ai)
#pragma unroll
            for (int m = 0; m < 4; ++m) { const int row = row0 + ai * 128 + m * 16;
#pragma unroll
                for (int bj = 0; bj < 2; ++bj) { f32x4 v0 = acc[ai][bj][m][0], v1 = acc[ai][bj][m][1];
#pragma unroll
                    for (int e = 0; e < 4; ++e) { const float a = fmaxf(v0[e], 0.f), b = fmaxf(v1[e], 0.f); v0[e] = a * a; v1[e] = b * b; }
                    u32x4 w; w.x = pg8::cvt_pk_bf16(v0[0], v0[1]); w.y = pg8::cvt_pk_bf16(v0[2], v0[3]); w.z = pg8::cvt_pk_bf16(v1[0], v1[1]); w.w = pg8::cvt_pk_bf16(v1[2], v1[3]);
                    *(u32x4*)(UP + (size_t)row * FF + col0 + bj * 128) = w; } }
    }
};
__device__ __forceinline__ void final_norm_rows(const Frame& F, const Args& A) {
    const int gw = F.vcu * NWAVES + F.wave, NGW = F.G * NWAVES, lane = F.lane;
    f32x4 gv[4];
#pragma unroll
    for (int j = 0; j < 4; ++j) gv[j] = *(const GAS f32x4*)(A.in[30] + 4 * lane + 256 * j);
    for (int row = gw; row < MROWS; row += NGW) { float* xr = F.out + (size_t)row * D; f32x4 v[4]; float s = 0.f;
#pragma unroll
        for (int j = 0; j < 4; ++j) { v[j] = *(const GAS f32x4*)(xr + 4 * lane + 256 * j); s += (v[j].x * v[j].x + v[j].y * v[j].y) + (v[j].z * v[j].z + v[j].w * v[j].w); }
        const float rstd = 1.f / sqrtf(wave_sum(s) * (1.f / D) + EPSN);
#pragma unroll
        for (int j = 0; j < 4; ++j) *(GAS f32x4*)(xr + 4 * lane + 256 * j) = v[j] * rstd * gv[j]; }
}

#ifndef MK_DEBUG
#define MK_DEBUG 0
#endif
#ifndef MK_REP
#define MK_REP 0
#endif
#ifndef MK_REP3
#define MK_REP3 3
#endif
#define REPK(k) for (int rep_ = 0; rep_ <= ((MK_REP >> (k)) & 1); ++rep_)
__global__ void __launch_bounds__(NWAVES * 64, 2) mk_fwd(Args args) {
    extern __shared__ __attribute__((aligned(16))) unsigned char lds[];
    Frame F;
    F.lds = (LAS unsigned char*)lds; F.MISC = (volatile LAS unsigned*)(F.lds + MISC_OFF);
    F.tid = threadIdx.x; F.lane = F.tid & 63; F.wave = __builtin_amdgcn_readfirstlane(F.tid >> 6);
    F.G = gridDim.x; { const int bx = blockIdx.x; F.vcu = (F.G % 8 == 0) ? (bx % 8) * (F.G / 8) + bx / 8 : bx; }
    F.ws = args.ws; F.out = args.out; F.ctl = (gu32*)(args.ws + WS_CTL);
    const Args& A = args;
    for (int u = F.tid; u < (LDS_BYTES - LDSCTL_OFF) / 4; u += NWAVES * 64) ((LAS unsigned*)(F.lds + LDSCTL_OFF))[u] = 0u;
    __syncthreads();
    XcdBarrier bar = xcd_barrier_post((unsigned*)(F.ctl + CW_BAR), F.MISC + 8);
    const int stop = args.stop_after; int n_ts = 1;
    if (MK_DEBUG && blockIdx.x == 0 && threadIdx.x == 0) ((unsigned long long*)(F.ctl + TS_WORDS))[0] = rt();
#define GRID_BAR() do { xcd_barrier(bar); if (MK_DEBUG && blockIdx.x == 0 && threadIdx.x == 0) { ((unsigned long long*)(F.ctl + TS_WORDS))[n_ts] = rt(); } ++n_ts; } while (0)
#define STOP_IF(k) do { if (MK_DEBUG && stop == (k)) return; } while (0)
#define PHASE_BEGIN() do { int t_ = threadIdx.x; asm volatile("" : "+v"(t_)); F.tid = t_; F.lane = t_ & 63; } while (0)

    REPK(0) { PHASE_BEGIN(); p0_prologue(F, A); }
    GRID_BAR(); STOP_IF(0);
    REPK(1) { PHASE_BEGIN(); modnorm_rows(F, A, 0); }
    GRID_BAR(); STOP_IF(1);
    REPK(2) {
        pg8::Gemm g{WSP(const pg8::bf16_t, WS_XN), WSP(const pg8::bf16_t, WS_WIN), MROWS, INC, D}; pg8::StaticOrder S; S.init(MROWS, INC, F.G, (int)blockIdx.x);
        EpiIn E{WSP(bf16, WS_Q), WSP(bf16, WS_K), WSP(bf16, WS_V), WSP(bf16, WS_UT), WSP(bf16, WS_G), F.out + (size_t)MROWS * D, F.out + (size_t)MROWS * D + (size_t)M_CTX * D, WSP(const float, WS_ROPE)};
        pg8::gemm_phase<EpiIn, pg8::StaticOrder, true, true>(F.lds + RING_OFF, g, S, E);
    }
    GRID_BAR(); STOP_IF(2);
    REPK(3) {
        PHASE_BEGIN();
        bf16* Obuf = WSP(bf16, WS_O);
        volatile LAS unsigned* qslot = (volatile LAS unsigned*)(F.lds + LDSCTL_OFF + 64);
        constexpr int NU = 512 + 512 + 256 + 512;
        for (;;) {
            __syncthreads();
            if (F.tid == 0) *qslot = __hip_atomic_fetch_add((unsigned*)(F.ctl + CW_QUEUE + 64 * rep_), 1u, __ATOMIC_RELAXED, __HIP_MEMORY_SCOPE_AGENT);
            __syncthreads();
            const int id = __builtin_amdgcn_readfirstlane((int)*qslot);
            if (id >= NU) break;
            if (rep_ == 1) { const bool is_attn = id < 512 || (id >= 1024 && id < 1280); if (is_attn ? !(MK_REP3 & 1) : !(MK_REP3 & 2)) continue; }
            if (id < 512) { const int b = id >> 6, head = (id >> 3) & 7, qb = id & 7; attn_unit(F, A, Obuf, M_CTX + b * LLAT + qb * 128, M_CTX + b * LKLAT, LKLAT / 64, head); }
            else if (id < 1024) hyena_unit<LLAT, 8>(F, A, id - 512);
            else if (id < 1280) { const int j = id - 1024, s = j >> 4, head = (j >> 1) & 7, qb = j & 1; attn_unit(F, A, Obuf, s * 256 + qb * 128, s * 256, LCTX / 64, head); }
            else hyena_unit<LCTX, 16>(F, A, id - 1280);
        }
    }
    GRID_BAR(); STOP_IF(3);
    REPK(4)
    {
        pg8::StaticOrder S; S.init(MROWS, D, F.G, (int)blockIdx.x);
        { pg8::Gemm g{WSP(const pg8::bf16_t, WS_O), WSP(const pg8::bf16_t, WS_WA), MROWS, D, D}; EpiT1 E{WSP(const bf16, WS_G), WSP(bf16, WS_V)};
          pg8::gemm_phase<EpiT1, pg8::StaticOrder, true, true>(F.lds + RING_OFF, g, S, E); }
        { pg8::Gemm g{WSP(const pg8::bf16_t, WS_XN), WSP(const pg8::bf16_t, WS_WH), MROWS, D, DH}; EpiMerge E{WSP(const bf16, WS_G), WSP(const bf16, WS_V), WSP(bf16, WS_K)};
          pg8::gemm_phase<EpiMerge, pg8::StaticOrder, true, true>(F.lds + RING_OFF, g, S, E); }
    }
    GRID_BAR(); STOP_IF(4);
    REPK(5) {
        pg8::Gemm g{WSP(const pg8::bf16_t, WS_K), WSP(const pg8::bf16_t, WS_WO), MROWS, D, D}; pg8::StaticOrder S; S.init(MROWS, D, F.G, (int)blockIdx.x);
        EpiRes E{A.in[0], A.in[1], WSP(const float, WS_MODF), 2048, F.out};
        pg8::gemm_phase<EpiRes, pg8::StaticOrder, true, true>(F.lds + RING_OFF, g, S, E);
    }
    GRID_BAR(); STOP_IF(5);
    REPK(6) { PHASE_BEGIN(); modnorm_rows(F, A, 1); }
    GRID_BAR(); STOP_IF(6);
    REPK(7) {
        pg8::Gemm g{WSP(const pg8::bf16_t, WS_XN), WSP(const pg8::bf16_t, WS_WUP), MROWS, FF, D}; pg8::StaticOrder S; S.init(MROWS, FF, F.G, (int)blockIdx.x);
        EpiUp E{WSP(bf16, WS_UP)};
        pg8::gemm_phase<EpiUp, pg8::StaticOrder, true, true>(F.lds + RING_OFF, g, S, E);
    }
    GRID_BAR(); STOP_IF(7);
    {
        pg8::Gemm g{WSP(const pg8::bf16_t, WS_UP), WSP(const pg8::bf16_t, WS_WDN), MROWS, D, FF}; pg8::StaticOrder S; S.init(MROWS, D, F.G, (int)blockIdx.x);
        EpiRes E{F.out, F.out + (size_t)M_CTX * D, WSP(const float, WS_MODF), 5120, F.out};
        pg8::gemm_phase<EpiRes, pg8::StaticOrder, true, true>(F.lds + RING_OFF, g, S, E);
    }
    GRID_BAR(); STOP_IF(8);
    PHASE_BEGIN(); final_norm_rows(F, A);
    if (MK_DEBUG && blockIdx.x == 0 && threadIdx.x == 0) { ((unsigned long long*)(F.ctl + TS_WORDS))[n_ts] = rt(); }

}

#if MK_DEBUG

#endif
extern "C" void kernel_launch(void* const* d_in, const int* in_sizes, int n_in, void* d_out, int out_size, void* d_ws, size_t ws_size, hipStream_t stream) {
    static int grid = 0;
    if (grid == 0) {
        if (n_in != 31 || out_size != MROWS * D + 2 * M_CTX * D || ws_size < WS_END) { fprintf(stderr, "kernel_launch: unexpected shapes (n_in %d out %d ws %zu)\n", n_in, out_size, ws_size); grid = -1; return; }
        int dev = 0, cus = 0;
        if (hipGetDevice(&dev) != hipSuccess || hipDeviceGetAttribute(&cus, hipDeviceAttributeMultiprocessorCount, dev) != hipSuccess) { grid = -1; return; }
        if (hipFuncSetAttribute((const void*)mk_fwd, hipFuncAttributeMaxDynamicSharedMemorySize, LDS_BYTES) != hipSuccess) { fprintf(stderr, "kernel_launch: hipFuncSetAttribute failed\n"); grid = -1; return; }
        int per_cu = 0;
        if (hipOccupancyMaxActiveBlocksPerMultiprocessor(&per_cu, (const void*)mk_fwd, NWAVES * 64, LDS_BYTES) != hipSuccess || per_cu < 1) { fprintf(stderr, "kernel_launch: occupancy query says %d\n", per_cu); }
        (void)hipGetLastError();
        grid = cus;
    }
    if (grid < 0) return;
    if (hipMemsetAsync((char*)d_ws + WS_CTL, 0, CTL_ZERO_BYTES, stream) != hipSuccess) return;
    Args a{};
    for (int i = 0; i < 31; ++i) a.in[i] = (const float*)d_in[i];
    a.out = (float*)d_out; a.ws = (unsigned char*)d_ws; a.stop_after = MK_STOP; a.pad = 0;
    hipLaunchKernelGGL(mk_fwd, dim3(grid), dim3(NWAVES * 64), LDS_BYTES, stream, a);
#if MK_DEBUG
    dbg_run(a, stream);
#endif
}
```

```cpp
#include <hip/hip_runtime.h>
#include <cstdio>
#include <cstdint>


#define MK_DEBUG 0
#define MK_STOP -1

namespace pg8 {
#define PG8_LAS __attribute__((address_space(3)))
typedef unsigned short bf16_t;
typedef short bf16x8 __attribute__((ext_vector_type(8)));
typedef float f32x4 __attribute__((ext_vector_type(4)));
typedef unsigned u32x4 __attribute__((ext_vector_type(4)));
constexpr int BM = 256, BK = 64, HALF = 128, HTB = HALF * BK * 2  , STAGE_BYTES = 8 * HTB, NXCD = 8, WGM = 8;

__host__ __device__ __forceinline__ int lds_byte(int r, int c) { const int st = (r >> 4) * 2 + (c >> 5), rr = r & 15, cc = c & 31, ob = rr * 64 + cc * 2; return st * 1024 + (ob ^ (((ob >> 9) & 1) << 5)); }
__host__ __device__ __forceinline__ void stage_rc(int b, int& R, int& C) { const int st = b / 1024, sb = b % 1024, swz = sb ^ (((sb >> 9) & 1) << 5); R = (st >> 1) * 16 + swz / 64; C = (st & 1) * 32 + (swz % 64) / 2; }
__host__ __device__ __forceinline__ int perm32(int rho) { const int n = rho >> 4, i = rho & 15; return 8 * (i >> 2) + 4 * n + (i & 3); }

struct Unit { int pm, pn; };
struct Gemm { const bf16_t* A; const bf16_t* Bt; int M, N, K; };

struct StaticOrder {
    int nM, nN, nwg, G, c;
    __host__ __device__ void init(int M, int N, int G_, int c_) { nM = M / BM; nN = N / BM; nwg = nM * nN; G = G_; c = c_; }
    __host__ __device__ bool next(int i, Unit& u) const {
        const long L = (long)i * G + c; if (L >= nwg) return false;
        int wgid = (int)L; { const int q = nwg / NXCD, r = nwg % NXCD, xcd = wgid % NXCD, off = wgid / NXCD; wgid = (xcd < r ? xcd * (q + 1) : r * (q + 1) + (xcd - r) * q) + off; }
        const int nig = WGM * nN, gid = wgid / nig, fm = gid * WGM, gsz = (nM - fm) < WGM ? (nM - fm) : WGM;
        u.pm = fm + ((wgid % nig) % gsz); u.pn = (wgid % nig) / gsz; return true;
    }
    __device__ __forceinline__ void a_ready(const Unit&) const {}
    __device__ __forceinline__ void done(const Unit&) const {}
};

__device__ __forceinline__ unsigned cvt_pk_bf16(float lo, float hi) { unsigned r; asm volatile("v_cvt_pk_bf16_f32 %0, %1, %2" : "=v"(r) : "v"(lo), "v"(hi)); return r; }
typedef float f32x2 __attribute__((ext_vector_type(2)));

template <class Epi, class Sched, bool ALIGN_EPI = false, bool SP2 = false>
__device__ __forceinline__ void gemm_phase(PG8_LAS unsigned char* lds, const Gemm g, const Sched& S, const Epi& E) {
    int tid_ = threadIdx.x; asm volatile("" : "+v"(tid_));
    const int tid = tid_, wid = __builtin_amdgcn_readfirstlane(tid >> 6), lane = tid & 63, wr = wid >> 2, wc = wid & 3, fr = lane & 15, fq = lane >> 4;
    const int K = g.K, nt = K / BK;
    unsigned voffA[2], voffB[2];
#pragma unroll
    for (int i = 0; i < 2; ++i) { int R, C; stage_rc(tid * 16 + i * 8192, R, C); const int Rb = Epi::PERM ? ((R & ~31) + perm32(R & 31)) : R;
        voffA[i] = (unsigned)(R * K + C) * 2u; voffB[i] = (unsigned)(Rb * K + C) * 2u; }
    const size_t kstep = (size_t)(BK * 2);
    const size_t hstep = (size_t)HALF * K * 2;
    const size_t tstep = 2 * hstep;
    const unsigned ldsw = (unsigned)wid * 1024u;
    const int aoff = lds_byte(wr * 64 + fr, fq * 8), boff = lds_byte(wc * 32 + fr, fq * 8);
#define PG8_SA(b, h) (((b) * 2 + (h)) * HTB)
#define PG8_SB(b, h) ((4 + (b) * 2 + (h)) * HTB)
#define PG8_STAGE(bufoff, gbase, voff) do { _Pragma("unroll") for (int _i = 0; _i < 2; ++_i) \
        __builtin_amdgcn_global_load_lds((const unsigned*)((const char*)(gbase) + (voff)[_i]), (PG8_LAS unsigned*)(lds + (bufoff) + ldsw + _i * 8192), 16, 0, 0); } while (0)
#define PG8_LDA(dst, b, h) do { _Pragma("unroll") for (int m = 0; m < 4; ++m) _Pragma("unroll") for (int k = 0; k < 2; ++k) dst[m][k] = *(const PG8_LAS bf16x8*)(lds + PG8_SA(b, h) + aoff + m * 2048 + k * 1024); } while (0)
#define PG8_LDB(dst, b, h) do { _Pragma("unroll") for (int n = 0; n < 2; ++n) _Pragma("unroll") for (int k = 0; k < 2; ++k) dst[n][k] = *(const PG8_LAS bf16x8*)(lds + PG8_SB(b, h) + boff + n * 2048 + k * 1024); } while (0)
#define PG8_MMA(ai, bj, At, Bt) do { __builtin_amdgcn_s_setprio(1); _Pragma("unroll") for (int m = 0; m < 4; ++m) _Pragma("unroll") for (int n = 0; n < 2; ++n) _Pragma("unroll") for (int k = 0; k < 2; ++k) \
        acc[ai][bj][m][n] = __builtin_amdgcn_mfma_f32_16x16x32_bf16(Bt[n][k], At[m][k], acc[ai][bj][m][n], 0, 0, 0); __builtin_amdgcn_s_setprio(0); } while (0)
#define PG8_WAIT_V(n) asm volatile("s_waitcnt vmcnt(" #n ")" ::: "memory")
#define PG8_WAIT_L(n) asm volatile("s_waitcnt lgkmcnt(" #n ")" ::: "memory")
#define PG8_BAR __builtin_amdgcn_s_barrier()
#define PG8_SCHED __builtin_amdgcn_sched_barrier(0)
    Unit cur, nxt; int ui = 0;
    if (!S.next(0, cur)) return;
    f32x4 acc[2][2][4][2];
#pragma unroll
    for (int a = 0; a < 2; ++a)
#pragma unroll
        for (int b = 0; b < 2; ++b)
#pragma unroll
            for (int m = 0; m < 4; ++m)
#pragma unroll
                for (int n = 0; n < 2; ++n) acc[a][b][m][n] = (f32x4){0.f, 0.f, 0.f, 0.f};
    bf16x8 At[4][2], B0[2][2], B1[2][2];
    const char* cA = (const char*)g.A + (size_t)cur.pm * tstep; const char* cB = (const char*)g.Bt + (size_t)cur.pn * tstep;
    S.a_ready(cur);
    if constexpr (SP2) {
        PG8_STAGE(PG8_SB(0, 0), cB, voffB); PG8_STAGE(PG8_SB(0, 1), cB + hstep, voffB); PG8_STAGE(PG8_SA(0, 0), cA, voffA); PG8_STAGE(PG8_SA(0, 1), cA + hstep, voffA);
        if (wr == 1) PG8_BAR;
        PG8_WAIT_V(2); PG8_BAR;
        PG8_STAGE(PG8_SB(1, 0), cB + kstep, voffB); PG8_STAGE(PG8_SA(1, 0), cA + kstep, voffA); PG8_STAGE(PG8_SB(1, 1), cB + hstep + kstep, voffB);
        PG8_WAIT_V(6); PG8_BAR;
    } else {
        PG8_STAGE(PG8_SB(0, 0), cB, voffB); PG8_STAGE(PG8_SA(0, 0), cA, voffA); PG8_STAGE(PG8_SB(0, 1), cB + hstep, voffB); PG8_STAGE(PG8_SA(0, 1), cA + hstep, voffA);
        if (wr == 1) PG8_BAR;
        PG8_WAIT_V(4); PG8_BAR;
        PG8_STAGE(PG8_SB(1, 0), cB + kstep, voffB); PG8_STAGE(PG8_SA(1, 0), cA + kstep, voffA); PG8_STAGE(PG8_SB(1, 1), cB + hstep + kstep, voffB);
        PG8_WAIT_V(6); PG8_BAR;
    }
    for (;;) {
        const bool has_next = S.next(ui + 1, nxt);
        const char* nA = has_next ? (const char*)g.A + (size_t)nxt.pm * tstep : cA; const char* nB = has_next ? (const char*)g.Bt + (size_t)nxt.pn * tstep : cB;
        for (int t = 0; t < nt; t += 2) {
            const bool last = (t == nt - 2);
            const char* a1 = cA + (size_t)(t + 1) * kstep;
            const char* a2 = last ? nA : cA + (size_t)(t + 2) * kstep; const char* b2 = last ? nB : cB + (size_t)(t + 2) * kstep;
            const char* a3 = a2 + kstep; const char* b3 = b2 + kstep;
            if (last && has_next) S.a_ready(nxt);
            if constexpr (SP2) {
            PG8_LDB(B0, 0, 0); PG8_LDB(B1, 0, 1); PG8_SCHED; PG8_LDA(At, 0, 0); PG8_STAGE(PG8_SA(1, 1), a1 + hstep, voffA);
            PG8_WAIT_V(8); PG8_WAIT_L(0); PG8_BAR; PG8_MMA(0, 0, At, B0); PG8_MMA(0, 1, At, B1); PG8_BAR; PG8_SCHED;
            PG8_LDA(At, 0, 1); PG8_STAGE(PG8_SB(0, 0), b2, voffB); PG8_STAGE(PG8_SB(0, 1), b2 + hstep, voffB); PG8_STAGE(PG8_SA(0, 0), a2, voffA);
            PG8_WAIT_V(8); PG8_WAIT_L(0); PG8_BAR; PG8_MMA(1, 0, At, B0); PG8_MMA(1, 1, At, B1); PG8_BAR; PG8_SCHED;
            PG8_LDB(B0, 1, 0); PG8_LDB(B1, 1, 1); PG8_SCHED; PG8_LDA(At, 1, 0); PG8_STAGE(PG8_SA(0, 1), a2 + hstep, voffA);
            PG8_WAIT_V(8); PG8_WAIT_L(0); PG8_BAR; PG8_MMA(0, 0, At, B0); PG8_MMA(0, 1, At, B1); PG8_BAR; PG8_SCHED;
            PG8_LDA(At, 1, 1); PG8_STAGE(PG8_SB(1, 0), b3, voffB); PG8_STAGE(PG8_SB(1, 1), b3 + hstep, voffB); PG8_STAGE(PG8_SA(1, 0), a3, voffA);
            PG8_WAIT_V(8); PG8_WAIT_L(0); PG8_BAR; PG8_MMA(1, 0, At, B0); PG8_MMA(1, 1, At, B1); PG8_BAR; PG8_SCHED;
            } else {
            PG8_LDB(B0, 0, 0); PG8_SCHED; PG8_LDA(At, 0, 0); PG8_STAGE(PG8_SA(1, 1), a1 + hstep, voffA);
            PG8_WAIT_L(8); PG8_BAR; PG8_WAIT_L(0); PG8_MMA(0, 0, At, B0); PG8_BAR; PG8_SCHED;
            PG8_LDB(B1, 0, 1); PG8_STAGE(PG8_SB(0, 0), b2, voffB);
            PG8_BAR; PG8_WAIT_L(0); PG8_MMA(0, 1, At, B1); PG8_BAR;
            PG8_LDA(At, 0, 1); PG8_STAGE(PG8_SA(0, 0), a2, voffA);
            PG8_BAR; PG8_WAIT_L(0); PG8_MMA(1, 0, At, B0); PG8_BAR; PG8_SCHED;
            PG8_STAGE(PG8_SB(0, 1), b2 + hstep, voffB);
            PG8_WAIT_V(6); PG8_BAR; PG8_MMA(1, 1, At, B1); PG8_BAR;
            PG8_LDB(B0, 1, 0); PG8_SCHED; PG8_LDA(At, 1, 0); PG8_STAGE(PG8_SA(0, 1), a2 + hstep, voffA);
            PG8_WAIT_L(8); PG8_BAR; PG8_WAIT_L(0); PG8_MMA(0, 0, At, B0); PG8_BAR; PG8_SCHED;
            PG8_LDB(B1, 1, 1); PG8_STAGE(PG8_SB(1, 0), b3, voffB);
            PG8_BAR; PG8_WAIT_L(0); PG8_MMA(0, 1, At, B1); PG8_BAR;
            PG8_LDA(At, 1, 1); PG8_STAGE(PG8_SA(1, 0), a3, voffA);
            PG8_BAR; PG8_WAIT_L(0); PG8_MMA(1, 0, At, B0); PG8_BAR; PG8_SCHED;
            PG8_STAGE(PG8_SB(1, 1), b3 + hstep, voffB);
            PG8_WAIT_V(6); PG8_BAR; PG8_MMA(1, 1, At, B1); PG8_BAR;
            }
        }
        if constexpr (ALIGN_EPI) { if (wr == 0) PG8_BAR; }
        if constexpr (!Epi::AFTER_DRAIN) { E(acc, cur, wr, wc, fr, fq); S.done(cur); }
        if (!has_next) break;
#pragma unroll
        for (int a = 0; a < 2; ++a)
#pragma unroll
            for (int b = 0; b < 2; ++b)
#pragma unroll
                for (int m = 0; m < 4; ++m)
#pragma unroll
                    for (int n = 0; n < 2; ++n) acc[a][b][m][n] = (f32x4){0.f, 0.f, 0.f, 0.f};
        cur = nxt; cA = nA; cB = nB; ++ui;
        if constexpr (ALIGN_EPI) { if (wr == 1) PG8_BAR; }
    }
    PG8_WAIT_V(0);
    if constexpr (!ALIGN_EPI) { if (wr == 0) PG8_BAR; }
    PG8_BAR;
    if constexpr (Epi::AFTER_DRAIN) { E.fused(acc, cur, wr, wc, fr, fq, lds, wid, lane); S.done(cur); }
#undef PG8_SA
#undef PG8_SB
#undef PG8_STAGE
#undef PG8_LDA
#undef PG8_LDB
#undef PG8_MMA
#undef PG8_WAIT_V
#undef PG8_WAIT_L
#undef PG8_BAR
#undef PG8_SCHED
}
}

constexpr bool PG8_SP2 = true, PG8_ALIGN = true;

#define GAS __attribute__((address_space(1)))
#define LAS __attribute__((address_space(3)))
typedef unsigned short bf16;
typedef unsigned v4u __attribute__((ext_vector_type(4)));
typedef float f32x4 __attribute__((ext_vector_type(4)));
typedef short bf16x8 __attribute__((ext_vector_type(8)));
typedef GAS unsigned gu32;
typedef GAS unsigned long long gu64;
#define RLX_AGENT __ATOMIC_RELAXED, __HIP_MEMORY_SCOPE_AGENT
#define LDS_WAIT() asm volatile("s_waitcnt lgkmcnt(0)" ::: "memory")
#define VM_WAIT() asm volatile("s_waitcnt vmcnt(0)" ::: "memory")
__device__ __forceinline__ unsigned long long rt() { return __builtin_amdgcn_s_memrealtime(); }
__device__ __forceinline__ unsigned f2bf(float f) { unsigned u = __builtin_bit_cast(unsigned, f); return (u + 0x7fffu + ((u >> 16) & 1u)) >> 16; }
__device__ __forceinline__ unsigned pk2(float lo, float hi) { return f2bf(lo) | (f2bf(hi) << 16); }

#define XB_TMO      128
#define XB_XCNT(j)  (256  + 64 * (j))
#define XB_XSUB(j)  (1280 + 64 * (j))
#define XB_XGEN(j)  (2304 + 64 * (j))
#define XB_TOP      3328
#define XB_TOPGEN   3392
#define XCD_BAR_WORDS 3456
#define XB_SPIN_CAP (1u << 18)

__device__ __forceinline__ unsigned xb_ld(unsigned* p)              { return __hip_atomic_load(p, __ATOMIC_RELAXED, __HIP_MEMORY_SCOPE_AGENT); }
__device__ __forceinline__ unsigned xb_add(unsigned* p, unsigned v) { return __hip_atomic_fetch_add(p, v, __ATOMIC_RELAXED, __HIP_MEMORY_SCOPE_AGENT); }
__device__ __forceinline__ unsigned xb_xcc_id() { return (unsigned)__builtin_amdgcn_s_getreg((3 << 11) | 20) & 0xFu; }
#define XB_SPIN(cond, bar) do { unsigned _sp = 0; while (cond) { __builtin_amdgcn_s_sleep(1); \
    if ((++_sp & 255u) == 0u) { if (xb_ld(&(bar)[XB_TMO])) break; if (_sp > XB_SPIN_CAP) { atomicAdd(&(bar)[XB_TMO], 1u); break; } } } } while (0)

struct XcdBarrier {
    unsigned* bar; unsigned x;
    volatile LAS unsigned* st;
};

__device__ __forceinline__ XcdBarrier xcd_barrier_post(unsigned* bar, volatile LAS unsigned* st) {
    XcdBarrier b; b.bar = bar; b.x = xb_xcc_id(); b.st = st;
    if (threadIdx.x == 0) (void)xb_add(&bar[XB_XCNT(b.x)], 1u);
    return b;
}
__device__ __forceinline__ void xcd_barrier_complete(unsigned* bar, unsigned x, unsigned& nloc, unsigned& nx) {
    const unsigned G = gridDim.x * gridDim.y * gridDim.z;
    unsigned sum, cnt, mine, sp = 0u;
    for (;;) {
        sum = 0u; cnt = 0u; mine = 0u;
#pragma unroll
        for (unsigned j = 0; j < 16; ++j) { const unsigned c = xb_ld(&bar[XB_XCNT(j)]); sum += c; cnt += (c > 0u) ? 1u : 0u; mine = (j == x) ? c : mine; }
        if (sum == G) break;
        __builtin_amdgcn_s_sleep(1);
        if ((++sp & 255u) == 0u) { if (xb_ld(&bar[XB_TMO])) break; if (sp > XB_SPIN_CAP) { atomicAdd(&bar[XB_TMO], 1u); break; } }
    }
    nloc = mine > 0u ? mine : 1u; nx = cnt > 0u ? cnt : 1u;
}

__device__ __forceinline__ void xcd_barrier(const XcdBarrier& b) {
    asm volatile("s_waitcnt vmcnt(0)" ::: "memory");
    __syncthreads();
    if (threadIdx.x == 0) {
        unsigned* bar = b.bar;
        __builtin_amdgcn_s_waitcnt(0);
        unsigned nloc = b.st[0], nx = b.st[1];
        if (nloc == 0u) { xcd_barrier_complete(bar, b.x, nloc, nx); b.st[0] = nloc; b.st[1] = nx; }
        const unsigned old = xb_add(&bar[XB_XSUB(b.x)], 1u);
        const unsigned gen = old / nloc;
        if (old + 1u == (gen + 1u) * nloc) {
            __builtin_amdgcn_fence(__ATOMIC_RELEASE, "agent");
            asm volatile("s_waitcnt vmcnt(0)" ::: "memory");
            const unsigned og = xb_add(&bar[XB_TOP], 1u);
            const unsigned tg = og / nx;
            if (og + 1u == (tg + 1u) * nx) xb_add(&bar[XB_TOPGEN], 1u);
            else XB_SPIN(xb_ld(&bar[XB_TOPGEN]) == tg, bar);
            __builtin_amdgcn_fence(__ATOMIC_ACQUIRE, "agent");
            xb_add(&bar[XB_XGEN(b.x)], 1u);
            asm volatile("s_waitcnt vmcnt(0)" ::: "memory");
        } else {
            XB_SPIN(xb_ld(&bar[XB_XGEN(b.x)]) == gen, bar);
            __builtin_amdgcn_fence(__ATOMIC_ACQUIRE, "agent");
            asm volatile("s_waitcnt vmcnt(0)" ::: "memory");
        }
    }
    __syncthreads();
}

__device__ __forceinline__ float wave_sum(float v) {
#pragma unroll
    for (int o = 1; o < 64; o <<= 1) v += __shfl_xor(v, o);
    return v;
}
__device__ __forceinline__ void p0_transpose_item(const float* W, int K, int N, bf16* WT, int row_off, LAS float* scr, int item, int lane) {
    const int nblk = N / 32, kb = item / nblk, nb = item % nblk, k0 = 64 * kb, n0 = 32 * nb;
    float tv[32];
#pragma unroll
    for (int i = 0; i < 32; ++i) tv[i] = W[(size_t)(k0 + 2 * i + (lane >> 5)) * N + n0 + (lane & 31)];
#pragma unroll
    for (int i = 0; i < 32; ++i) scr[(2 * i + (lane >> 5)) * 33 + (lane & 31)] = tv[i];
    LDS_WAIT(); asm volatile("" ::: "memory");
    const int c = lane & 7;
#pragma unroll
    for (int j = 0; j < 4; ++j) { const int n = (lane >> 3) + 8 * j; const LAS float* s = scr + (8 * c) * 33 + n;
        v4u o; o.x = pk2(s[0 * 33], s[1 * 33]); o.y = pk2(s[2 * 33], s[3 * 33]); o.z = pk2(s[4 * 33], s[5 * 33]); o.w = pk2(s[6 * 33], s[7 * 33]);
        *(GAS v4u*)(WT + (size_t)(row_off + n0 + n) * K + k0 + 8 * c) = o; }
    LDS_WAIT(); asm volatile("" ::: "memory");
}

#ifndef MK_PROBE_ST
#define MK_PROBE_ST 0
#endif
#ifndef MK_REP0
#define MK_REP0 0
#endif
constexpr int NWAVES = 8;
constexpr int D = 1024, M_CTX = 4096, M_LAT = 8192, MROWS = 12288, INC = 6656, FF = 4096, DH = 512, HYC = 1536;
constexpr int LCTX = 256, LLAT = 1024, PAST = 256, LKLAT = 1280, KROWS = M_CTX + 8 * LKLAT;
constexpr float EPSN = 1e-6f, LAM_INIT = 0.2f;
constexpr float QSCALE = 0.125f * 1.4426950408889634f;
constexpr size_t MiB = 1u << 20;
constexpr size_t WS_CTL = 0, CTL_ZERO_BYTES = 1 * MiB;
constexpr size_t WS_WIN = 1 * MiB, WS_WA = 14 * MiB, WS_WH = 16 * MiB, WS_WO = 17 * MiB, WS_WUP = 19 * MiB, WS_WDN = 27 * MiB;
constexpr size_t WS_MODP = 232 * MiB;
constexpr size_t WS_MODF = 37 * MiB;
constexpr size_t WS_ROPE = 38 * MiB;
constexpr size_t WS_H2 = 38 * MiB + 65536;
constexpr size_t WS_FILT = 39 * MiB;
constexpr size_t WS_XN = 44 * MiB;
constexpr size_t WS_Q = 68 * MiB;
constexpr size_t WS_K = 92 * MiB;
constexpr size_t WS_V = 120 * MiB;
constexpr size_t WS_UT = 148 * MiB;
constexpr size_t WS_G = 184 * MiB;
constexpr size_t WS_UP = 68 * MiB;
constexpr size_t WS_O = 232 * MiB;
constexpr size_t WS_END = 256 * MiB;
constexpr int CW_TMO = 0, CW_CODE = 1, CW_QUEUE = 64, CW_BAR = 4096;
constexpr int DBG_WORDS = 8192, TS_WORDS = 12288;
constexpr int RING_OFF = 0, RING_BYTES = 131072, LDSCTL_OFF = RING_BYTES, MISC_OFF = LDSCTL_OFF + 320, LDS_BYTES = 147456;

struct Args { const float* in[31]; float* out; unsigned char* ws; int stop_after; int pad; };
struct Frame {
    LAS unsigned char* lds; volatile LAS unsigned* MISC; gu32* ctl;
    int tid, lane, wave, vcu, G;
    float* out; unsigned char* ws;
};
#define WSP(T, off) ((T*)(F.ws + (off)))
__device__ __forceinline__ float bf2f(bf16 h) { return __uint_as_float((unsigned)h << 16); }
__device__ __forceinline__ const float* xrow_ptr(const Frame& F, const Args& A, int row) { return row < M_CTX ? A.in[0] + (size_t)row * D : A.in[1] + (size_t)(row - M_CTX) * D; }
__device__ __forceinline__ int mod_row(int row) { return row < M_CTX ? 0 : 1 + ((row - M_CTX) >> 10); }

__device__ __forceinline__ void p0_mod_item(const Frame& F, const Args& A, LAS float* scr, int item) {
    const int cb = item >> 3, kc = item & 7, lane = F.lane, col = cb * 64 + lane, k0 = kc * 128;
    float sv0[9], sv1[9];
#pragma unroll
    for (int r = 0; r < 9; ++r) { const float* cv = (r == 0) ? A.in[5] : A.in[4] + (r - 1) * D; const float x0 = cv[k0 + lane], x1 = cv[k0 + 64 + lane];
        sv0[r] = x0 / (1.f + expf(-x0)); sv1[r] = x1 / (1.f + expf(-x1)); }
    float acc[9];
#pragma unroll
    for (int r = 0; r < 9; ++r) acc[r] = 0.f;
    const float* wp = A.in[6] + (size_t)k0 * 6144 + col;
#pragma unroll 1
    for (int kb = 0; kb < 4; ++kb, wp += 32 * 6144) { float w[32];
#pragma unroll
        for (int k = 0; k < 32; ++k) w[k] = wp[(size_t)k * 6144];
        float svr[9];
#pragma unroll
        for (int r = 0; r < 9; ++r) svr[r] = kb < 2 ? sv0[r] : sv1[r];
        const int lb = (kb & 1) * 32;
#pragma unroll
        for (int k = 0; k < 32; ++k)
#pragma unroll
            for (int r = 0; r < 9; ++r) acc[r] += __int_as_float(__builtin_amdgcn_readlane(__float_as_int(svr[r]), lb + k)) * w[k]; }
    float* mp = WSP(float, WS_MODP) + (size_t)kc * 9 * 6144 + col;
#pragma unroll
    for (int r = 0; r < 9; ++r) mp[r * 6144] = acc[r];
    (void)scr;
}
__device__ __forceinline__ void p0_cache_item(const Frame& F, const Args& A, int r) {
    const int b = r >> 8, j = r & 255; const size_t drow = (size_t)(M_CTX + b * LKLAT + j) * D;
    const GAS f32x4* sk = (const GAS f32x4*)(A.in[2] + (size_t)r * D) + F.lane; const GAS f32x4* sv = (const GAS f32x4*)(A.in[3] + (size_t)r * D) + F.lane;
    GAS unsigned long long* dk = (GAS unsigned long long*)(WSP(bf16, WS_K) + drow) + F.lane; GAS unsigned long long* dv = (GAS unsigned long long*)(WSP(bf16, WS_V) + drow) + F.lane;
#pragma unroll
    for (int q = 0; q < 4; ++q) { const f32x4 a = sk[64 * q], c = sv[64 * q];
        dk[64 * q] = (unsigned long long)pk2(a.x, a.y) | ((unsigned long long)pk2(a.z, a.w) << 32);
        dv[64 * q] = (unsigned long long)pk2(c.x, c.y) | ((unsigned long long)pk2(c.z, c.w) << 32); }
}
__device__ __forceinline__ void p0_rope_item(const Frame& F, const Args& A) {
    float* tb = WSP(float, WS_ROPE);
    for (int e = F.lane; e < 1024; e += 64) { const int pos = e >> 4, i = e & 15; const float inv = powf(10000.0f, -(float)i / 16.0f); const float ang = (float)pos * inv;
        tb[2 * e] = cosf(ang); tb[2 * e + 1] = sinf(ang); }
}
__device__ __forceinline__ void p0_filter_item(const Frame& F, const Args& A, LAS float* scr, const LAS float* wsh, int item) {
    const int lane = F.lane; const bool big = item >= 256; const int L = big ? 1024 : 256, t = big ? item - 256 : item; const float tt = (float)t / (float)(L - 1);
    const LAS float* w1s = wsh + lane; const LAS float* w2s = wsh + 33 * 64 + lane;
    if (lane < 33) { float e;
        if (lane == 0) e = tt;
        else { const int bnd = (lane - 1) & 15; const float f = 1e-4f + (float)bnd * ((15.0f - 1e-4f) / 15.0f); const float wpos = 2.0f * 3.14159265358979323846f * (float)t / (float)L; const float a = f * wpos;
            e = (lane <= 16) ? cosf(a) : -sinf(a); }
        scr[lane] = e; }
    LDS_WAIT(); asm volatile("" ::: "memory");
    const float fr = A.in[23][lane];
    float acc = A.in[19][lane];
#pragma unroll
    for (int i = 0; i < 33; ++i) acc += scr[i] * w1s[i * 64];
    scr[64 + lane] = sinf(fr * acc);
    LDS_WAIT(); asm volatile("" ::: "memory");
    float acc2 = A.in[21][lane];
#pragma unroll
    for (int i = 0; i < 64; ++i) acc2 += scr[64 + i] * w2s[i * 64];
    WSP(float, WS_H2)[(size_t)lane * 1280 + item] = sinf(fr * acc2);
    LDS_WAIT(); asm volatile("" ::: "memory");
}
typedef float f32x16t __attribute__((ext_vector_type(16)));
__device__ __forceinline__ void p1_taps_item(const Frame& F, const Args& A, int item) {
    const int lane = F.lane, r32 = lane & 31, hi = lane >> 5, cp = item & 31, pb = item >> 5; const bool big = pb >= 8; const int L = big ? 1024 : 256;
    const int t = (big ? pb - 8 : pb) * 32 + r32, pos = (big ? 256 : 0) + t, col0 = cp * 32;
    const float* wp = A.in[22] + (size_t)hi * 2048 + col0 + r32; const float* hp = WSP(const float, WS_H2) + (size_t)hi * 1280 + pos;
    f32x16t cf = f32x16t{}, cb = f32x16t{};
#pragma unroll 4
    for (int st = 0; st < 32; ++st) { const float wf = wp[(size_t)st * 4096], wb = wp[(size_t)st * 4096 + 1024], h = hp[(size_t)st * 2560];
        cf = __builtin_amdgcn_mfma_f32_32x32x2f32(wf, h, cf, 0, 0, 0); cb = __builtin_amdgcn_mfma_f32_32x32x2f32(wb, h, cb, 0, 0, 0); }
    bf16* R = WSP(bf16, WS_FILT) + (big ? (size_t)(1 * MiB / 2) : 0);
    const float d0 = logf(1e-2f) / 0.3f, d1 = logf(1e-2f) / 1.5f; const float tt = (float)t / (float)(L - 1);
#pragma unroll
    for (int r = 0; r < 16; ++r) { const int col = col0 + (r & 3) + 8 * (r >> 2) + 4 * hi, ch = col & 511, ord = col >> 9; const float dec = expf(-tt * fabsf(d0 + (d1 - d0) * (float)ch / 511.0f));
        bf16* Rc = R + ((size_t)ord * 512 + ch) * (2 * L);
        if (t == 0) { Rc[L] = (bf16)f2bf((cf[r] + cb[r]) * dec); Rc[0] = 0; } else { Rc[L - t] = (bf16)f2bf(cf[r] * dec); Rc[L + t] = (bf16)f2bf(cb[r] * dec); } }
}
__device__ __forceinline__ void p0_prologue(const Frame& F, const Args& A) {
    LAS float* scr = (LAS float*)(F.lds + RING_OFF + F.wave * 9216);
    LAS float* wsh = (LAS float*)(F.lds + RING_OFF + 8 * 9216);
    for (int i = F.tid; i < 33 * 64 + 64 * 64; i += NWAVES * 64) wsh[i] = i < 33 * 64 ? A.in[18][i] : A.in[20][i - 33 * 64];
    __syncthreads();
    const int gw = F.vcu * NWAVES + F.wave, NGW = F.G * NWAVES;
    constexpr int I_IN = (D / 64) * (INC / 32), I_A = (D / 64) * (D / 32), I_H = (DH / 64) * (D / 32);
    constexpr int N_MOD = 768, N_CACHE = 2048, N_FILT = 1280;
    if (NGW == 2048) { if (gw < N_FILT) { for (int q_ = 0; q_ <= (MK_REP0 & 1); ++q_) p0_filter_item(F, A, scr, wsh, gw); } else { for (int q_ = 0; q_ <= ((MK_REP0 >> 1) & 1); ++q_) p0_mod_item(F, A, scr, gw - N_FILT); } }
    else { for (int it = gw; it < N_FILT; it += NGW) p0_filter_item(F, A, scr, wsh, it); for (int it = gw; it < N_MOD; it += NGW) p0_mod_item(F, A, scr, it); }
    if (gw == NGW - 1) p0_rope_item(F, A);
    for (int q_ = 0; q_ <= ((MK_REP0 >> 2) & 1); ++q_) for (int it = gw; it < N_CACHE; it += NGW) p0_cache_item(F, A, it);
    for (int q_ = 0; q_ <= ((MK_REP0 >> 3) & 1); ++q_) for (int it = gw; it < I_IN + I_A + I_H; it += NGW) {
        int r = it;
        if (r < I_IN) { p0_transpose_item(A.in[10], D, INC, WSP(bf16, WS_WIN), 0, scr, r, F.lane); continue; } r -= I_IN;
        if (r < I_A) { p0_transpose_item(A.in[25], D, D, WSP(bf16, WS_WA), 0, scr, r, F.lane); continue; } r -= I_A;
        p0_transpose_item(A.in[26], DH, D, WSP(bf16, WS_WH), 0, scr, r, F.lane);
    }
}
constexpr int N_TRU = 72;
__device__ __forceinline__ void p3_transpose_unit(const Frame& F, const Args& A, int u) {
    constexpr int I_O = (D / 64) * (D / 32), I_UP = (D / 64) * (FF / 32);
    LAS float* scr = (LAS float*)(F.lds + RING_OFF + F.wave * 9216);
#pragma unroll 1
    for (int j = 0; j < 8; ++j) { int r = u * 64 + F.wave * 8 + j;
        if (r < I_O) { p0_transpose_item(A.in[27], D, D, WSP(bf16, WS_WO), 0, scr, r, F.lane); continue; } r -= I_O;
        if (r < I_UP) { p0_transpose_item(A.in[28], D, FF, WSP(bf16, WS_WUP), 0, scr, r, F.lane); continue; } r -= I_UP;
        p0_transpose_item(A.in[29], FF, D, WSP(bf16, WS_WDN), 0, scr, r, F.lane); }
}
__device__ __forceinline__ void modnorm_rows(const Frame& F, const Args& A, int which) {
    const int gw = F.vcu * NWAVES + F.wave, NGW = F.G * NWAVES, lane = F.lane;
    const float* gvec = which ? A.in[9] : A.in[8]; const int shoff = which ? 3072 : 0, scoff = which ? 4096 : 1024;
    if (which == 0) { for (int it = gw; it < 1280; it += NGW) p1_taps_item(F, A, it); }
    for (int ch = gw; ch < MROWS / 6; ch += NGW) {
        int cur = -1; f32x4 av[4], sv[4];
        for (int rr = 0; rr < 6; ++rr) { const int row = ch * 6 + rr; const int mr = mod_row(row);
            if (mr != cur) { cur = mr;
#pragma unroll
                for (int j = 0; j < 4; ++j) { const int c = 4 * lane + 256 * j; f32x4 sh, sc;
                    if (which == 0) { sh = *(const GAS f32x4*)(A.in[7] + c); sc = *(const GAS f32x4*)(A.in[7] + 1024 + c);
                        for (int kc = 0; kc < 8; ++kc) { const float* mp = WSP(float, WS_MODP) + ((size_t)kc * 9 + mr) * 6144; sh += *(const GAS f32x4*)(mp + c); sc += *(const GAS f32x4*)(mp + 1024 + c); } }
                    else { const float* mf = WSP(float, WS_MODF) + (size_t)mr * 6144; sh = *(const GAS f32x4*)(mf + shoff + c); sc = *(const GAS f32x4*)(mf + scoff + c); }
                    const f32x4 g = *(const GAS f32x4*)(gvec + c); av[j] = g * (sc + 1.0f); sv[j] = sh; } }
            const float* xr = which ? F.out + (size_t)row * D : xrow_ptr(F, A, row);
            f32x4 v[4]; float s = 0.f;
#pragma unroll
            for (int j = 0; j < 4; ++j) { v[j] = *(const GAS f32x4*)(xr + 4 * lane + 256 * j); s += (v[j].x * v[j].x + v[j].y * v[j].y) + (v[j].z * v[j].z + v[j].w * v[j].w); }
            const float rstd = 1.f / sqrtf(wave_sum(s) * (1.f / D) + EPSN);
            GAS unsigned long long* o8 = (GAS unsigned long long*)(WSP(bf16, WS_XN) + (size_t)row * D) + lane;
#pragma unroll
            for (int j = 0; j < 4; ++j) { const f32x4 y = v[j] * rstd * av[j] + sv[j]; o8[64 * j] = (unsigned long long)pk2(y.x, y.y) | ((unsigned long long)pk2(y.z, y.w) << 32); } }
    }
    if (which == 0) {
        for (int it = gw; it < 9 * 6144 / 64; it += NGW) { const int idx = it * 64 + lane, r = idx / 6144, col = idx % 6144; float a = A.in[7][col];
            for (int kc = 0; kc < 8; ++kc) a += WSP(float, WS_MODP)[((size_t)kc * 9 + r) * 6144 + col];
            WSP(float, WS_MODF)[idx] = a; } }
}
struct EpiIn {
    static constexpr bool PERM = true, AFTER_DRAIN = false;
    bf16 *Q, *Kb, *Vb, *UT, *G; float *nk, *nv; const float* rope;
    __device__ __forceinline__ void operator()(const pg8::f32x4 (&acc)[2][2][4][2], const pg8::Unit& u, int wr, int wc, int fr, int fq) const {
        using pg8::f32x4; using pg8::u32x4;
        const int pn = u.pn, pm = u.pm; const bool lat = pm >= 16;
        const int rowt = pm * 256 + wr * 64 + fr;
        if (pn < 12) {
            const int typ = pn >> 2, cb = (pn & 3) * 256 + wc * 32 + 8 * fq;
            const int lb = (pm - 16) >> 2, t0 = ((pm - 16) & 3) * 256 + wr * 64 + fr;
#pragma unroll
            for (int ai = 0; ai < 2; ++ai)
#pragma unroll
                for (int m = 0; m < 4; ++m) {
                    const int row = rowt + ai * 128 + m * 16, t = t0 + ai * 128 + m * 16;
#pragma unroll
                    for (int bj = 0; bj < 2; ++bj) {
                        f32x4 v0 = acc[ai][bj][m][0], v1 = acc[ai][bj][m][1];
                        if (lat && typ < 2) {
                            const int pos = (wc & 1) ? (t & 63) : (t >> 6);
                            const float* tb = rope + (size_t)pos * 32 + (8 * (fq & 1)) * 2;
                            const f32x4 c0 = *(const f32x4*)(tb), c1 = *(const f32x4*)(tb + 4), c2 = *(const f32x4*)(tb + 8), c3 = *(const f32x4*)(tb + 12);
                            f32x4 p0, p1;
                            p0.x = __shfl_xor(v0.x, 32); p0.y = __shfl_xor(v0.y, 32); p0.z = __shfl_xor(v0.z, 32); p0.w = __shfl_xor(v0.w, 32);
                            p1.x = __shfl_xor(v1.x, 32); p1.y = __shfl_xor(v1.y, 32); p1.z = __shfl_xor(v1.z, 32); p1.w = __shfl_xor(v1.w, 32);
                            const float sg = (fq < 2) ? -1.f : 1.f;
                            v0.x = v0.x * c0.x + sg * p0.x * c0.y; v0.y = v0.y * c0.z + sg * p0.y * c0.w; v0.z = v0.z * c1.x + sg * p0.z * c1.y; v0.w = v0.w * c1.z + sg * p0.w * c1.w;
                            v1.x = v1.x * c2.x + sg * p1.x * c2.y; v1.y = v1.y * c2.z + sg * p1.y * c2.w; v1.z = v1.z * c3.x + sg * p1.z * c3.y; v1.w = v1.w * c3.z + sg * p1.w * c3.w;
                        }
                        const int col = cb + bj * 128;
                        if (!lat && typ > 0) { float* op = (typ == 1 ? nk : nv) + (size_t)row * D + col; *(f32x4*)op = v0; *(f32x4*)(op + 4) = v1; }
                        if (typ == 0) { v0 = v0 * QSCALE; v1 = v1 * QSCALE; }
                        u32x4 w; w.x = pg8::cvt_pk_bf16(v0[0], v0[1]); w.y = pg8::cvt_pk_bf16(v0[2], v0[3]); w.z = pg8::cvt_pk_bf16(v1[0], v1[1]); w.w = pg8::cvt_pk_bf16(v1[2], v1[3]);
                        bf16* dst;
                        if (typ == 0) dst = Q + (size_t)row * D + col;
                        else { const size_t kr = lat ? (size_t)(M_CTX + lb * LKLAT + PAST + t) : (size_t)row; dst = (typ == 1 ? Kb : Vb) + kr * D + col; }
                        *(u32x4*)dst = w;
                    }
                }
        } else if (pn < 18) {
            const int cb = (pn - 12) * 256 + wc * 32 + 8 * fq;
#pragma unroll
            for (int ai = 0; ai < 2; ++ai)
#pragma unroll
                for (int m = 0; m < 4; ++m) { const int row = rowt + ai * 128 + m * 16;
#pragma unroll
                    for (int bj = 0; bj < 2; ++bj)
#pragma unroll
                        for (int n = 0; n < 2; ++n)
#pragma unroll
                            for (int e = 0; e < 4; ++e) UT[(size_t)(cb + bj * 128 + 4 * n + e) * MROWS + row] = (bf16)f2bf(acc[ai][bj][m][n][e]); }
        } else {
            const int cb = (pn - 18) * 256 + wc * 32 + 8 * fq;
#pragma unroll
            for (int ai = 0; ai < 2; ++ai)
#pragma unroll
                for (int m = 0; m < 4; ++m) { const int row = rowt + ai * 128 + m * 16;
#pragma unroll
                    for (int bj = 0; bj < 2; ++bj) { f32x4 v0 = acc[ai][bj][m][0], v1 = acc[ai][bj][m][1];
#pragma unroll
                        for (int e = 0; e < 4; ++e) { v0[e] = 1.f / (1.f + __expf(-v0[e])); v1[e] = 1.f / (1.f + __expf(-v1[e])); }
                        u32x4 w; w.x = pg8::cvt_pk_bf16(v0[0], v0[1]); w.y = pg8::cvt_pk_bf16(v0[2], v0[3]); w.z = pg8::cvt_pk_bf16(v1[0], v1[1]); w.w = pg8::cvt_pk_bf16(v1[2], v1[3]);
                        *(u32x4*)(G + (size_t)row * 2048 + cb + bj * 128) = w; } }
        }
    }
};

typedef float f32x16 __attribute__((ext_vector_type(16)));
typedef short s16x4 __attribute__((ext_vector_type(4)));
constexpr int AT_KV = 32768;
static_assert(4 * AT_KV <= RING_BYTES, "attention LDS");
__device__ __forceinline__ unsigned off_b(unsigned row, unsigned ch) { return 256u * row + 16u * (ch ^ (((row & 3u) << 2) | ((row >> 2) & 3u))); }
__device__ __forceinline__ s16x4 tr16(LAS unsigned char* p) { return __builtin_bit_cast(s16x4, __builtin_amdgcn_ds_read_tr16_b64_v4i16((LAS s16x4*)p)); }
__device__ __forceinline__ unsigned pkbf(float lo, float hi) { return pg8::cvt_pk_bf16(lo, hi); }
__device__ __forceinline__ float xh_max(float v) { auto rr = __builtin_amdgcn_permlane32_swap(__float_as_uint(v), __float_as_uint(v), false, false); return fmaxf(__uint_as_float(rr[0]), __uint_as_float(rr[1])); }
__device__ __forceinline__ float xh_sum(float v) { auto rr = __builtin_amdgcn_permlane32_swap(__float_as_uint(v), __float_as_uint(v), false, false); return __uint_as_float(rr[0]) + __uint_as_float(rr[1]); }
__device__ __forceinline__ void attn_unit(const Frame& F, const Args& A, bf16* Obuf, int qrow0, int krow0, int nt, int head) {
    int tid = F.tid; asm volatile("" : "+v"(tid));
    const int lane = tid & 63, wave = __builtin_amdgcn_readfirstlane(tid >> 6), r32 = lane & 31, hi = lane >> 5, mp = wave >> 2, qb = wave & 3;
    bf16x8 qf[4];
    { const bf16* qg = WSP(const bf16, WS_Q) + (size_t)(qrow0 + qb * 32 + r32) * D + head * 128 + mp * 64 + 8 * hi;
#pragma unroll
      for (int ds = 0; ds < 4; ++ds) qf[ds] = *(const GAS bf16x8*)(qg + 16 * ds); }
    const bf16* kg = WSP(const bf16, WS_K) + (size_t)krow0 * D + head * 128; const bf16* vg = WSP(const bf16, WS_V) + (size_t)krow0 * D + head * 128;
    const int srow = wave * 8 + (lane >> 4); const unsigned sc0 = (unsigned)(lane & 15) ^ ((((unsigned)srow & 3u) << 2) | (((unsigned)srow >> 2) & 3u)), sc1 = (unsigned)(lane & 15) ^ ((((unsigned)(srow + 4) & 3u) << 2) | (((unsigned)(srow + 4) >> 2) & 3u));
    const bf16* ks0 = kg + (size_t)srow * D + sc0 * 8; const bf16* ks1 = kg + (size_t)(srow + 4) * D + sc1 * 8;
    const bf16* vs0 = vg + (size_t)srow * D + sc0 * 8; const bf16* vs1 = vg + (size_t)(srow + 4) * D + sc1 * 8;
    LAS unsigned char* dbase = F.lds + wave * 2048;
#define AT_STAGE(tt, bufsel) do { const size_t o_ = (size_t)(tt) * 64 * D; LAS unsigned char* d_ = dbase + (bufsel) * AT_KV; \
        __builtin_amdgcn_global_load_lds((const unsigned*)(ks0 + o_), (LAS unsigned*)(d_), 16, 0, 0); __builtin_amdgcn_global_load_lds((const unsigned*)(ks1 + o_), (LAS unsigned*)(d_ + 1024), 16, 0, 0); \
        __builtin_amdgcn_global_load_lds((const unsigned*)(vs0 + o_), (LAS unsigned*)(d_ + 16384), 16, 0, 0); __builtin_amdgcn_global_load_lds((const unsigned*)(vs1 + o_), (LAS unsigned*)(d_ + 16384 + 1024), 16, 0, 0); } while (0)
    const int blk = (lane >> 4) & 1, q4 = (lane & 15) >> 2, p4 = lane & 3;
    unsigned ka[4], va[2][4];
    { const unsigned fr = (((unsigned)r32 & 3u) << 2) | (((unsigned)r32 >> 2) & 3u), g = (unsigned)(8 * mp + hi) ^ fr, c2 = (unsigned)(2 * blk + (p4 >> 1));
      const unsigned vb0 = 256u * (unsigned)(4 * hi + q4) + 16u * (c2 ^ (unsigned)hi) + 8u * (unsigned)(p4 & 1), vb1 = 256u * (unsigned)(4 * hi + q4 + 8) + 16u * (c2 ^ (unsigned)(hi + 2)) + 8u * (unsigned)(p4 & 1);
#pragma unroll
      for (int i = 0; i < 4; ++i) { ka[i] = 256u * (unsigned)r32 + 16u * (g ^ (unsigned)(2 * i)); va[0][i] = 16384u + vb0 + 64u * ((unsigned)i ^ (unsigned)q4); va[1][i] = 16384u + vb1 + 64u * ((unsigned)i ^ (unsigned)q4); } }
    AT_STAGE(0, 0); if (nt > 1) AT_STAGE(1, 1); if (nt > 2) AT_STAGE(2, 2);
    if (nt > 2) asm volatile("s_waitcnt vmcnt(4)\n\ts_barrier" ::: "memory"); else asm volatile("s_waitcnt vmcnt(0)\n\ts_barrier" ::: "memory");
    f32x16 O[4];
#pragma unroll
    for (int e = 0; e < 4; ++e) O[e] = f32x16{};
    float mrun = -1e30f, lrun = 0.f;
    f32x16 S0 = f32x16{}, S1 = f32x16{};
#pragma unroll
    for (int ds = 0; ds < 4; ++ds) { const bf16x8 k0 = *(const LAS bf16x8*)(F.lds + ka[ds]); const bf16x8 k1 = *(const LAS bf16x8*)(F.lds + ka[ds] + 8192);
        S0 = __builtin_amdgcn_mfma_f32_32x32x16_bf16(k0, qf[ds], S0, 0, 0, 0); S1 = __builtin_amdgcn_mfma_f32_32x32x16_bf16(k1, qf[ds], S1, 0, 0, 0); }
    for (int t = 0; t < nt; ++t) {
        LAS unsigned char* lk = F.lds + (t & 3) * AT_KV; LAS unsigned char* ln = F.lds + ((t + 1) & 3) * AT_KV;
        if (t + 3 < nt) AT_STAGE(t + 3, (t + 3) & 3);
        f32x16 N0 = f32x16{}, N1 = f32x16{};
        if (t + 1 < nt) {
#pragma unroll
            for (int ds = 0; ds < 4; ++ds) { const bf16x8 k0 = *(const LAS bf16x8*)(ln + ka[ds]); const bf16x8 k1 = *(const LAS bf16x8*)(ln + ka[ds] + 8192);
                N0 = __builtin_amdgcn_mfma_f32_32x32x16_bf16(k0, qf[ds], N0, 0, 0, 0); N1 = __builtin_amdgcn_mfma_f32_32x32x16_bf16(k1, qf[ds], N1, 0, 0, 0); } }
        float mx = fmaxf(S0[0], S1[0]);
#pragma unroll
        for (int r = 1; r < 16; ++r) mx = fmaxf(mx, fmaxf(S0[r], S1[r]));
        mx = xh_max(mx);
        const float mn = fmaxf(mrun, mx); const float alpha = __builtin_amdgcn_exp2f(mrun - mn);
        float rs = 0.f;
#pragma unroll
        for (int r = 0; r < 16; ++r) { S0[r] = __builtin_amdgcn_exp2f(S0[r] - mn); S1[r] = __builtin_amdgcn_exp2f(S1[r] - mn); rs += S0[r] + S1[r]; }
        mrun = mn; lrun = lrun * alpha + rs;
#pragma unroll
        for (int e = 0; e < 4; ++e) O[e] = O[e] * alpha;
        bf16x8 P[4];
#pragma unroll
        for (int s = 0; s < 2; ++s) {
            v4u a, b;
            a.x = pkbf(S0[8 * s + 0], S0[8 * s + 1]); a.y = pkbf(S0[8 * s + 2], S0[8 * s + 3]); a.z = pkbf(S0[8 * s + 4], S0[8 * s + 5]); a.w = pkbf(S0[8 * s + 6], S0[8 * s + 7]);
            b.x = pkbf(S1[8 * s + 0], S1[8 * s + 1]); b.y = pkbf(S1[8 * s + 2], S1[8 * s + 3]); b.z = pkbf(S1[8 * s + 4], S1[8 * s + 5]); b.w = pkbf(S1[8 * s + 6], S1[8 * s + 7]);
            P[0 * 2 + s] = __builtin_bit_cast(bf16x8, a); P[1 * 2 + s] = __builtin_bit_cast(bf16x8, b); }
#pragma unroll
        for (int eb = 0; eb < 4; ++eb)
#pragma unroll
            for (int kb = 0; kb < 2; ++kb)
#pragma unroll
                for (int s = 0; s < 2; ++s) {
                    const s16x4 lo = tr16(lk + va[0][eb] + (8192 * kb + 4096 * s)); const s16x4 hh = tr16(lk + va[1][eb] + (8192 * kb + 4096 * s));
                    const bf16x8 vf = (bf16x8){lo[0], lo[1], lo[2], lo[3], hh[0], hh[1], hh[2], hh[3]};
                    O[eb] = __builtin_amdgcn_mfma_f32_32x32x16_bf16(vf, P[kb * 2 + s], O[eb], 0, 0, 0); }
        S0 = N0; S1 = N1;
        if (t + 3 < nt) asm volatile("s_waitcnt vmcnt(4) lgkmcnt(0)\n\ts_barrier" ::: "memory"); else asm volatile("s_waitcnt vmcnt(0) lgkmcnt(0)\n\ts_barrier" ::: "memory");
    }
#undef AT_STAGE
    lrun = xh_sum(lrun);
    LAS float* X = (LAS float*)(F.lds + qb * 16384);
    if (mp == 1) {
        float s1 = 0.f, s2 = 0.f;
        for (int i = 0; i < 64; ++i) { s1 += A.in[11][i] * A.in[12][i]; s2 += A.in[13][i] * A.in[14][i]; }
        const float lam = expf(s1) - expf(s2) + LAM_INIT; const float sc = lam / lrun;
#pragma unroll
        for (int e = 0; e < 4; ++e)
#pragma unroll
            for (int r = 0; r < 16; ++r) X[(e * 32 + (r & 3) + 8 * (r >> 2) + 4 * hi) * 32 + r32] = O[e][r] * sc;
    }
    __syncthreads();
    if (mp == 0) {
        const float i0 = 1.f / lrun; float ss = 0.f;
#pragma unroll
        for (int e = 0; e < 4; ++e)
#pragma unroll
            for (int r = 0; r < 16; ++r) { const float o = O[e][r] * i0 - X[(e * 32 + (r & 3) + 8 * (r >> 2) + 4 * hi) * 32 + r32]; O[e][r] = o; ss += o * o; }
        ss = xh_sum(ss);
        const float rstd = (1.f - LAM_INIT) / sqrtf(ss * (1.f / 128.f) + EPSN);
        LAS unsigned char* stg = (LAS unsigned char*)X;
#pragma unroll
        for (int e = 0; e < 4; ++e)
#pragma unroll
            for (int g4 = 0; g4 < 4; ++g4) { const int e0 = e * 32 + 8 * g4 + 4 * hi; const f32x4 gg = *(const GAS f32x4*)(A.in[15] + e0);
                const unsigned w0 = pkbf(O[e][4 * g4 + 0] * rstd * gg.x, O[e][4 * g4 + 1] * rstd * gg.y), w1 = pkbf(O[e][4 * g4 + 2] * rstd * gg.z, O[e][4 * g4 + 3] * rstd * gg.w);
                *(LAS unsigned long long*)(stg + r32 * 256 + ((((unsigned)e0 >> 3) ^ ((unsigned)r32 & 15u)) << 4) + (e0 & 7) * 2) = (unsigned long long)w0 | ((unsigned long long)w1 << 32); }
        LDS_WAIT(); asm volatile("" ::: "memory");
        { bf16* og = Obuf + (size_t)(qrow0 + qb * 32) * D + head * 128;
#pragma unroll
          for (int i = 0; i < 8; ++i) { const int id = lane + 64 * i, row = id >> 4, ch = id & 15; const v4u x = *(const LAS v4u*)(stg + row * 256 + ((ch ^ (row & 15)) << 4)); *(GAS v4u*)(og + (size_t)row * D + ch * 8) = x; } }
        LDS_WAIT(); asm volatile("" ::: "memory");
    }
}

template <int L, int NB> __device__ __forceinline__ void hyena_unit(const Frame& F, const Args& A, int c) {
    constexpr int ROW0 = (L == LCTX) ? 0 : M_CTX, NTOK = NB * L, PITCH = L + 8, CP = 2 * L + 8, TW = (L / 16) / 8;
    constexpr int OFF_V = 8 * CP * 2, ARR = NB * PITCH * 2, OFF_Z = OFF_V + ARR, OFF_X1 = OFF_Z + ARR, OFF_X2 = OFF_X1 + ARR;
    static_assert(OFF_X2 + ARR <= RING_BYTES, "hyena LDS");
    int tid = F.tid; asm volatile("" : "+v"(tid));
    const int lane = tid & 63, wave = __builtin_amdgcn_readfirstlane(tid >> 6);
    LAS unsigned char* lds = F.lds;
#pragma unroll
    for (int p = 0; p < 3; ++p) {
        const bf16* src = WSP(const bf16, WS_UT) + (size_t)(p * DH + c) * MROWS + ROW0;
        const float w0 = A.in[16][p * DH + c], w1 = A.in[16][HYC + p * DH + c], w2 = A.in[16][2 * HYC + p * DH + c], bb = A.in[17][p * DH + c];
        LAS unsigned char* dst = lds + (p == 0 ? OFF_V : (p == 1 ? OFF_X1 : OFF_X2));
        for (int idx = tid; idx < NTOK / 8; idx += NWAVES * 64) { const int t8 = idx * 8, b = t8 / L, t = t8 % L;
            const v4u raw = *(const GAS v4u*)(src + t8);
            float x[10];
            x[0] = (t == 0) ? 0.f : bf2f(src[t8 - 1]); x[9] = (t + 8 == L) ? 0.f : bf2f(src[t8 + 8]);
            x[1] = __uint_as_float(raw.x << 16); x[2] = __uint_as_float(raw.x & 0xffff0000u); x[3] = __uint_as_float(raw.y << 16); x[4] = __uint_as_float(raw.y & 0xffff0000u);
            x[5] = __uint_as_float(raw.z << 16); x[6] = __uint_as_float(raw.z & 0xffff0000u); x[7] = __uint_as_float(raw.w << 16); x[8] = __uint_as_float(raw.w & 0xffff0000u);
            v4u o;
            o.x = pk2(w0 * x[0] + w1 * x[1] + w2 * x[2] + bb, w0 * x[1] + w1 * x[2] + w2 * x[3] + bb); o.y = pk2(w0 * x[2] + w1 * x[3] + w2 * x[4] + bb, w0 * x[3] + w1 * x[4] + w2 * x[5] + bb);
            o.z = pk2(w0 * x[4] + w1 * x[5] + w2 * x[6] + bb, w0 * x[5] + w1 * x[6] + w2 * x[7] + bb); o.w = pk2(w0 * x[6] + w1 * x[7] + w2 * x[8] + bb, w0 * x[7] + w1 * x[8] + w2 * x[9] + bb);
            *(LAS v4u*)(dst + (b * PITCH + t) * 2) = o; }
    }
    const float bias0 = A.in[24][c], bias1 = A.in[24][DH + c];
    const int tl = lane & 15, kg = lane >> 4, msh = (16 - tl) & 7;
#pragma unroll
    for (int ord = 0; ord < 2; ++ord) {
        { const bf16* R = WSP(const bf16, WS_FILT) + (L == LCTX ? 0 : (size_t)(MiB / 2)) + ((size_t)ord * DH + c) * (2 * L);
          for (int q = tid; q < 2 * L / 8; q += NWAVES * 64) {
              const v4u lo = *(const GAS v4u*)(R + 8 * q); v4u hi4 = (v4u){0u, 0u, 0u, 0u}; if (q + 1 < 2 * L / 8) hi4 = *(const GAS v4u*)(R + 8 * q + 8);
              const unsigned w[8] = {lo.x, lo.y, lo.z, lo.w, hi4.x, hi4.y, hi4.z, hi4.w};
#pragma unroll
              for (int m = 0; m < 8; ++m) { v4u o;
                  if (m & 1) { o.x = __builtin_amdgcn_alignbit(w[m / 2 + 1], w[m / 2], 16); o.y = __builtin_amdgcn_alignbit(w[m / 2 + 2], w[m / 2 + 1], 16); o.z = __builtin_amdgcn_alignbit(w[m / 2 + 3], w[m / 2 + 2], 16); o.w = __builtin_amdgcn_alignbit(w[m / 2 + 4], w[m / 2 + 3], 16); }
                  else { o.x = w[m / 2]; o.y = w[m / 2 + 1]; o.z = w[m / 2 + 2]; o.w = w[m / 2 + 3]; }
                  *(LAS v4u*)(lds + (m * CP + 8 * q) * 2) = o; } } }
        __syncthreads();
        pg8::f32x4 acc[TW];
#pragma unroll
        for (int i = 0; i < TW; ++i) acc[i] = (pg8::f32x4){0.f, 0.f, 0.f, 0.f};
        const LAS unsigned char* ub = lds + (ord == 0 ? OFF_V : OFF_Z) + ((lane & (NB - 1)) * PITCH + 8 * kg) * 2;
        const int tbase = wave * TW * 16;
        const LAS unsigned char* ab = lds + (msh * CP + (L - tbase - tl + 8 * kg - msh)) * 2;
#pragma unroll 2
        for (int ss = 0; ss < L / 32; ++ss) { const bf16x8 bfr = *(const LAS bf16x8*)(ub + ss * 64);
#pragma unroll
            for (int i = 0; i < TW; ++i) { const bf16x8 afr = *(const LAS bf16x8*)(ab + (ss * 32 - 16 * i) * 2);
                acc[i] = __builtin_amdgcn_mfma_f32_16x16x32_bf16(afr, bfr, acc[i], 0, 0, 0); } }
        const int b = tl;
        if (b < NB) {
#pragma unroll
            for (int i = 0; i < TW; ++i) { const int t = tbase + 16 * i + 4 * kg; const int eo = (b * PITCH + t) * 2;
                const unsigned long long uu = *(const LAS unsigned long long*)(lds + (ord == 0 ? OFF_V : OFF_Z) + eo), gg = *(const LAS unsigned long long*)(lds + (ord == 0 ? OFF_X1 : OFF_X2) + eo);
                const float bias = ord == 0 ? bias0 : bias1; float y[4];
#pragma unroll
                for (int r = 0; r < 4; ++r) { const float uv = __uint_as_float((unsigned)((uu >> (16 * r)) & 0xffffull) << 16), gv = __uint_as_float((unsigned)((gg >> (16 * r)) & 0xffffull) << 16);
                    y[r] = gv * (acc[i][r] + uv * bias); }
                if (ord == 0) *(LAS unsigned long long*)(lds + OFF_Z + eo) = (unsigned long long)pk2(y[0], y[1]) | ((unsigned long long)pk2(y[2], y[3]) << 32);
                else { bf16* og = WSP(bf16, WS_XN) + (size_t)(ROW0 + b * L + t) * DH + c;
#pragma unroll
                    for (int r = 0; r < 4; ++r) { og[(size_t)r * DH] = (bf16)f2bf(y[r]); if (MK_PROBE_ST) og[(size_t)r * DH + (size_t)MROWS * DH] = (bf16)f2bf(y[r]); } } }
        }
        __syncthreads();
    }
}

struct EpiT1 {
    static constexpr bool PERM = true, AFTER_DRAIN = false;
    const bf16* G; bf16* T1;
    __device__ __forceinline__ void operator()(const pg8::f32x4 (&acc)[2][2][4][2], const pg8::Unit& u, int wr, int wc, int fr, int fq) const {
        using pg8::f32x4; using pg8::u32x4;
        const int row0 = u.pm * 256 + wr * 64 + fr, col0 = u.pn * 256 + wc * 32 + 8 * fq;
#pragma unroll
        for (int ai = 0; ai < 2; ++ai)
#pragma unroll
            for (int m = 0; m < 4; ++m) { const int row = row0 + ai * 128 + m * 16;
#pragma unroll
                for (int bj = 0; bj < 2; ++bj) { const int col = col0 + bj * 128; const u32x4 g = *(const u32x4*)(G + (size_t)row * 2048 + col);
                    const f32x4 v0 = acc[ai][bj][m][0], v1 = acc[ai][bj][m][1]; u32x4 w;
                    w.x = pg8::cvt_pk_bf16(v0[0] * __uint_as_float(g.x << 16), v0[1] * __uint_as_float(g.x & 0xffff0000u)); w.y = pg8::cvt_pk_bf16(v0[2] * __uint_as_float(g.y << 16), v0[3] * __uint_as_float(g.y & 0xffff0000u));
                    w.z = pg8::cvt_pk_bf16(v1[0] * __uint_as_float(g.z << 16), v1[1] * __uint_as_float(g.z & 0xffff0000u)); w.w = pg8::cvt_pk_bf16(v1[2] * __uint_as_float(g.w << 16), v1[3] * __uint_as_float(g.w & 0xffff0000u));
                    *(u32x4*)(T1 + (size_t)row * D + col) = w; } }
    }
};
struct EpiMerge {
    static constexpr bool PERM = true, AFTER_DRAIN = false;
    const bf16* G; const bf16* T1; bf16* MG;
    __device__ __forceinline__ void operator()(const pg8::f32x4 (&acc)[2][2][4][2], const pg8::Unit& u, int wr, int wc, int fr, int fq) const {
        using pg8::f32x4; using pg8::u32x4;
        const int row0 = u.pm * 256 + wr * 64 + fr, col0 = u.pn * 256 + wc * 32 + 8 * fq;
#pragma unroll
        for (int ai = 0; ai < 2; ++ai)
#pragma unroll
            for (int m = 0; m < 4; ++m) { const int row = row0 + ai * 128 + m * 16;
#pragma unroll
                for (int bj = 0; bj < 2; ++bj) { const int col = col0 + bj * 128; const u32x4 g = *(const u32x4*)(G + (size_t)row * 2048 + 1024 + col); const u32x4 t = *(const u32x4*)(T1 + (size_t)row * D + col);
                    const f32x4 v0 = acc[ai][bj][m][0], v1 = acc[ai][bj][m][1]; u32x4 w;
                    w.x = pg8::cvt_pk_bf16(__uint_as_float(t.x << 16) + v0[0] * __uint_as_float(g.x << 16), __uint_as_float(t.x & 0xffff0000u) + v0[1] * __uint_as_float(g.x & 0xffff0000u));
                    w.y = pg8::cvt_pk_bf16(__uint_as_float(t.y << 16) + v0[2] * __uint_as_float(g.y << 16), __uint_as_float(t.y & 0xffff0000u) + v0[3] * __uint_as_float(g.y & 0xffff0000u));
                    w.z = pg8::cvt_pk_bf16(__uint_as_float(t.z << 16) + v1[0] * __uint_as_float(g.z << 16), __uint_as_float(t.z & 0xffff0000u) + v1[1] * __uint_as_float(g.z & 0xffff0000u));
                    w.w = pg8::cvt_pk_bf16(__uint_as_float(t.w << 16) + v1[2] * __uint_as_float(g.w << 16), __uint_as_float(t.w & 0xffff0000u) + v1[3] * __uint_as_float(g.w & 0xffff0000u));
                    *(u32x4*)(MG + (size_t)row * D + col) = w; } }
    }
};
struct EpiRes {
    static constexpr bool PERM = false, AFTER_DRAIN = false;
    const float* xa; const float* xb; const float* modf; int goff; float* out;
    __device__ __forceinline__ void operator()(const pg8::f32x4 (&acc)[2][2][4][2], const pg8::Unit& u, int wr, int wc, int fr, int fq) const {
        using pg8::f32x4;
        const int row0 = u.pm * 256 + wr * 64 + fr, col0 = u.pn * 256 + wc * 32 + 4 * fq; const int mr = u.pm < 16 ? 0 : 1 + ((u.pm - 16) >> 2);
        const float* gp = modf + (size_t)mr * 6144 + goff + col0; f32x4 gv[2][2];
#pragma unroll
        for (int bj = 0; bj < 2; ++bj)
#pragma unroll
            for (int n = 0; n < 2; ++n) gv[bj][n] = *(const f32x4*)(gp + bj * 128 + n * 16);
#pragma unroll
        for (int ai = 0; ai < 2; ++ai)
#pragma unroll
            for (int m = 0; m < 4; ++m) { const int row = row0 + ai * 128 + m * 16; const float* bp = (row < M_CTX ? xa + (size_t)row * D : xb + (size_t)(row - M_CTX) * D) + col0; float* op = out + (size_t)row * D + col0;
#pragma unroll
                for (int bj = 0; bj < 2; ++bj)
#pragma unroll
                    for (int n = 0; n < 2; ++n) { const f32x4 bs = *(const f32x4*)(bp + bj * 128 + n * 16); *(f32x4*)(op + bj * 128 + n * 16) = bs + gv[bj][n] * acc[ai][bj][m][n]; } }
    }
};
struct EpiUp {
    static constexpr bool PERM = true, AFTER_DRAIN = false;
    bf16* UP;
    __device__ __forceinline__ void operator()(const pg8::f32x4 (&acc)[2][2][4][2], const pg8::Unit& u, int wr, int wc, int fr, int fq) const {
        using pg8::f32x4; using pg8::u32x4;
        const int row0 = u.pm * 256 + wr * 64 + fr, col0 = u.pn * 256 + wc * 32 + 8 * fq;
#pragma unroll
        for (int ai = 0; ai < 2; ++ai)
#pragma unroll
            for (int m = 0; m < 4; ++m) { const int row = row0 + ai * 128 + m * 16;
#pragma unroll
                for (int bj = 0; bj < 2; ++bj) { f32x4 v0 = acc[ai][bj][m][0], v1 = acc[ai][bj][m][1];
#pragma unroll
                    for (int e = 0; e < 4; ++e) { const float a = fmaxf(v0[e], 0.f), b = fmaxf(v1[e], 0.f); v0[e] = a * a; v1[e] = b * b; }
                    u32x4 w; w.x = pg8::cvt_pk_bf16(v0[0], v0[1]); w.y = pg8::cvt_pk_bf16(v0[2], v0[3]); w.z = pg8::cvt_pk_bf16(v1[0], v1[1]); w.w = pg8::cvt_pk_bf16(v1[2], v1[3]);
                    *(u32x4*)(UP + (size_t)row * FF + col0 + bj * 128) = w; } }
    }
};
__device__ __forceinline__ void final_norm_rows(const Frame& F, const Args& A) {
    const int gw = F.vcu * NWAVES + F.wave, NGW = F.G * NWAVES, lane = F.lane;
    f32x4 gv[4];
#pragma unroll
    for (int j = 0; j < 4; ++j) gv[j] = *(const GAS f32x4*)(A.in[30] + 4 * lane + 256 * j);
    for (int row = gw; row < MROWS; row += NGW) { float* xr = F.out + (size_t)row * D; f32x4 v[4]; float s = 0.f;
#pragma unroll
        for (int j = 0; j < 4; ++j) { v[j] = *(const GAS f32x4*)(xr + 4 * lane + 256 * j); s += (v[j].x * v[j].x + v[j].y * v[j].y) + (v[j].z * v[j].z + v[j].w * v[j].w); }
        const float rstd = 1.f / sqrtf(wave_sum(s) * (1.f / D) + EPSN);
#pragma unroll
        for (int j = 0; j < 4; ++j) *(GAS f32x4*)(xr + 4 * lane + 256 * j) = v[j] * rstd * gv[j]; }
}

#ifndef MK_DEBUG
#define MK_DEBUG 0
#endif
#ifndef MK_REP
#define MK_REP 0
#endif
#ifndef MK_REP3
#define MK_REP3 3
#endif
#define REPK(k) for (int rep_ = 0; rep_ <= ((MK_REP >> (k)) & 1); ++rep_)
__global__ void __launch_bounds__(NWAVES * 64, 2) mk_fwd(Args args) {
    extern __shared__ __attribute__((aligned(16))) unsigned char lds[];
    Frame F;
    F.lds = (LAS unsigned char*)lds; F.MISC = (volatile LAS unsigned*)(F.lds + MISC_OFF);
    F.tid = threadIdx.x; F.lane = F.tid & 63; F.wave = __builtin_amdgcn_readfirstlane(F.tid >> 6);
    F.G = gridDim.x; { const int bx = blockIdx.x; F.vcu = (F.G % 8 == 0) ? (bx % 8) * (F.G / 8) + bx / 8 : bx; }
    F.ws = args.ws; F.out = args.out; F.ctl = (gu32*)(args.ws + WS_CTL);
    const Args& A = args;
    for (int u = F.tid; u < (LDS_BYTES - LDSCTL_OFF) / 4; u += NWAVES * 64) ((LAS unsigned*)(F.lds + LDSCTL_OFF))[u] = 0u;
    __syncthreads();
    XcdBarrier bar = xcd_barrier_post((unsigned*)(F.ctl + CW_BAR), F.MISC + 8);
    const int stop = args.stop_after; int n_ts = 1;
    if (MK_DEBUG && blockIdx.x == 0 && threadIdx.x == 0) ((unsigned long long*)(F.ctl + TS_WORDS))[0] = rt();
#define GRID_BAR() do { xcd_barrier(bar); if (MK_DEBUG && blockIdx.x == 0 && threadIdx.x == 0) { ((unsigned long long*)(F.ctl + TS_WORDS))[n_ts] = rt(); } ++n_ts; } while (0)
#define STOP_IF(k) do { if (MK_DEBUG && stop == (k)) return; } while (0)
#define PHASE_BEGIN() do { int t_ = threadIdx.x; asm volatile("" : "+v"(t_)); F.tid = t_; F.lane = t_ & 63; unsigned char* w_ = args.ws; asm volatile("" : "+s"(w_)); F.ws = w_; } while (0)

    REPK(0) { PHASE_BEGIN(); p0_prologue(F, A); }
    GRID_BAR(); STOP_IF(0);
    REPK(1) { PHASE_BEGIN(); modnorm_rows(F, A, 0); }
    GRID_BAR(); STOP_IF(1);
    REPK(2) { PHASE_BEGIN();
        pg8::Gemm g{WSP(const pg8::bf16_t, WS_XN), WSP(const pg8::bf16_t, WS_WIN), MROWS, INC, D}; pg8::StaticOrder S; S.init(MROWS, INC, F.G, (int)blockIdx.x);
        EpiIn E{WSP(bf16, WS_Q), WSP(bf16, WS_K), WSP(bf16, WS_V), WSP(bf16, WS_UT), WSP(bf16, WS_G), F.out + (size_t)MROWS * D, F.out + (size_t)MROWS * D + (size_t)M_CTX * D, WSP(const float, WS_ROPE)};
        pg8::gemm_phase<EpiIn, pg8::StaticOrder, true, true>(F.lds + RING_OFF, g, S, E);
    }
    GRID_BAR(); STOP_IF(2);
    REPK(3) {
        PHASE_BEGIN();
        bf16* Obuf = WSP(bf16, WS_O);
        volatile LAS unsigned* qslot = (volatile LAS unsigned*)(F.lds + LDSCTL_OFF + 64);
        constexpr int NU = 512 + 512 + 256 + 512 + N_TRU;
        for (;;) {
            __syncthreads();
            if (F.tid == 0) *qslot = __hip_atomic_fetch_add((unsigned*)(F.ctl + CW_QUEUE + 64 * rep_), 1u, __ATOMIC_RELAXED, __HIP_MEMORY_SCOPE_AGENT);
            __syncthreads();
            const int id = __builtin_amdgcn_readfirstlane((int)*qslot);
            if (id >= NU) break;
            { int t_ = threadIdx.x; asm volatile("" : "+v"(t_)); F.tid = t_; F.lane = t_ & 63; }
            if (rep_ == 1) { if (id >= 1792) continue; const bool is_attn = id < 512 || (id >= 1024 && id < 1280); if (is_attn ? !(MK_REP3 & 1) : !(MK_REP3 & 2)) continue; }
            if (id < 512) { const int b = id >> 6, head = (id >> 3) & 7, qb = id & 7; attn_unit(F, A, Obuf, M_CTX + b * LLAT + qb * 128, M_CTX + b * LKLAT, LKLAT / 64, head); }
            else if (id < 1024) hyena_unit<LLAT, 8>(F, A, id - 512);
            else if (id < 1280) { const int j = id - 1024, s = j >> 4, head = (j >> 1) & 7, qb = j & 1; attn_unit(F, A, Obuf, s * 256 + qb * 128, s * 256, LCTX / 64, head); }
            else if (id < 1792) hyena_unit<LCTX, 16>(F, A, id - 1280);
            else p3_transpose_unit(F, A, id - 1792);
        }
    }
    GRID_BAR(); STOP_IF(3);
    REPK(4)
    { PHASE_BEGIN();
        pg8::StaticOrder S; S.init(MROWS, D, F.G, (int)blockIdx.x);
        { pg8::Gemm g{WSP(const pg8::bf16_t, WS_O), WSP(const pg8::bf16_t, WS_WA), MROWS, D, D}; EpiT1 E{WSP(const bf16, WS_G), WSP(bf16, WS_V)};
          pg8::gemm_phase<EpiT1, pg8::StaticOrder, true, true>(F.lds + RING_OFF, g, S, E); }
        { pg8::Gemm g{WSP(const pg8::bf16_t, WS_XN), WSP(const pg8::bf16_t, WS_WH), MROWS, D, DH}; EpiMerge E{WSP(const bf16, WS_G), WSP(const bf16, WS_V), WSP(bf16, WS_K)};
          pg8::gemm_phase<EpiMerge, pg8::StaticOrder, true, true>(F.lds + RING_OFF, g, S, E); }
    }
    GRID_BAR(); STOP_IF(4);
    REPK(5) { PHASE_BEGIN();
        pg8::Gemm g{WSP(const pg8::bf16_t, WS_K), WSP(const pg8::bf16_t, WS_WO), MROWS, D, D}; pg8::StaticOrder S; S.init(MROWS, D, F.G, (int)blockIdx.x);
        EpiRes E{A.in[0], A.in[1], WSP(const float, WS_MODF), 2048, F.out};
        pg8::gemm_phase<EpiRes, pg8::StaticOrder, true, true>(F.lds + RING_OFF, g, S, E);
    }
    GRID_BAR(); STOP_IF(5);
    REPK(6) { PHASE_BEGIN(); modnorm_rows(F, A, 1); }
    GRID_BAR(); STOP_IF(6);
    REPK(7) { PHASE_BEGIN();
        pg8::Gemm g{WSP(const pg8::bf16_t, WS_XN), WSP(const pg8::bf16_t, WS_WUP), MROWS, FF, D}; pg8::StaticOrder S; S.init(MROWS, FF, F.G, (int)blockIdx.x);
        EpiUp E{WSP(bf16, WS_UP)};
        pg8::gemm_phase<EpiUp, pg8::StaticOrder, true, true>(F.lds + RING_OFF, g, S, E);
    }
    GRID_BAR(); STOP_IF(7);
    { PHASE_BEGIN();
        pg8::Gemm g{WSP(const pg8::bf16_t, WS_UP), WSP(const pg8::bf16_t, WS_WDN), MROWS, D, FF}; pg8::StaticOrder S; S.init(MROWS, D, F.G, (int)blockIdx.x);
        EpiRes E{F.out, F.out + (size_t)M_CTX * D, WSP(const float, WS_MODF), 5120, F.out};
        pg8::gemm_phase<EpiRes, pg8::StaticOrder, true, true>(F.lds + RING_OFF, g, S, E);
    }
    GRID_BAR(); STOP_IF(8);
    PHASE_BEGIN(); final_norm_rows(F, A);
    if (MK_DEBUG && blockIdx.x == 0 && threadIdx.x == 0) { ((unsigned long long*)(F.ctl + TS_WORDS))[n_ts] = rt(); }

}

#if MK_DEBUG

#endif
extern "C" void kernel_launch(void* const* d_in, const int* in_sizes, int n_in, void* d_out, int out_size, void* d_ws, size_t ws_size, hipStream_t stream) {
    static int grid = 0;
    if (grid == 0) {
        if (n_in != 31 || out_size != MROWS * D + 2 * M_CTX * D || ws_size < WS_END) { fprintf(stderr, "kernel_launch: unexpected shapes (n_in %d out %d ws %zu)\n", n_in, out_size, ws_size); grid = -1; return; }
        int dev = 0, cus = 0;
        if (hipGetDevice(&dev) != hipSuccess || hipDeviceGetAttribute(&cus, hipDeviceAttributeMultiprocessorCount, dev) != hipSuccess) { grid = -1; return; }
        if (hipFuncSetAttribute((const void*)mk_fwd, hipFuncAttributeMaxDynamicSharedMemorySize, LDS_BYTES) != hipSuccess) { fprintf(stderr, "kernel_launch: hipFuncSetAttribute failed\n"); grid = -1; return; }
        int per_cu = 0;
        if (hipOccupancyMaxActiveBlocksPerMultiprocessor(&per_cu, (const void*)mk_fwd, NWAVES * 64, LDS_BYTES) != hipSuccess || per_cu < 1) { fprintf(stderr, "kernel_launch: occupancy query says %d\n", per_cu); }
        (void)hipGetLastError();
        grid = cus;
    }
    if (grid < 0) return;
    if (hipMemsetAsync((char*)d_ws + WS_CTL, 0, CTL_ZERO_BYTES, stream) != hipSuccess) return;
    Args a{};
    for (int i = 0; i < 31; ++i) a.in[i] = (const float*)d_in[i];
    a.out = (float*)d_out; a.ws = (unsigned char*)d_ws; a.stop_after = MK_STOP; a.pad = 0;
    hipLaunchKernelGGL(mk_fwd, dim3(grid), dim3(NWAVES * 64), LDS_BYTES, stream, a);
#if MK_DEBUG
    dbg_run(a, stream);
#endif
}
```

```cpp
#include <hip/hip_runtime.h>
#include <cstdio>
#include <cstdint>


#define MK_DEBUG 0
#define MK_STOP -1

namespace pg8 {
#define PG8_LAS __attribute__((address_space(3)))
typedef unsigned short bf16_t;
typedef short bf16x8 __attribute__((ext_vector_type(8)));
typedef float f32x4 __attribute__((ext_vector_type(4)));
typedef unsigned u32x4 __attribute__((ext_vector_type(4)));
constexpr int BM = 256, BK = 64, HALF = 128, HTB = HALF * BK * 2  , STAGE_BYTES = 8 * HTB, NXCD = 8, WGM = 8;

__host__ __device__ __forceinline__ int lds_byte(int r, int c) { const int st = (r >> 4) * 2 + (c >> 5), rr = r & 15, cc = c & 31, ob = rr * 64 + cc * 2; return st * 1024 + (ob ^ (((ob >> 9) & 1) << 5)); }
__host__ __device__ __forceinline__ void stage_rc(int b, int& R, int& C) { const int st = b / 1024, sb = b % 1024, swz = sb ^ (((sb >> 9) & 1) << 5); R = (st >> 1) * 16 + swz / 64; C = (st & 1) * 32 + (swz % 64) / 2; }
__host__ __device__ __forceinline__ int perm32(int rho) { const int n = rho >> 4, i = rho & 15; return 8 * (i >> 2) + 4 * n + (i & 3); }

struct Unit { int pm, pn; };
struct Gemm { const bf16_t* A; const bf16_t* Bt; int M, N, K; };

struct StaticOrder {
    int nM, nN, nwg, G, c;
    __host__ __device__ void init(int M, int N, int G_, int c_, int rows_per_tile = BM) { nM = M / rows_per_tile; nN = N / BM; nwg = nM * nN; G = G_; c = c_; }
    __host__ __device__ bool next(int i, Unit& u) const {
        const long L = (long)i * G + c; if (L >= nwg) return false;
        int wgid = (int)L; { const int q = nwg / NXCD, r = nwg % NXCD, xcd = wgid % NXCD, off = wgid / NXCD; wgid = (xcd < r ? xcd * (q + 1) : r * (q + 1) + (xcd - r) * q) + off; }
        const int nig = WGM * nN, gid = wgid / nig, fm = gid * WGM, gsz = (nM - fm) < WGM ? (nM - fm) : WGM;
        u.pm = fm + ((wgid % nig) % gsz); u.pn = (wgid % nig) / gsz; return true;
    }
    __device__ __forceinline__ void a_ready(const Unit&) const {}
    __device__ __forceinline__ void done(const Unit&) const {}
};

__device__ __forceinline__ unsigned cvt_pk_bf16(float lo, float hi) { unsigned r; asm volatile("v_cvt_pk_bf16_f32 %0, %1, %2" : "=v"(r) : "v"(lo), "v"(hi)); return r; }
typedef float f32x2 __attribute__((ext_vector_type(2)));

template <class Epi, class Sched, bool ALIGN_EPI = false, bool SP2 = false, int MF = 4>
__device__ __forceinline__ void gemm_phase(PG8_LAS unsigned char* lds, const Gemm g, const Sched& S, const Epi& E) {
    int tid_ = threadIdx.x; asm volatile("" : "+v"(tid_));
    const int tid = tid_, wid = __builtin_amdgcn_readfirstlane(tid >> 6), lane = tid & 63, wr = wid >> 2, wc = wid & 3, fr = lane & 15, fq = lane >> 4;
    const int K = g.K, nt = K / BK;
    unsigned voffA[2], voffB[2];
#pragma unroll
    for (int i = 0; i < 2; ++i) { int R, C; stage_rc(tid * 16 + i * 8192, R, C); const int Rb = Epi::PERM ? ((R & ~31) + perm32(R & 31)) : R; const int Ra = (R >= 32 * MF) ? R - 32 * MF : R;
        voffA[i] = (unsigned)(Ra * K + C) * 2u; voffB[i] = (unsigned)(Rb * K + C) * 2u; }
    const size_t kstep = (size_t)(BK * 2);
    const size_t hstepA = (size_t)(32 * MF) * K * 2, hstepB = (size_t)HALF * K * 2;
    const size_t tstepA = 2 * hstepA, tstepB = 2 * hstepB;
    const unsigned ldsw = (unsigned)wid * 1024u;
    const int aoff = lds_byte(wr * 16 * MF + fr, fq * 8), boff = lds_byte(wc * 32 + fr, fq * 8);
#define PG8_SA(b, h) (((b) * 2 + (h)) * HTB)
#define PG8_SB(b, h) ((4 + (b) * 2 + (h)) * HTB)
#define PG8_STAGE(bufoff, gbase, voff) do { _Pragma("unroll") for (int _i = 0; _i < 2; ++_i) \
        __builtin_amdgcn_global_load_lds((const unsigned*)((const char*)(gbase) + (voff)[_i]), (PG8_LAS unsigned*)(lds + (bufoff) + ldsw + _i * 8192), 16, 0, 0); } while (0)
#define PG8_LDA(dst, b, h) do { _Pragma("unroll") for (int m = 0; m < MF; ++m) _Pragma("unroll") for (int k = 0; k < 2; ++k) dst[m][k] = *(const PG8_LAS bf16x8*)(lds + PG8_SA(b, h) + aoff + m * 2048 + k * 1024); } while (0)
#define PG8_LDB(dst, b, h) do { _Pragma("unroll") for (int n = 0; n < 2; ++n) _Pragma("unroll") for (int k = 0; k < 2; ++k) dst[n][k] = *(const PG8_LAS bf16x8*)(lds + PG8_SB(b, h) + boff + n * 2048 + k * 1024); } while (0)
#define PG8_MMA(ai, bj, At, Bt) do { __builtin_amdgcn_s_setprio(1); _Pragma("unroll") for (int m = 0; m < MF; ++m) _Pragma("unroll") for (int n = 0; n < 2; ++n) _Pragma("unroll") for (int k = 0; k < 2; ++k) \
        acc[ai][bj][m][n] = __builtin_amdgcn_mfma_f32_16x16x32_bf16(Bt[n][k], At[m][k], acc[ai][bj][m][n], 0, 0, 0); __builtin_amdgcn_s_setprio(0); } while (0)
#define PG8_WAIT_V(n) asm volatile("s_waitcnt vmcnt(" #n ")" ::: "memory")
#define PG8_WAIT_L(n) asm volatile("s_waitcnt lgkmcnt(" #n ")" ::: "memory")
#define PG8_BAR __builtin_amdgcn_s_barrier()
#define PG8_SCHED __builtin_amdgcn_sched_barrier(0)
    Unit cur, nxt; int ui = 0;
    if (!S.next(0, cur)) return;
    f32x4 acc[2][2][MF][2];
#pragma unroll
    for (int a = 0; a < 2; ++a)
#pragma unroll
        for (int b = 0; b < 2; ++b)
#pragma unroll
            for (int m = 0; m < MF; ++m)
#pragma unroll
                for (int n = 0; n < 2; ++n) acc[a][b][m][n] = (f32x4){0.f, 0.f, 0.f, 0.f};
    bf16x8 At[MF][2], B0[2][2], B1[2][2];
    const char* cA = (const char*)g.A + (size_t)cur.pm * tstepA; const char* cB = (const char*)g.Bt + (size_t)cur.pn * tstepB;
    S.a_ready(cur);
    if constexpr (SP2) {
        PG8_STAGE(PG8_SB(0, 0), cB, voffB); PG8_STAGE(PG8_SB(0, 1), cB + hstepB, voffB); PG8_STAGE(PG8_SA(0, 0), cA, voffA); PG8_STAGE(PG8_SA(0, 1), cA + hstepA, voffA);
        if (wr == 1) PG8_BAR;
        PG8_WAIT_V(2); PG8_BAR;
        PG8_STAGE(PG8_SB(1, 0), cB + kstep, voffB); PG8_STAGE(PG8_SA(1, 0), cA + kstep, voffA); PG8_STAGE(PG8_SB(1, 1), cB + hstepB + kstep, voffB);
        PG8_WAIT_V(6); PG8_BAR;
    } else {
        PG8_STAGE(PG8_SB(0, 0), cB, voffB); PG8_STAGE(PG8_SA(0, 0), cA, voffA); PG8_STAGE(PG8_SB(0, 1), cB + hstepB, voffB); PG8_STAGE(PG8_SA(0, 1), cA + hstepA, voffA);
        if (wr == 1) PG8_BAR;
        PG8_WAIT_V(4); PG8_BAR;
        PG8_STAGE(PG8_SB(1, 0), cB + kstep, voffB); PG8_STAGE(PG8_SA(1, 0), cA + kstep, voffA); PG8_STAGE(PG8_SB(1, 1), cB + hstepB + kstep, voffB);
        PG8_WAIT_V(6); PG8_BAR;
    }
    for (;;) {
        const bool has_next = S.next(ui + 1, nxt);
        const char* nA = has_next ? (const char*)g.A + (size_t)nxt.pm * tstepA : cA; const char* nB = has_next ? (const char*)g.Bt + (size_t)nxt.pn * tstepB : cB;
        for (int t = 0; t < nt; t += 2) {
            const bool last = (t == nt - 2);
            const char* a1 = cA + (size_t)(t + 1) * kstep;
            const char* a2 = last ? nA : cA + (size_t)(t + 2) * kstep; const char* b2 = last ? nB : cB + (size_t)(t + 2) * kstep;
            const char* a3 = a2 + kstep; const char* b3 = b2 + kstep;
            if (last && has_next) S.a_ready(nxt);
            if constexpr (SP2) {
            PG8_LDB(B0, 0, 0); PG8_LDB(B1, 0, 1); PG8_SCHED; PG8_LDA(At, 0, 0); PG8_STAGE(PG8_SA(1, 1), a1 + hstepA, voffA);
            PG8_WAIT_V(8); PG8_WAIT_L(0); PG8_BAR; PG8_MMA(0, 0, At, B0); PG8_MMA(0, 1, At, B1); PG8_BAR; PG8_SCHED;
            PG8_LDA(At, 0, 1); PG8_STAGE(PG8_SB(0, 0), b2, voffB); PG8_STAGE(PG8_SB(0, 1), b2 + hstepB, voffB); PG8_STAGE(PG8_SA(0, 0), a2, voffA);
            PG8_WAIT_V(8); PG8_WAIT_L(0); PG8_BAR; PG8_MMA(1, 0, At, B0); PG8_MMA(1, 1, At, B1); PG8_BAR; PG8_SCHED;
            PG8_LDB(B0, 1, 0); PG8_LDB(B1, 1, 1); PG8_SCHED; PG8_LDA(At, 1, 0); PG8_STAGE(PG8_SA(0, 1), a2 + hstepA, voffA);
            PG8_WAIT_V(8); PG8_WAIT_L(0); PG8_BAR; PG8_MMA(0, 0, At, B0); PG8_MMA(0, 1, At, B1); PG8_BAR; PG8_SCHED;
            PG8_LDA(At, 1, 1); PG8_STAGE(PG8_SB(1, 0), b3, voffB); PG8_STAGE(PG8_SB(1, 1), b3 + hstepB, voffB); PG8_STAGE(PG8_SA(1, 0), a3, voffA);
            PG8_WAIT_V(8); PG8_WAIT_L(0); PG8_BAR; PG8_MMA(1, 0, At, B0); PG8_MMA(1, 1, At, B1); PG8_BAR; PG8_SCHED;
            } else {
            PG8_LDB(B0, 0, 0); PG8_SCHED; PG8_LDA(At, 0, 0); PG8_STAGE(PG8_SA(1, 1), a1 + hstepA, voffA);
            PG8_WAIT_L(8); PG8_BAR; PG8_WAIT_L(0); PG8_MMA(0, 0, At, B0); PG8_BAR; PG8_SCHED;
            PG8_LDB(B1, 0, 1); PG8_STAGE(PG8_SB(0, 0), b2, voffB);
            PG8_BAR; PG8_WAIT_L(0); PG8_MMA(0, 1, At, B1); PG8_BAR;
            PG8_LDA(At, 0, 1); PG8_STAGE(PG8_SA(0, 0), a2, voffA);
            PG8_BAR; PG8_WAIT_L(0); PG8_MMA(1, 0, At, B0); PG8_BAR; PG8_SCHED;
            PG8_STAGE(PG8_SB(0, 1), b2 + hstepB, voffB);
            PG8_WAIT_V(6); PG8_BAR; PG8_MMA(1, 1, At, B1); PG8_BAR;
            PG8_LDB(B0, 1, 0); PG8_SCHED; PG8_LDA(At, 1, 0); PG8_STAGE(PG8_SA(0, 1), a2 + hstepA, voffA);
            PG8_WAIT_L(8); PG8_BAR; PG8_WAIT_L(0); PG8_MMA(0, 0, At, B0); PG8_BAR; PG8_SCHED;
            PG8_LDB(B1, 1, 1); PG8_STAGE(PG8_SB(1, 0), b3, voffB);
            PG8_BAR; PG8_WAIT_L(0); PG8_MMA(0, 1, At, B1); PG8_BAR;
            PG8_LDA(At, 1, 1); PG8_STAGE(PG8_SA(1, 0), a3, voffA);
            PG8_BAR; PG8_WAIT_L(0); PG8_MMA(1, 0, At, B0); PG8_BAR; PG8_SCHED;
            PG8_STAGE(PG8_SB(1, 1), b3 + hstepB, voffB);
            PG8_WAIT_V(6); PG8_BAR; PG8_MMA(1, 1, At, B1); PG8_BAR;
            }
        }
        if constexpr (ALIGN_EPI) { if (wr == 0) PG8_BAR; }
        if constexpr (!Epi::AFTER_DRAIN) { E(acc, cur, wr, wc, fr, fq); S.done(cur); }
        if (!has_next) break;
#pragma unroll
        for (int a = 0; a < 2; ++a)
#pragma unroll
            for (int b = 0; b < 2; ++b)
#pragma unroll
                for (int m = 0; m < MF; ++m)
#pragma unroll
                    for (int n = 0; n < 2; ++n) acc[a][b][m][n] = (f32x4){0.f, 0.f, 0.f, 0.f};
        cur = nxt; cA = nA; cB = nB; ++ui;
        if constexpr (ALIGN_EPI) { if (wr == 1) PG8_BAR; }
    }
    PG8_WAIT_V(0);
    if constexpr (!ALIGN_EPI) { if (wr == 0) PG8_BAR; }
    PG8_BAR;
    if constexpr (Epi::AFTER_DRAIN) { E.fused(acc, cur, wr, wc, fr, fq, lds, wid, lane); S.done(cur); }
#undef PG8_SA
#undef PG8_SB
#undef PG8_STAGE
#undef PG8_LDA
#undef PG8_LDB
#undef PG8_MMA
#undef PG8_WAIT_V
#undef PG8_WAIT_L
#undef PG8_BAR
#undef PG8_SCHED
}
}

constexpr bool PG8_SP2 = true, PG8_ALIGN = true;

#define GAS __attribute__((address_space(1)))
#define LAS __attribute__((address_space(3)))
typedef unsigned short bf16;
typedef unsigned v4u __attribute__((ext_vector_type(4)));
typedef float f32x4 __attribute__((ext_vector_type(4)));
typedef short bf16x8 __attribute__((ext_vector_type(8)));
typedef GAS unsigned gu32;
typedef GAS unsigned long long gu64;
#define RLX_AGENT __ATOMIC_RELAXED, __HIP_MEMORY_SCOPE_AGENT
#define LDS_WAIT() asm volatile("s_waitcnt lgkmcnt(0)" ::: "memory")
#define VM_WAIT() asm volatile("s_waitcnt vmcnt(0)" ::: "memory")
__device__ __forceinline__ unsigned long long rt() { return __builtin_amdgcn_s_memrealtime(); }
__device__ __forceinline__ unsigned f2bf(float f) { unsigned u = __builtin_bit_cast(unsigned, f); return (u + 0x7fffu + ((u >> 16) & 1u)) >> 16; }
__device__ __forceinline__ unsigned pk2(float lo, float hi) { return f2bf(lo) | (f2bf(hi) << 16); }

#define XB_TMO      128
#define XB_XCNT(j)  (256  + 64 * (j))
#define XB_XSUB(j)  (1280 + 64 * (j))
#define XB_XGEN(j)  (2304 + 64 * (j))
#define XB_TOP      3328
#define XB_TOPGEN   3392
#define XCD_BAR_WORDS 3456
#define XB_SPIN_CAP (1u << 18)

__device__ __forceinline__ unsigned xb_ld(unsigned* p)              { return __hip_atomic_load(p, __ATOMIC_RELAXED, __HIP_MEMORY_SCOPE_AGENT); }
__device__ __forceinline__ unsigned xb_add(unsigned* p, unsigned v) { return __hip_atomic_fetch_add(p, v, __ATOMIC_RELAXED, __HIP_MEMORY_SCOPE_AGENT); }
__device__ __forceinline__ unsigned xb_xcc_id() { return (unsigned)__builtin_amdgcn_s_getreg((3 << 11) | 20) & 0xFu; }
#define XB_SPIN(cond, bar) do { unsigned _sp = 0; while (cond) { __builtin_amdgcn_s_sleep(1); \
    if ((++_sp & 255u) == 0u) { if (xb_ld(&(bar)[XB_TMO])) break; if (_sp > XB_SPIN_CAP) { atomicAdd(&(bar)[XB_TMO], 1u); break; } } } } while (0)

struct XcdBarrier {
    unsigned* bar; unsigned x;
    volatile LAS unsigned* st;
};

__device__ __forceinline__ XcdBarrier xcd_barrier_post(unsigned* bar, volatile LAS unsigned* st) {
    XcdBarrier b; b.bar = bar; b.x = xb_xcc_id(); b.st = st;
    if (threadIdx.x == 0) (void)xb_add(&bar[XB_XCNT(b.x)], 1u);
    return b;
}
__device__ __forceinline__ void xcd_barrier_complete(unsigned* bar, unsigned x, unsigned& nloc, unsigned& nx) {
    const unsigned G = gridDim.x * gridDim.y * gridDim.z;
    unsigned sum, cnt, mine, sp = 0u;
    for (;;) {
        sum = 0u; cnt = 0u; mine = 0u;
#pragma unroll
        for (unsigned j = 0; j < 16; ++j) { const unsigned c = xb_ld(&bar[XB_XCNT(j)]); sum += c; cnt += (c > 0u) ? 1u : 0u; mine = (j == x) ? c : mine; }
        if (sum == G) break;
        __builtin_amdgcn_s_sleep(1);
        if ((++sp & 255u) == 0u) { if (xb_ld(&bar[XB_TMO])) break; if (sp > XB_SPIN_CAP) { atomicAdd(&bar[XB_TMO], 1u); break; } }
    }
    nloc = mine > 0u ? mine : 1u; nx = cnt > 0u ? cnt : 1u;
}

__device__ __forceinline__ void xcd_barrier(const XcdBarrier& b) {
    asm volatile("s_waitcnt vmcnt(0)" ::: "memory");
    __syncthreads();
    if (threadIdx.x == 0) {
        unsigned* bar = b.bar;
        __builtin_amdgcn_s_waitcnt(0);
        unsigned nloc = b.st[0], nx = b.st[1];
        if (nloc == 0u) { xcd_barrier_complete(bar, b.x, nloc, nx); b.st[0] = nloc; b.st[1] = nx; }
        const unsigned old = xb_add(&bar[XB_XSUB(b.x)], 1u);
        const unsigned gen = old / nloc;
        if (old + 1u == (gen + 1u) * nloc) {
            __builtin_amdgcn_fence(__ATOMIC_RELEASE, "agent");
            asm volatile("s_waitcnt vmcnt(0)" ::: "memory");
            const unsigned og = xb_add(&bar[XB_TOP], 1u);
            const unsigned tg = og / nx;
            if (og + 1u == (tg + 1u) * nx) xb_add(&bar[XB_TOPGEN], 1u);
            else XB_SPIN(xb_ld(&bar[XB_TOPGEN]) == tg, bar);
            __builtin_amdgcn_fence(__ATOMIC_ACQUIRE, "agent");
            xb_add(&bar[XB_XGEN(b.x)], 1u);
            asm volatile("s_waitcnt vmcnt(0)" ::: "memory");
        } else {
            XB_SPIN(xb_ld(&bar[XB_XGEN(b.x)]) == gen, bar);
            __builtin_amdgcn_fence(__ATOMIC_ACQUIRE, "agent");
            asm volatile("s_waitcnt vmcnt(0)" ::: "memory");
        }
    }
    __syncthreads();
}

__device__ __forceinline__ float wave_sum(float v) {
#pragma unroll
    for (int o = 1; o < 64; o <<= 1) v += __shfl_xor(v, o);
    return v;
}
__device__ __forceinline__ void p0_transpose_item(const float* W, int K, int N, bf16* WT, int row_off, LAS float* scr, int item, int lane) {
    const int nblk = N / 32, kb = item / nblk, nb = item % nblk, k0 = 64 * kb, n0 = 32 * nb;
    float tv[32];
#pragma unroll
    for (int i = 0; i < 32; ++i) tv[i] = W[(size_t)(k0 + 2 * i + (lane >> 5)) * N + n0 + (lane & 31)];
#pragma unroll
    for (int i = 0; i < 32; ++i) scr[(2 * i + (lane >> 5)) * 33 + (lane & 31)] = tv[i];
    LDS_WAIT(); asm volatile("" ::: "memory");
    const int c = lane & 7;
#pragma unroll
    for (int j = 0; j < 4; ++j) { const int n = (lane >> 3) + 8 * j; const LAS float* s = scr + (8 * c) * 33 + n;
        v4u o; o.x = pk2(s[0 * 33], s[1 * 33]); o.y = pk2(s[2 * 33], s[3 * 33]); o.z = pk2(s[4 * 33], s[5 * 33]); o.w = pk2(s[6 * 33], s[7 * 33]);
        *(GAS v4u*)(WT + (size_t)(row_off + n0 + n) * K + k0 + 8 * c) = o; }
    LDS_WAIT(); asm volatile("" ::: "memory");
}

#ifndef MK_PROBE_ST
#define MK_PROBE_ST 0
#endif
#ifndef MK_REP0
#define MK_REP0 0
#endif
constexpr int NWAVES = 8;
constexpr int D = 1024, M_CTX = 4096, M_LAT = 8192, MROWS = 12288, INC = 6656, FF = 4096, DH = 512, HYC = 1536;
constexpr int LCTX = 256, LLAT = 1024, PAST = 256, LKLAT = 1280, KROWS = M_CTX + 8 * LKLAT;
constexpr float EPSN = 1e-6f, LAM_INIT = 0.2f;
constexpr float QSCALE = 0.125f * 1.4426950408889634f;
constexpr size_t MiB = 1u << 20;
constexpr size_t WS_CTL = 0, CTL_ZERO_BYTES = 1 * MiB;
constexpr size_t WS_WIN = 1 * MiB, WS_WA = 14 * MiB, WS_WH = 16 * MiB, WS_WO = 17 * MiB, WS_WUP = 19 * MiB, WS_WDN = 27 * MiB;
constexpr size_t WS_MODP = 232 * MiB;
constexpr size_t WS_MODF = 37 * MiB;
constexpr size_t WS_ROPE = 38 * MiB;
constexpr size_t WS_H2 = 38 * MiB + 65536;
constexpr size_t WS_FILT = 39 * MiB;
constexpr size_t WS_XN = 44 * MiB;
constexpr size_t WS_Q = 68 * MiB;
constexpr size_t WS_K = 92 * MiB;
constexpr size_t WS_V = 120 * MiB;
constexpr size_t WS_UT = 148 * MiB;
constexpr size_t WS_G = 184 * MiB;
constexpr size_t WS_UP = 68 * MiB;
constexpr size_t WS_O = 232 * MiB;
constexpr size_t WS_END = 256 * MiB;
constexpr int CW_TMO = 0, CW_CODE = 1, CW_QUEUE = 64, CW_BAR = 4096;
constexpr int DBG_WORDS = 8192, TS_WORDS = 12288;
constexpr int RING_OFF = 0, RING_BYTES = 131072, LDSCTL_OFF = RING_BYTES, MISC_OFF = LDSCTL_OFF + 320, LDS_BYTES = 147456;

struct Args { const float* in[31]; float* out; unsigned char* ws; int stop_after; int pad; };
struct Frame {
    LAS unsigned char* lds; volatile LAS unsigned* MISC; gu32* ctl;
    int tid, lane, wave, vcu, G;
    float* out; unsigned char* ws;
};
#define WSP(T, off) ((T*)(F.ws + (off)))
__device__ __forceinline__ float bf2f(bf16 h) { return __uint_as_float((unsigned)h << 16); }
__device__ __forceinline__ const float* xrow_ptr(const Frame& F, const Args& A, int row) { return row < M_CTX ? A.in[0] + (size_t)row * D : A.in[1] + (size_t)(row - M_CTX) * D; }
__device__ __forceinline__ int mod_row(int row) { return row < M_CTX ? 0 : 1 + ((row - M_CTX) >> 10); }

__device__ __forceinline__ void p0_mod_item(const Frame& F, const Args& A, LAS float* scr, int item) {
    const int cb = item >> 3, kc = item & 7, lane = F.lane, col = cb * 64 + lane, k0 = kc * 128;
    float sv0[9], sv1[9];
#pragma unroll
    for (int r = 0; r < 9; ++r) { const float* cv = (r == 0) ? A.in[5] : A.in[4] + (r - 1) * D; const float x0 = cv[k0 + lane], x1 = cv[k0 + 64 + lane];
        sv0[r] = x0 / (1.f + expf(-x0)); sv1[r] = x1 / (1.f + expf(-x1)); }
    float acc[9];
#pragma unroll
    for (int r = 0; r < 9; ++r) acc[r] = 0.f;
    const float* wp = A.in[6] + (size_t)k0 * 6144 + col;
#pragma unroll 1
    for (int kb = 0; kb < 4; ++kb, wp += 32 * 6144) { float w[32];
#pragma unroll
        for (int k = 0; k < 32; ++k) w[k] = wp[(size_t)k * 6144];
        float svr[9];
#pragma unroll
        for (int r = 0; r < 9; ++r) svr[r] = kb < 2 ? sv0[r] : sv1[r];
        const int lb = (kb & 1) * 32;
#pragma unroll
        for (int k = 0; k < 32; ++k)
#pragma unroll
            for (int r = 0; r < 9; ++r) acc[r] += __int_as_float(__builtin_amdgcn_readlane(__float_as_int(svr[r]), lb + k)) * w[k]; }
    float* mp = WSP(float, WS_MODP) + (size_t)kc * 9 * 6144 + col;
#pragma unroll
    for (int r = 0; r < 9; ++r) mp[r * 6144] = acc[r];
    (void)scr;
}
__device__ __forceinline__ void p0_cache_item(const Frame& F, const Args& A, int r) {
    const int b = r >> 8, j = r & 255; const size_t drow = (size_t)(M_CTX + b * LKLAT + j) * D;
    const GAS f32x4* sk = (const GAS f32x4*)(A.in[2] + (size_t)r * D) + F.lane; const GAS f32x4* sv = (const GAS f32x4*)(A.in[3] + (size_t)r * D) + F.lane;
    GAS unsigned long long* dk = (GAS unsigned long long*)(WSP(bf16, WS_K) + drow) + F.lane; GAS unsigned long long* dv = (GAS unsigned long long*)(WSP(bf16, WS_V) + drow) + F.lane;
#pragma unroll
    for (int q = 0; q < 4; ++q) { const f32x4 a = sk[64 * q], c = sv[64 * q];
        dk[64 * q] = (unsigned long long)pk2(a.x, a.y) | ((unsigned long long)pk2(a.z, a.w) << 32);
        dv[64 * q] = (unsigned long long)pk2(c.x, c.y) | ((unsigned long long)pk2(c.z, c.w) << 32); }
}
__device__ __forceinline__ void p0_rope_item(const Frame& F, const Args& A) {
    float* tb = WSP(float, WS_ROPE);
    for (int e = F.lane; e < 1024; e += 64) { const int pos = e >> 4, i = e & 15; const float inv = powf(10000.0f, -(float)i / 16.0f); const float ang = (float)pos * inv;
        tb[2 * e] = cosf(ang); tb[2 * e + 1] = sinf(ang); }
}
__device__ __forceinline__ void p0_filter_item(const Frame& F, const Args& A, LAS float* scr, const LAS float* wsh, int item) {
    const int lane = F.lane; const bool big = item >= 256; const int L = big ? 1024 : 256, t = big ? item - 256 : item; const float tt = (float)t / (float)(L - 1);
    const LAS float* w1s = wsh + lane; const LAS float* w2s = wsh + 33 * 64 + lane;
    if (lane < 33) { float e;
        if (lane == 0) e = tt;
        else { const int bnd = (lane - 1) & 15; const float f = 1e-4f + (float)bnd * ((15.0f - 1e-4f) / 15.0f); const float wpos = 2.0f * 3.14159265358979323846f * (float)t / (float)L; const float a = f * wpos;
            e = (lane <= 16) ? cosf(a) : -sinf(a); }
        scr[lane] = e; }
    LDS_WAIT(); asm volatile("" ::: "memory");
    const float fr = A.in[23][lane];
    float acc = A.in[19][lane];
#pragma unroll
    for (int i = 0; i < 33; ++i) acc += scr[i] * w1s[i * 64];
    scr[64 + lane] = sinf(fr * acc);
    LDS_WAIT(); asm volatile("" ::: "memory");
    float acc2 = A.in[21][lane];
#pragma unroll
    for (int i = 0; i < 64; ++i) acc2 += scr[64 + i] * w2s[i * 64];
    WSP(float, WS_H2)[(size_t)lane * 1280 + item] = sinf(fr * acc2);
    LDS_WAIT(); asm volatile("" ::: "memory");
}
typedef float f32x16t __attribute__((ext_vector_type(16)));
__device__ __forceinline__ void p1_taps_item(const Frame& F, const Args& A, int item) {
    const int lane = F.lane, r32 = lane & 31, hi = lane >> 5, cp = item & 31, pb = item >> 5; const bool big = pb >= 8; const int L = big ? 1024 : 256;
    const int t = (big ? pb - 8 : pb) * 32 + r32, pos = (big ? 256 : 0) + t, col0 = cp * 32;
    const float* wp = A.in[22] + (size_t)hi * 2048 + col0 + r32; const float* hp = WSP(const float, WS_H2) + (size_t)hi * 1280 + pos;
    f32x16t cf = f32x16t{}, cb = f32x16t{};
#pragma unroll 4
    for (int st = 0; st < 32; ++st) { const float wf = wp[(size_t)st * 4096], wb = wp[(size_t)st * 4096 + 1024], h = hp[(size_t)st * 2560];
        cf = __builtin_amdgcn_mfma_f32_32x32x2f32(wf, h, cf, 0, 0, 0); cb = __builtin_amdgcn_mfma_f32_32x32x2f32(wb, h, cb, 0, 0, 0); }
    bf16* R = WSP(bf16, WS_FILT) + (big ? (size_t)(1 * MiB / 2) : 0);
    const float d0 = logf(1e-2f) / 0.3f, d1 = logf(1e-2f) / 1.5f; const float tt = (float)t / (float)(L - 1);
#pragma unroll
    for (int r = 0; r < 16; ++r) { const int col = col0 + (r & 3) + 8 * (r >> 2) + 4 * hi, ch = col & 511, ord = col >> 9; const float dec = expf(-tt * fabsf(d0 + (d1 - d0) * (float)ch / 511.0f));
        bf16* Rc = R + ((size_t)ord * 512 + ch) * (2 * L);
        if (t == 0) { Rc[L] = (bf16)f2bf((cf[r] + cb[r]) * dec); Rc[0] = 0; } else { Rc[L - t] = (bf16)f2bf(cf[r] * dec); Rc[L + t] = (bf16)f2bf(cb[r] * dec); } }
}
__device__ __forceinline__ void p0_prologue(const Frame& F, const Args& A) {
    LAS float* scr = (LAS float*)(F.lds + RING_OFF + F.wave * 9216);
    LAS float* wsh = (LAS float*)(F.lds + RING_OFF + 8 * 9216);
    for (int i = F.tid; i < 33 * 64 + 64 * 64; i += NWAVES * 64) wsh[i] = i < 33 * 64 ? A.in[18][i] : A.in[20][i - 33 * 64];
    __syncthreads();
    const int gw = F.vcu * NWAVES + F.wave, NGW = F.G * NWAVES;
    constexpr int I_IN = (D / 64) * (INC / 32), I_A = (D / 64) * (D / 32), I_H = (DH / 64) * (D / 32);
    constexpr int N_MOD = 768, N_CACHE = 2048, N_FILT = 1280;
    if (NGW == 2048) { if (gw < N_FILT) { for (int q_ = 0; q_ <= (MK_REP0 & 1); ++q_) p0_filter_item(F, A, scr, wsh, gw); } else { for (int q_ = 0; q_ <= ((MK_REP0 >> 1) & 1); ++q_) p0_mod_item(F, A, scr, gw - N_FILT); } }
    else { for (int it = gw; it < N_FILT; it += NGW) p0_filter_item(F, A, scr, wsh, it); for (int it = gw; it < N_MOD; it += NGW) p0_mod_item(F, A, scr, it); }
    if (gw == NGW - 1) p0_rope_item(F, A);
    for (int q_ = 0; q_ <= ((MK_REP0 >> 2) & 1); ++q_) for (int it = gw; it < N_CACHE; it += NGW) p0_cache_item(F, A, it);
    for (int q_ = 0; q_ <= ((MK_REP0 >> 3) & 1); ++q_) for (int it = gw; it < I_IN + I_A + I_H; it += NGW) {
        int r = it;
        if (r < I_IN) { p0_transpose_item(A.in[10], D, INC, WSP(bf16, WS_WIN), 0, scr, r, F.lane); continue; } r -= I_IN;
        if (r < I_A) { p0_transpose_item(A.in[25], D, D, WSP(bf16, WS_WA), 0, scr, r, F.lane); continue; } r -= I_A;
        p0_transpose_item(A.in[26], DH, D, WSP(bf16, WS_WH), 0, scr, r, F.lane);
    }
}
constexpr int N_TRU = 72;
__device__ __forceinline__ void p3_transpose_unit(const Frame& F, const Args& A, int u) {
    constexpr int I_O = (D / 64) * (D / 32), I_UP = (D / 64) * (FF / 32);
    LAS float* scr = (LAS float*)(F.lds + RING_OFF + F.wave * 9216);
#pragma unroll 1
    for (int j = 0; j < 8; ++j) { int r = u * 64 + F.wave * 8 + j;
        if (r < I_O) { p0_transpose_item(A.in[27], D, D, WSP(bf16, WS_WO), 0, scr, r, F.lane); continue; } r -= I_O;
        if (r < I_UP) { p0_transpose_item(A.in[28], D, FF, WSP(bf16, WS_WUP), 0, scr, r, F.lane); continue; } r -= I_UP;
        p0_transpose_item(A.in[29], FF, D, WSP(bf16, WS_WDN), 0, scr, r, F.lane); }
}
__device__ __forceinline__ void modnorm_rows(const Frame& F, const Args& A, int which) {
    const int gw = F.vcu * NWAVES + F.wave, NGW = F.G * NWAVES, lane = F.lane;
    const float* gvec = which ? A.in[9] : A.in[8]; const int shoff = which ? 3072 : 0, scoff = which ? 4096 : 1024;
    if (which == 0) { for (int it = gw; it < 1280; it += NGW) p1_taps_item(F, A, it); }
    for (int ch = gw; ch < MROWS / 6; ch += NGW) {
        int cur = -1; f32x4 av[4], sv[4];
        for (int rr = 0; rr < 6; ++rr) { const int row = ch * 6 + rr; const int mr = mod_row(row);
            if (mr != cur) { cur = mr;
#pragma unroll
                for (int j = 0; j < 4; ++j) { const int c = 4 * lane + 256 * j; f32x4 sh, sc;
                    if (which == 0) { sh = *(const GAS f32x4*)(A.in[7] + c); sc = *(const GAS f32x4*)(A.in[7] + 1024 + c);
                        for (int kc = 0; kc < 8; ++kc) { const float* mp = WSP(float, WS_MODP) + ((size_t)kc * 9 + mr) * 6144; sh += *(const GAS f32x4*)(mp + c); sc += *(const GAS f32x4*)(mp + 1024 + c); } }
                    else { const float* mf = WSP(float, WS_MODF) + (size_t)mr * 6144; sh = *(const GAS f32x4*)(mf + shoff + c); sc = *(const GAS f32x4*)(mf + scoff + c); }
                    const f32x4 g = *(const GAS f32x4*)(gvec + c); av[j] = g * (sc + 1.0f); sv[j] = sh; } }
            const float* xr = which ? F.out + (size_t)row * D : xrow_ptr(F, A, row);
            f32x4 v[4]; float s = 0.f;
#pragma unroll
            for (int j = 0; j < 4; ++j) { v[j] = *(const GAS f32x4*)(xr + 4 * lane + 256 * j); s += (v[j].x * v[j].x + v[j].y * v[j].y) + (v[j].z * v[j].z + v[j].w * v[j].w); }
            const float rstd = 1.f / sqrtf(wave_sum(s) * (1.f / D) + EPSN);
            GAS unsigned long long* o8 = (GAS unsigned long long*)(WSP(bf16, WS_XN) + (size_t)row * D) + lane;
#pragma unroll
            for (int j = 0; j < 4; ++j) { const f32x4 y = v[j] * rstd * av[j] + sv[j]; o8[64 * j] = (unsigned long long)pk2(y.x, y.y) | ((unsigned long long)pk2(y.z, y.w) << 32); } }
    }
    if (which == 0) {
        for (int it = gw; it < 9 * 6144 / 64; it += NGW) { const int idx = it * 64 + lane, r = idx / 6144, col = idx % 6144; float a = A.in[7][col];
            for (int kc = 0; kc < 8; ++kc) a += WSP(float, WS_MODP)[((size_t)kc * 9 + r) * 6144 + col];
            WSP(float, WS_MODF)[idx] = a; } }
}
struct EpiIn {
    static constexpr bool PERM = true, AFTER_DRAIN = false;
    bf16 *Q, *Kb, *Vb, *UT, *G; float *nk, *nv; const float* rope;
    __device__ __forceinline__ void operator()(const pg8::f32x4 (&acc)[2][2][4][2], const pg8::Unit& u, int wr, int wc, int fr, int fq) const {
        using pg8::f32x4; using pg8::u32x4;
        const int pn = u.pn, pm = u.pm; const bool lat = pm >= 16;
        const int rowt = pm * 256 + wr * 64 + fr;
        if (pn < 12) {
            const int typ = pn >> 2, cb = (pn & 3) * 256 + wc * 32 + 8 * fq;
            const int lb = (pm - 16) >> 2, t0 = ((pm - 16) & 3) * 256 + wr * 64 + fr;
#pragma unroll
            for (int ai = 0; ai < 2; ++ai)
#pragma unroll
                for (int m = 0; m < 4; ++m) {
                    const int row = rowt + ai * 128 + m * 16, t = t0 + ai * 128 + m * 16;
#pragma unroll
                    for (int bj = 0; bj < 2; ++bj) {
                        f32x4 v0 = acc[ai][bj][m][0], v1 = acc[ai][bj][m][1];
                        if (lat && typ < 2) {
                            const int pos = (wc & 1) ? (t & 63) : (t >> 6);
                            const float* tb = rope + (size_t)pos * 32 + (8 * (fq & 1)) * 2;
                            const f32x4 c0 = *(const f32x4*)(tb), c1 = *(const f32x4*)(tb + 4), c2 = *(const f32x4*)(tb + 8), c3 = *(const f32x4*)(tb + 12);
                            f32x4 p0, p1;
                            p0.x = __shfl_xor(v0.x, 32); p0.y = __shfl_xor(v0.y, 32); p0.z = __shfl_xor(v0.z, 32); p0.w = __shfl_xor(v0.w, 32);
                            p1.x = __shfl_xor(v1.x, 32); p1.y = __shfl_xor(v1.y, 32); p1.z = __shfl_xor(v1.z, 32); p1.w = __shfl_xor(v1.w, 32);
                            const float sg = (fq < 2) ? -1.f : 1.f;
                            v0.x = v0.x * c0.x + sg * p0.x * c0.y; v0.y = v0.y * c0.z + sg * p0.y * c0.w; v0.z = v0.z * c1.x + sg * p0.z * c1.y; v0.w = v0.w * c1.z + sg * p0.w * c1.w;
                            v1.x = v1.x * c2.x + sg * p1.x * c2.y; v1.y = v1.y * c2.z + sg * p1.y * c2.w; v1.z = v1.z * c3.x + sg * p1.z * c3.y; v1.w = v1.w * c3.z + sg * p1.w * c3.w;
                        }
                        const int col = cb + bj * 128;
                        if (!lat && typ > 0) { float* op = (typ == 1 ? nk : nv) + (size_t)row * D + col; *(f32x4*)op = v0; *(f32x4*)(op + 4) = v1; }
                        if (typ == 0) { v0 = v0 * QSCALE; v1 = v1 * QSCALE; }
                        u32x4 w; w.x = pg8::cvt_pk_bf16(v0[0], v0[1]); w.y = pg8::cvt_pk_bf16(v0[2], v0[3]); w.z = pg8::cvt_pk_bf16(v1[0], v1[1]); w.w = pg8::cvt_pk_bf16(v1[2], v1[3]);
                        bf16* dst;
                        if (typ == 0) dst = Q + (size_t)row * D + col;
                        else { const size_t kr = lat ? (size_t)(M_CTX + lb * LKLAT + PAST + t) : (size_t)row; dst = (typ == 1 ? Kb : Vb) + kr * D + col; }
                        *(u32x4*)dst = w;
                    }
                }
        } else if (pn < 18) {
            const int cb = (pn - 12) * 256 + wc * 32 + 8 * fq;
#pragma unroll
            for (int ai = 0; ai < 2; ++ai)
#pragma unroll
                for (int m = 0; m < 4; ++m) { const int row = rowt + ai * 128 + m * 16;
#pragma unroll
                    for (int bj = 0; bj < 2; ++bj)
#pragma unroll
                        for (int n = 0; n < 2; ++n)
#pragma unroll
                            for (int e = 0; e < 4; ++e) UT[(size_t)(cb + bj * 128 + 4 * n + e) * MROWS + row] = (bf16)f2bf(acc[ai][bj][m][n][e]); }
        } else {
            const int cb = (pn - 18) * 256 + wc * 32 + 8 * fq;
#pragma unroll
            for (int ai = 0; ai < 2; ++ai)
#pragma unroll
                for (int m = 0; m < 4; ++m) { const int row = rowt + ai * 128 + m * 16;
#pragma unroll
                    for (int bj = 0; bj < 2; ++bj) { f32x4 v0 = acc[ai][bj][m][0], v1 = acc[ai][bj][m][1];
#pragma unroll
                        for (int e = 0; e < 4; ++e) { v0[e] = 1.f / (1.f + __expf(-v0[e])); v1[e] = 1.f / (1.f + __expf(-v1[e])); }
                        u32x4 w; w.x = pg8::cvt_pk_bf16(v0[0], v0[1]); w.y = pg8::cvt_pk_bf16(v0[2], v0[3]); w.z = pg8::cvt_pk_bf16(v1[0], v1[1]); w.w = pg8::cvt_pk_bf16(v1[2], v1[3]);
                        *(u32x4*)(G + (size_t)row * 2048 + cb + bj * 128) = w; } }
        }
    }
};

typedef float f32x16 __attribute__((ext_vector_type(16)));
typedef short s16x4 __attribute__((ext_vector_type(4)));
constexpr int AT_KV = 32768;
static_assert(4 * AT_KV <= RING_BYTES, "attention LDS");
__device__ __forceinline__ unsigned off_b(unsigned row, unsigned ch) { return 256u * row + 16u * (ch ^ (((row & 3u) << 2) | ((row >> 2) & 3u))); }
__device__ __forceinline__ s16x4 tr16(LAS unsigned char* p) { return __builtin_bit_cast(s16x4, __builtin_amdgcn_ds_read_tr16_b64_v4i16((LAS s16x4*)p)); }
__device__ __forceinline__ unsigned pkbf(float lo, float hi) { return pg8::cvt_pk_bf16(lo, hi); }
__device__ __forceinline__ float xh_max(float v) { auto rr = __builtin_amdgcn_permlane32_swap(__float_as_uint(v), __float_as_uint(v), false, false); return fmaxf(__uint_as_float(rr[0]), __uint_as_float(rr[1])); }
__device__ __forceinline__ float xh_sum(float v) { auto rr = __builtin_amdgcn_permlane32_swap(__float_as_uint(v), __float_as_uint(v), false, false); return __uint_as_float(rr[0]) + __uint_as_float(rr[1]); }
__device__ __forceinline__ void attn_unit(const Frame& F, const Args& A, bf16* Obuf, int qrow0, int krow0, int nt, int head) {
    int tid = F.tid; asm volatile("" : "+v"(tid));
    const int lane = tid & 63, wave = __builtin_amdgcn_readfirstlane(tid >> 6), r32 = lane & 31, hi = lane >> 5, mp = wave >> 2, qb = wave & 3;
    bf16x8 qf[4];
    { const bf16* qg = WSP(const bf16, WS_Q) + (size_t)(qrow0 + qb * 32 + r32) * D + head * 128 + mp * 64 + 8 * hi;
#pragma unroll
      for (int ds = 0; ds < 4; ++ds) qf[ds] = *(const GAS bf16x8*)(qg + 16 * ds); }
    const bf16* kg = WSP(const bf16, WS_K) + (size_t)krow0 * D + head * 128; const bf16* vg = WSP(const bf16, WS_V) + (size_t)krow0 * D + head * 128;
    const int srow = wave * 8 + (lane >> 4); const unsigned sc0 = (unsigned)(lane & 15) ^ ((((unsigned)srow & 3u) << 2) | (((unsigned)srow >> 2) & 3u)), sc1 = (unsigned)(lane & 15) ^ ((((unsigned)(srow + 4) & 3u) << 2) | (((unsigned)(srow + 4) >> 2) & 3u));
    const bf16* ks0 = kg + (size_t)srow * D + sc0 * 8; const bf16* ks1 = kg + (size_t)(srow + 4) * D + sc1 * 8;
    const bf16* vs0 = vg + (size_t)srow * D + sc0 * 8; const bf16* vs1 = vg + (size_t)(srow + 4) * D + sc1 * 8;
    LAS unsigned char* dbase = F.lds + wave * 2048;
#define AT_STAGE(tt, bufsel) do { const size_t o_ = (size_t)(tt) * 64 * D; LAS unsigned char* d_ = dbase + (bufsel) * AT_KV; \
        __builtin_amdgcn_global_load_lds((const unsigned*)(ks0 + o_), (LAS unsigned*)(d_), 16, 0, 0); __builtin_amdgcn_global_load_lds((const unsigned*)(ks1 + o_), (LAS unsigned*)(d_ + 1024), 16, 0, 0); \
        __builtin_amdgcn_global_load_lds((const unsigned*)(vs0 + o_), (LAS unsigned*)(d_ + 16384), 16, 0, 0); __builtin_amdgcn_global_load_lds((const unsigned*)(vs1 + o_), (LAS unsigned*)(d_ + 16384 + 1024), 16, 0, 0); } while (0)
    const int blk = (lane >> 4) & 1, q4 = (lane & 15) >> 2, p4 = lane & 3;
    unsigned ka[4], va[2][4];
    { const unsigned fr = (((unsigned)r32 & 3u) << 2) | (((unsigned)r32 >> 2) & 3u), g = (unsigned)(8 * mp + hi) ^ fr, c2 = (unsigned)(2 * blk + (p4 >> 1));
      const unsigned vb0 = 256u * (unsigned)(4 * hi + q4) + 16u * (c2 ^ (unsigned)hi) + 8u * (unsigned)(p4 & 1), vb1 = 256u * (unsigned)(4 * hi + q4 + 8) + 16u * (c2 ^ (unsigned)(hi + 2)) + 8u * (unsigned)(p4 & 1);
#pragma unroll
      for (int i = 0; i < 4; ++i) { ka[i] = 256u * (unsigned)r32 + 16u * (g ^ (unsigned)(2 * i)); va[0][i] = 16384u + vb0 + 64u * ((unsigned)i ^ (unsigned)q4); va[1][i] = 16384u + vb1 + 64u * ((unsigned)i ^ (unsigned)q4); } }
    AT_STAGE(0, 0); if (nt > 1) AT_STAGE(1, 1); if (nt > 2) AT_STAGE(2, 2);
    if (nt > 2) asm volatile("s_waitcnt vmcnt(4)\n\ts_barrier" ::: "memory"); else asm volatile("s_waitcnt vmcnt(0)\n\ts_barrier" ::: "memory");
    f32x16 O[4];
#pragma unroll
    for (int e = 0; e < 4; ++e) O[e] = f32x16{};
    float mrun = -1e30f, lrun = 0.f;
    f32x16 S0 = f32x16{}, S1 = f32x16{};
#pragma unroll
    for (int ds = 0; ds < 4; ++ds) { const bf16x8 k0 = *(const LAS bf16x8*)(F.lds + ka[ds]); const bf16x8 k1 = *(const LAS bf16x8*)(F.lds + ka[ds] + 8192);
        S0 = __builtin_amdgcn_mfma_f32_32x32x16_bf16(k0, qf[ds], S0, 0, 0, 0); S1 = __builtin_amdgcn_mfma_f32_32x32x16_bf16(k1, qf[ds], S1, 0, 0, 0); }
    for (int t = 0; t < nt; ++t) {
        LAS unsigned char* lk = F.lds + (t & 3) * AT_KV; LAS unsigned char* ln = F.lds + ((t + 1) & 3) * AT_KV;
        if (t + 3 < nt) AT_STAGE(t + 3, (t + 3) & 3);
        f32x16 N0 = f32x16{}, N1 = f32x16{};
        if (t + 1 < nt) {
#pragma unroll
            for (int ds = 0; ds < 4; ++ds) { const bf16x8 k0 = *(const LAS bf16x8*)(ln + ka[ds]); const bf16x8 k1 = *(const LAS bf16x8*)(ln + ka[ds] + 8192);
                N0 = __builtin_amdgcn_mfma_f32_32x32x16_bf16(k0, qf[ds], N0, 0, 0, 0); N1 = __builtin_amdgcn_mfma_f32_32x32x16_bf16(k1, qf[ds], N1, 0, 0, 0); } }
        float mx = fmaxf(S0[0], S1[0]);
#pragma unroll
        for (int r = 1; r < 16; ++r) mx = fmaxf(mx, fmaxf(S0[r], S1[r]));
        mx = xh_max(mx);
        const float mn = fmaxf(mrun, mx); const float alpha = __builtin_amdgcn_exp2f(mrun - mn);
        float rs = 0.f;
#pragma unroll
        for (int r = 0; r < 16; ++r) { S0[r] = __builtin_amdgcn_exp2f(S0[r] - mn); S1[r] = __builtin_amdgcn_exp2f(S1[r] - mn); rs += S0[r] + S1[r]; }
        mrun = mn; lrun = lrun * alpha + rs;
#pragma unroll
        for (int e = 0; e < 4; ++e) O[e] = O[e] * alpha;
        bf16x8 P[4];
#pragma unroll
        for (int s = 0; s < 2; ++s) {
            v4u a, b;
            a.x = pkbf(S0[8 * s + 0], S0[8 * s + 1]); a.y = pkbf(S0[8 * s + 2], S0[8 * s + 3]); a.z = pkbf(S0[8 * s + 4], S0[8 * s + 5]); a.w = pkbf(S0[8 * s + 6], S0[8 * s + 7]);
            b.x = pkbf(S1[8 * s + 0], S1[8 * s + 1]); b.y = pkbf(S1[8 * s + 2], S1[8 * s + 3]); b.z = pkbf(S1[8 * s + 4], S1[8 * s + 5]); b.w = pkbf(S1[8 * s + 6], S1[8 * s + 7]);
            P[0 * 2 + s] = __builtin_bit_cast(bf16x8, a); P[1 * 2 + s] = __builtin_bit_cast(bf16x8, b); }
#pragma unroll
        for (int eb = 0; eb < 4; ++eb)
#pragma unroll
            for (int kb = 0; kb < 2; ++kb)
#pragma unroll
                for (int s = 0; s < 2; ++s) {
                    const s16x4 lo = tr16(lk + va[0][eb] + (8192 * kb + 4096 * s)); const s16x4 hh = tr16(lk + va[1][eb] + (8192 * kb + 4096 * s));
                    const bf16x8 vf = (bf16x8){lo[0], lo[1], lo[2], lo[3], hh[0], hh[1], hh[2], hh[3]};
                    O[eb] = __builtin_amdgcn_mfma_f32_32x32x16_bf16(vf, P[kb * 2 + s], O[eb], 0, 0, 0); }
        S0 = N0; S1 = N1;
        if (t + 3 < nt) asm volatile("s_waitcnt vmcnt(4) lgkmcnt(0)\n\ts_barrier" ::: "memory"); else asm volatile("s_waitcnt vmcnt(0) lgkmcnt(0)\n\ts_barrier" ::: "memory");
    }
#undef AT_STAGE
    lrun = xh_sum(lrun);
    LAS float* X = (LAS float*)(F.lds + qb * 16384);
    if (mp == 1) {
        float s1 = 0.f, s2 = 0.f;
        for (int i = 0; i < 64; ++i) { s1 += A.in[11][i] * A.in[12][i]; s2 += A.in[13][i] * A.in[14][i]; }
        const float lam = expf(s1) - expf(s2) + LAM_INIT; const float sc = lam / lrun;
#pragma unroll
        for (int e = 0; e < 4; ++e)
#pragma unroll
            for (int r = 0; r < 16; ++r) X[(e * 32 + (r & 3) + 8 * (r >> 2) + 4 * hi) * 32 + r32] = O[e][r] * sc;
    }
    __syncthreads();
    if (mp == 0) {
        const float i0 = 1.f / lrun; float ss = 0.f;
#pragma unroll
        for (int e = 0; e < 4; ++e)
#pragma unroll
            for (int r = 0; r < 16; ++r) { const float o = O[e][r] * i0 - X[(e * 32 + (r & 3) + 8 * (r >> 2) + 4 * hi) * 32 + r32]; O[e][r] = o; ss += o * o; }
        ss = xh_sum(ss);
        const float rstd = (1.f - LAM_INIT) / sqrtf(ss * (1.f / 128.f) + EPSN);
        LAS unsigned char* stg = (LAS unsigned char*)X;
#pragma unroll
        for (int e = 0; e < 4; ++e)
#pragma unroll
            for (int g4 = 0; g4 < 4; ++g4) { const int e0 = e * 32 + 8 * g4 + 4 * hi; const f32x4 gg = *(const GAS f32x4*)(A.in[15] + e0);
                const unsigned w0 = pkbf(O[e][4 * g4 + 0] * rstd * gg.x, O[e][4 * g4 + 1] * rstd * gg.y), w1 = pkbf(O[e][4 * g4 + 2] * rstd * gg.z, O[e][4 * g4 + 3] * rstd * gg.w);
                *(LAS unsigned long long*)(stg + r32 * 256 + ((((unsigned)e0 >> 3) ^ ((unsigned)r32 & 15u)) << 4) + (e0 & 7) * 2) = (unsigned long long)w0 | ((unsigned long long)w1 << 32); }
        LDS_WAIT(); asm volatile("" ::: "memory");
        { bf16* og = Obuf + (size_t)(qrow0 + qb * 32) * D + head * 128;
#pragma unroll
          for (int i = 0; i < 8; ++i) { const int id = lane + 64 * i, row = id >> 4, ch = id & 15; const v4u x = *(const LAS v4u*)(stg + row * 256 + ((ch ^ (row & 15)) << 4)); *(GAS v4u*)(og + (size_t)row * D + ch * 8) = x; } }
        LDS_WAIT(); asm volatile("" ::: "memory");
    }
}

template <int L, int NB> __device__ __forceinline__ void hyena_unit(const Frame& F, const Args& A, int c) {
    constexpr int ROW0 = (L == LCTX) ? 0 : M_CTX, NTOK = NB * L, PITCH = L + 8, CP = 2 * L + 8, TW = (L / 16) / 8;
    constexpr int OFF_V = 8 * CP * 2, ARR = NB * PITCH * 2, OFF_Z = OFF_V + ARR, OFF_X1 = OFF_Z + ARR, OFF_X2 = OFF_X1 + ARR;
    static_assert(OFF_X2 + ARR <= RING_BYTES, "hyena LDS");
    int tid = F.tid; asm volatile("" : "+v"(tid));
    const int lane = tid & 63, wave = __builtin_amdgcn_readfirstlane(tid >> 6);
    LAS unsigned char* lds = F.lds;
#pragma unroll
    for (int p = 0; p < 3; ++p) {
        const bf16* src = WSP(const bf16, WS_UT) + (size_t)(p * DH + c) * MROWS + ROW0;
        const float w0 = A.in[16][p * DH + c], w1 = A.in[16][HYC + p * DH + c], w2 = A.in[16][2 * HYC + p * DH + c], bb = A.in[17][p * DH + c];
        LAS unsigned char* dst = lds + (p == 0 ? OFF_V : (p == 1 ? OFF_X1 : OFF_X2));
        for (int idx = tid; idx < NTOK / 8; idx += NWAVES * 64) { const int t8 = idx * 8, b = t8 / L, t = t8 % L;
            const v4u raw = *(const GAS v4u*)(src + t8);
            float x[10];
            x[0] = (t == 0) ? 0.f : bf2f(src[t8 - 1]); x[9] = (t + 8 == L) ? 0.f : bf2f(src[t8 + 8]);
            x[1] = __uint_as_float(raw.x << 16); x[2] = __uint_as_float(raw.x & 0xffff0000u); x[3] = __uint_as_float(raw.y << 16); x[4] = __uint_as_float(raw.y & 0xffff0000u);
            x[5] = __uint_as_float(raw.z << 16); x[6] = __uint_as_float(raw.z & 0xffff0000u); x[7] = __uint_as_float(raw.w << 16); x[8] = __uint_as_float(raw.w & 0xffff0000u);
            v4u o;
            o.x = pk2(w0 * x[0] + w1 * x[1] + w2 * x[2] + bb, w0 * x[1] + w1 * x[2] + w2 * x[3] + bb); o.y = pk2(w0 * x[2] + w1 * x[3] + w2 * x[4] + bb, w0 * x[3] + w1 * x[4] + w2 * x[5] + bb);
            o.z = pk2(w0 * x[4] + w1 * x[5] + w2 * x[6] + bb, w0 * x[5] + w1 * x[6] + w2 * x[7] + bb); o.w = pk2(w0 * x[6] + w1 * x[7] + w2 * x[8] + bb, w0 * x[7] + w1 * x[8] + w2 * x[9] + bb);
            *(LAS v4u*)(dst + (b * PITCH + t) * 2) = o; }
    }
    const float bias0 = A.in[24][c], bias1 = A.in[24][DH + c];
    const int tl = lane & 15, kg = lane >> 4, msh = (16 - tl) & 7;
#pragma unroll
    for (int ord = 0; ord < 2; ++ord) {
        { const bf16* R = WSP(const bf16, WS_FILT) + (L == LCTX ? 0 : (size_t)(MiB / 2)) + ((size_t)ord * DH + c) * (2 * L);
          for (int q = tid; q < 2 * L / 8; q += NWAVES * 64) {
              const v4u lo = *(const GAS v4u*)(R + 8 * q); v4u hi4 = (v4u){0u, 0u, 0u, 0u}; if (q + 1 < 2 * L / 8) hi4 = *(const GAS v4u*)(R + 8 * q + 8);
              const unsigned w[8] = {lo.x, lo.y, lo.z, lo.w, hi4.x, hi4.y, hi4.z, hi4.w};
#pragma unroll
              for (int m = 0; m < 8; ++m) { v4u o;
                  if (m & 1) { o.x = __builtin_amdgcn_alignbit(w[m / 2 + 1], w[m / 2], 16); o.y = __builtin_amdgcn_alignbit(w[m / 2 + 2], w[m / 2 + 1], 16); o.z = __builtin_amdgcn_alignbit(w[m / 2 + 3], w[m / 2 + 2], 16); o.w = __builtin_amdgcn_alignbit(w[m / 2 + 4], w[m / 2 + 3], 16); }
                  else { o.x = w[m / 2]; o.y = w[m / 2 + 1]; o.z = w[m / 2 + 2]; o.w = w[m / 2 + 3]; }
                  *(LAS v4u*)(lds + (m * CP + 8 * q) * 2) = o; } } }
        __syncthreads();
        pg8::f32x4 acc[TW];
#pragma unroll
        for (int i = 0; i < TW; ++i) acc[i] = (pg8::f32x4){0.f, 0.f, 0.f, 0.f};
        const LAS unsigned char* ub = lds + (ord == 0 ? OFF_V : OFF_Z) + ((lane & (NB - 1)) * PITCH + 8 * kg) * 2;
        const int tbase = wave * TW * 16;
        const LAS unsigned char* ab = lds + (msh * CP + (L - tbase - tl + 8 * kg - msh)) * 2;
#pragma unroll 2
        for (int ss = 0; ss < L / 32; ++ss) { const bf16x8 bfr = *(const LAS bf16x8*)(ub + ss * 64);
#pragma unroll
            for (int i = 0; i < TW; ++i) { const bf16x8 afr = *(const LAS bf16x8*)(ab + (ss * 32 - 16 * i) * 2);
                acc[i] = __builtin_amdgcn_mfma_f32_16x16x32_bf16(afr, bfr, acc[i], 0, 0, 0); } }
        const int b = tl;
        if (b < NB) {
#pragma unroll
            for (int i = 0; i < TW; ++i) { const int t = tbase + 16 * i + 4 * kg; const int eo = (b * PITCH + t) * 2;
                const unsigned long long uu = *(const LAS unsigned long long*)(lds + (ord == 0 ? OFF_V : OFF_Z) + eo), gg = *(const LAS unsigned long long*)(lds + (ord == 0 ? OFF_X1 : OFF_X2) + eo);
                const float bias = ord == 0 ? bias0 : bias1; float y[4];
#pragma unroll
                for (int r = 0; r < 4; ++r) { const float uv = __uint_as_float((unsigned)((uu >> (16 * r)) & 0xffffull) << 16), gv = __uint_as_float((unsigned)((gg >> (16 * r)) & 0xffffull) << 16);
                    y[r] = gv * (acc[i][r] + uv * bias); }
                if (ord == 0) *(LAS unsigned long long*)(lds + OFF_Z + eo) = (unsigned long long)pk2(y[0], y[1]) | ((unsigned long long)pk2(y[2], y[3]) << 32);
                else { bf16* og = WSP(bf16, WS_XN) + (size_t)(ROW0 + b * L + t) * DH + c;
#pragma unroll
                    for (int r = 0; r < 4; ++r) { og[(size_t)r * DH] = (bf16)f2bf(y[r]); if (MK_PROBE_ST) og[(size_t)r * DH + (size_t)MROWS * DH] = (bf16)f2bf(y[r]); } } }
        }
        __syncthreads();
    }
}

template <int MF> struct EpiT1 {
    static constexpr bool PERM = true, AFTER_DRAIN = false;
    const bf16* G; bf16* T1;
    __device__ __forceinline__ void operator()(const pg8::f32x4 (&acc)[2][2][MF][2], const pg8::Unit& u, int wr, int wc, int fr, int fq) const {
        using pg8::f32x4; using pg8::u32x4;
        const int row0 = u.pm * (64 * MF) + wr * (16 * MF) + fr, col0 = u.pn * 256 + wc * 32 + 8 * fq;
#pragma unroll
        for (int ai = 0; ai < 2; ++ai)
#pragma unroll
            for (int m = 0; m < MF; ++m) { const int row = row0 + ai * (32 * MF) + m * 16;
#pragma unroll
                for (int bj = 0; bj < 2; ++bj) { const int col = col0 + bj * 128; const u32x4 g = *(const u32x4*)(G + (size_t)row * 2048 + col);
                    const f32x4 v0 = acc[ai][bj][m][0], v1 = acc[ai][bj][m][1]; u32x4 w;
                    w.x = pg8::cvt_pk_bf16(v0[0] * __uint_as_float(g.x << 16), v0[1] * __uint_as_float(g.x & 0xffff0000u)); w.y = pg8::cvt_pk_bf16(v0[2] * __uint_as_float(g.y << 16), v0[3] * __uint_as_float(g.y & 0xffff0000u));
                    w.z = pg8::cvt_pk_bf16(v1[0] * __uint_as_float(g.z << 16), v1[1] * __uint_as_float(g.z & 0xffff0000u)); w.w = pg8::cvt_pk_bf16(v1[2] * __uint_as_float(g.w << 16), v1[3] * __uint_as_float(g.w & 0xffff0000u));
                    *(u32x4*)(T1 + (size_t)row * D + col) = w; } }
    }
};
template <int MF> struct EpiMerge {
    static constexpr bool PERM = true, AFTER_DRAIN = false;
    const bf16* G; const bf16* T1; bf16* MG;
    __device__ __forceinline__ void operator()(const pg8::f32x4 (&acc)[2][2][MF][2], const pg8::Unit& u, int wr, int wc, int fr, int fq) const {
        using pg8::f32x4; using pg8::u32x4;
        const int row0 = u.pm * (64 * MF) + wr * (16 * MF) + fr, col0 = u.pn * 256 + wc * 32 + 8 * fq;
#pragma unroll
        for (int ai = 0; ai < 2; ++ai)
#pragma unroll
            for (int m = 0; m < MF; ++m) { const int row = row0 + ai * (32 * MF) + m * 16;
#pragma unroll
                for (int bj = 0; bj < 2; ++bj) { const int col = col0 + bj * 128; const u32x4 g = *(const u32x4*)(G + (size_t)row * 2048 + 1024 + col); const u32x4 t = *(const u32x4*)(T1 + (size_t)row * D + col);
                    const f32x4 v0 = acc[ai][bj][m][0], v1 = acc[ai][bj][m][1]; u32x4 w;
                    w.x = pg8::cvt_pk_bf16(__uint_as_float(t.x << 16) + v0[0] * __uint_as_float(g.x << 16), __uint_as_float(t.x & 0xffff0000u) + v0[1] * __uint_as_float(g.x & 0xffff0000u));
                    w.y = pg8::cvt_pk_bf16(__uint_as_float(t.y << 16) + v0[2] * __uint_as_float(g.y << 16), __uint_as_float(t.y & 0xffff0000u) + v0[3] * __uint_as_float(g.y & 0xffff0000u));
                    w.z = pg8::cvt_pk_bf16(__uint_as_float(t.z << 16) + v1[0] * __uint_as_float(g.z << 16), __uint_as_float(t.z & 0xffff0000u) + v1[1] * __uint_as_float(g.z & 0xffff0000u));
                    w.w = pg8::cvt_pk_bf16(__uint_as_float(t.w << 16) + v1[2] * __uint_as_float(g.w << 16), __uint_as_float(t.w & 0xffff0000u) + v1[3] * __uint_as_float(g.w & 0xffff0000u));
                    *(u32x4*)(MG + (size_t)row * D + col) = w; } }
    }
};
template <int MF> struct EpiRes {
    static constexpr bool PERM = false, AFTER_DRAIN = false;
    const float* xa; const float* xb; const float* modf; int goff; float* out;
    __device__ __forceinline__ void operator()(const pg8::f32x4 (&acc)[2][2][MF][2], const pg8::Unit& u, int wr, int wc, int fr, int fq) const {
        using pg8::f32x4;
        const int row0 = u.pm * (64 * MF) + wr * (16 * MF) + fr, col0 = u.pn * 256 + wc * 32 + 4 * fq;
#pragma unroll
        for (int ai = 0; ai < 2; ++ai)
#pragma unroll
            for (int m = 0; m < MF; ++m) { const int row = row0 + ai * (32 * MF) + m * 16; const float* bp = (row < M_CTX ? xa + (size_t)row * D : xb + (size_t)(row - M_CTX) * D) + col0; float* op = out + (size_t)row * D + col0;
                const float* gp = modf + (size_t)mod_row(row) * 6144 + goff + col0;
#pragma unroll
                for (int bj = 0; bj < 2; ++bj)
#pragma unroll
                    for (int n = 0; n < 2; ++n) { const f32x4 bs = *(const f32x4*)(bp + bj * 128 + n * 16), gv = *(const f32x4*)(gp + bj * 128 + n * 16); *(f32x4*)(op + bj * 128 + n * 16) = bs + gv * acc[ai][bj][m][n]; } }
    }
};
struct EpiUp {
    static constexpr bool PERM = true, AFTER_DRAIN = false;
    bf16* UP;
    __device__ __forceinline__ void operator()(const pg8::f32x4 (&acc)[2][2][4][2], const pg8::Unit& u, int wr, int wc, int fr, int fq) const {
        using pg8::f32x4; using pg8::u32x4;
        const int row0 = u.pm * 256 + wr * 64 + fr, col0 = u.pn * 256 + wc * 32 + 8 * fq;
#pragma unroll
        for (int ai = 0; ai < 2; ++ai)
#pragma unroll
            for (int m = 0; m < 4; ++m) { const int row = row0 + ai * 128 + m * 16;
#pragma unroll
                for (int bj = 0; bj < 2; ++bj) { f32x4 v0 = acc[ai][bj][m][0], v1 = acc[ai][bj][m][1];
#pragma unroll
                    for (int e = 0; e < 4; ++e) { const float a = fmaxf(v0[e], 0.f), b = fmaxf(v1[e], 0.f); v0[e] = a * a; v1[e] = b * b; }
                    u32x4 w; w.x = pg8::cvt_pk_bf16(v0[0], v0[1]); w.y = pg8::cvt_pk_bf16(v0[2], v0[3]); w.z = pg8::cvt_pk_bf16(v1[0], v1[1]); w.w = pg8::cvt_pk_bf16(v1[2], v1[3]);
                    *(u32x4*)(UP + (size_t)row * FF + col0 + bj * 128) = w; } }
    }
};
__device__ __forceinline__ void final_norm_rows(const Frame& F, const Args& A) {
    const int gw = F.vcu * NWAVES + F.wave, NGW = F.G * NWAVES, lane = F.lane;
    f32x4 gv[4];
#pragma unroll
    for (int j = 0; j < 4; ++j) gv[j] = *(const GAS f32x4*)(A.in[30] + 4 * lane + 256 * j);
    for (int row = gw; row < MROWS; row += NGW) { float* xr = F.out + (size_t)row * D; f32x4 v[4]; float s = 0.f;
#pragma unroll
        for (int j = 0; j < 4; ++j) { v[j] = *(const GAS f32x4*)(xr + 4 * lane + 256 * j); s += (v[j].x * v[j].x + v[j].y * v[j].y) + (v[j].z * v[j].z + v[j].w * v[j].w); }
        const float rstd = 1.f / sqrtf(wave_sum(s) * (1.f / D) + EPSN);
#pragma unroll
        for (int j = 0; j < 4; ++j) *(GAS f32x4*)(xr + 4 * lane + 256 * j) = v[j] * rstd * gv[j]; }
}

#ifndef MK_DEBUG
#define MK_DEBUG 0
#endif
#ifndef MK_REP
#define MK_REP 0
#endif
#ifndef MK_REP3
#define MK_REP3 3
#endif
#define REPK(k) for (int rep_ = 0; rep_ <= ((MK_REP >> (k)) & 1); ++rep_)
__global__ void __launch_bounds__(NWAVES * 64, 2) mk_fwd(Args args) {
    extern __shared__ __attribute__((aligned(16))) unsigned char lds[];
    Frame F;
    F.lds = (LAS unsigned char*)lds; F.MISC = (volatile LAS unsigned*)(F.lds + MISC_OFF);
    F.tid = threadIdx.x; F.lane = F.tid & 63; F.wave = __builtin_amdgcn_readfirstlane(F.tid >> 6);
    F.G = gridDim.x; { const int bx = blockIdx.x; F.vcu = (F.G % 8 == 0) ? (bx % 8) * (F.G / 8) + bx / 8 : bx; }
    F.ws = args.ws; F.out = args.out; F.ctl = (gu32*)(args.ws + WS_CTL);
    const Args& A = args;
    for (int u = F.tid; u < (LDS_BYTES - LDSCTL_OFF) / 4; u += NWAVES * 64) ((LAS unsigned*)(F.lds + LDSCTL_OFF))[u] = 0u;
    __syncthreads();
    XcdBarrier bar = xcd_barrier_post((unsigned*)(F.ctl + CW_BAR), F.MISC + 8);
    const int stop = args.stop_after; int n_ts = 1;
    if (MK_DEBUG && blockIdx.x == 0 && threadIdx.x == 0) ((unsigned long long*)(F.ctl + TS_WORDS))[0] = rt();
#define GRID_BAR() do { xcd_barrier(bar); if (MK_DEBUG && blockIdx.x == 0 && threadIdx.x == 0) { ((unsigned long long*)(F.ctl + TS_WORDS))[n_ts] = rt(); } ++n_ts; } while (0)
#define STOP_IF(k) do { if (MK_DEBUG && stop == (k)) return; } while (0)
#define PHASE_BEGIN() do { int t_ = threadIdx.x; asm volatile("" : "+v"(t_)); F.tid = t_; F.lane = t_ & 63; unsigned char* w_ = args.ws; asm volatile("" : "+s"(w_)); F.ws = w_; } while (0)

    REPK(0) { PHASE_BEGIN(); p0_prologue(F, A); }
    GRID_BAR(); STOP_IF(0);
    REPK(1) { PHASE_BEGIN(); modnorm_rows(F, A, 0); }
    GRID_BAR(); STOP_IF(1);
    REPK(2) { PHASE_BEGIN();
        pg8::Gemm g{WSP(const pg8::bf16_t, WS_XN), WSP(const pg8::bf16_t, WS_WIN), MROWS, INC, D}; pg8::StaticOrder S; S.init(MROWS, INC, F.G, (int)blockIdx.x);
        EpiIn E{WSP(bf16, WS_Q), WSP(bf16, WS_K), WSP(bf16, WS_V), WSP(bf16, WS_UT), WSP(bf16, WS_G), F.out + (size_t)MROWS * D, F.out + (size_t)MROWS * D + (size_t)M_CTX * D, WSP(const float, WS_ROPE)};
        pg8::gemm_phase<EpiIn, pg8::StaticOrder, true, true>(F.lds + RING_OFF, g, S, E);
    }
    GRID_BAR(); STOP_IF(2);
    REPK(3) {
        PHASE_BEGIN();
        bf16* Obuf = WSP(bf16, WS_O);
        volatile LAS unsigned* qslot = (volatile LAS unsigned*)(F.lds + LDSCTL_OFF + 64);
        constexpr int NU = 512 + 512 + 256 + 512 + N_TRU;
        for (;;) {
            __syncthreads();
            if (F.tid == 0) *qslot = __hip_atomic_fetch_add((unsigned*)(F.ctl + CW_QUEUE + 64 * rep_), 1u, __ATOMIC_RELAXED, __HIP_MEMORY_SCOPE_AGENT);
            __syncthreads();
            const int id = __builtin_amdgcn_readfirstlane((int)*qslot);
            if (id >= NU) break;
            { int t_ = threadIdx.x; asm volatile("" : "+v"(t_)); F.tid = t_; F.lane = t_ & 63; }
            if (rep_ == 1) { if (id >= 1792) continue; const bool is_attn = id < 512 || (id >= 1024 && id < 1280); if (is_attn ? !(MK_REP3 & 1) : !(MK_REP3 & 2)) continue; }
            if (id < 512) { const int b = id >> 6, head = (id >> 3) & 7, qb = id & 7; attn_unit(F, A, Obuf, M_CTX + b * LLAT + qb * 128, M_CTX + b * LKLAT, LKLAT / 64, head); }
            else if (id < 1024) hyena_unit<LLAT, 8>(F, A, id - 512);
            else if (id < 1280) { const int j = id - 1024, s = j >> 4, head = (j >> 1) & 7, qb = j & 1; attn_unit(F, A, Obuf, s * 256 + qb * 128, s * 256, LCTX / 64, head); }
            else if (id < 1792) hyena_unit<LCTX, 16>(F, A, id - 1280);
            else p3_transpose_unit(F, A, id - 1792);
        }
    }
    GRID_BAR(); STOP_IF(3);
    REPK(4)
    { PHASE_BEGIN();
        pg8::StaticOrder S; S.init(MROWS, D, F.G, (int)blockIdx.x, 192);
        { pg8::Gemm g{WSP(const pg8::bf16_t, WS_O), WSP(const pg8::bf16_t, WS_WA), MROWS, D, D}; EpiT1<3> E{WSP(const bf16, WS_G), WSP(bf16, WS_V)};
          pg8::gemm_phase<EpiT1<3>, pg8::StaticOrder, true, true, 3>(F.lds + RING_OFF, g, S, E); }
        { pg8::Gemm g{WSP(const pg8::bf16_t, WS_XN), WSP(const pg8::bf16_t, WS_WH), MROWS, D, DH}; EpiMerge<3> E{WSP(const bf16, WS_G), WSP(const bf16, WS_V), WSP(bf16, WS_K)};
          pg8::gemm_phase<EpiMerge<3>, pg8::StaticOrder, true, true, 3>(F.lds + RING_OFF, g, S, E); }
    }
    GRID_BAR(); STOP_IF(4);
    REPK(5) { PHASE_BEGIN();
        pg8::Gemm g{WSP(const pg8::bf16_t, WS_K), WSP(const pg8::bf16_t, WS_WO), MROWS, D, D}; pg8::StaticOrder S; S.init(MROWS, D, F.G, (int)blockIdx.x, 192);
        EpiRes<3> E{A.in[0], A.in[1], WSP(const float, WS_MODF), 2048, F.out};
        pg8::gemm_phase<EpiRes<3>, pg8::StaticOrder, true, true, 3>(F.lds + RING_OFF, g, S, E);
    }
    GRID_BAR(); STOP_IF(5);
    REPK(6) { PHASE_BEGIN(); modnorm_rows(F, A, 1); }
    GRID_BAR(); STOP_IF(6);
    REPK(7) { PHASE_BEGIN();
        pg8::Gemm g{WSP(const pg8::bf16_t, WS_XN), WSP(const pg8::bf16_t, WS_WUP), MROWS, FF, D}; pg8::StaticOrder S; S.init(MROWS, FF, F.G, (int)blockIdx.x);
        EpiUp E{WSP(bf16, WS_UP)};
        pg8::gemm_phase<EpiUp, pg8::StaticOrder, true, true>(F.lds + RING_OFF, g, S, E);
    }
    GRID_BAR(); STOP_IF(7);
    { PHASE_BEGIN();
        pg8::Gemm g{WSP(const pg8::bf16_t, WS_UP), WSP(const pg8::bf16_t, WS_WDN), MROWS, D, FF}; pg8::StaticOrder S; S.init(MROWS, D, F.G, (int)blockIdx.x, 192);
        EpiRes<3> E{F.out, F.out + (size_t)M_CTX * D, WSP(const float, WS_MODF), 5120, F.out};
        pg8::gemm_phase<EpiRes<3>, pg8::StaticOrder, true, true, 3>(F.lds + RING_OFF, g, S, E);
    }
    GRID_BAR(); STOP_IF(8);
    PHASE_BEGIN(); final_norm_rows(F, A);
    if (MK_DEBUG && blockIdx.x == 0 && threadIdx.x == 0) { ((unsigned long long*)(F.ctl + TS_WORDS))[n_ts] = rt(); }

}

#if MK_DEBUG

#endif
extern "C" void kernel_launch(void* const* d_in, const int* in_sizes, int n_in, void* d_out, int out_size, void* d_ws, size_t ws_size, hipStream_t stream) {
    static int grid = 0;
    if (grid == 0) {
        if (n_in != 31 || out_size != MROWS * D + 2 * M_CTX * D || ws_size < WS_END) { fprintf(stderr, "kernel_launch: unexpected shapes (n_in %d out %d ws %zu)\n", n_in, out_size, ws_size); grid = -1; return; }
        int dev = 0, cus = 0;
        if (hipGetDevice(&dev) != hipSuccess || hipDeviceGetAttribute(&cus, hipDeviceAttributeMultiprocessorCount, dev) != hipSuccess) { grid = -1; return; }
        if (hipFuncSetAttribute((const void*)mk_fwd, hipFuncAttributeMaxDynamicSharedMemorySize, LDS_BYTES) != hipSuccess) { fprintf(stderr, "kernel_launch: hipFuncSetAttribute failed\n"); grid = -1; return; }
        int per_cu = 0;
        if (hipOccupancyMaxActiveBlocksPerMultiprocessor(&per_cu, (const void*)mk_fwd, NWAVES * 64, LDS_BYTES) != hipSuccess || per_cu < 1) { fprintf(stderr, "kernel_launch: occupancy query says %d\n", per_cu); }
        (void)hipGetLastError();
        grid = cus;
    }
    if (grid < 0) return;
    if (hipMemsetAsync((char*)d_ws + WS_CTL, 0, CTL_ZERO_BYTES, stream) != hipSuccess) return;
    Args a{};
    for (int i = 0; i < 31; ++i) a.in[i] = (const float*)d_in[i];
    a.out = (float*)d_out; a.ws = (unsigned char*)d_ws; a.stop_after = MK_STOP; a.pad = 0;
    hipLaunchKernelGGL(mk_fwd, dim3(grid), dim3(NWAVES * 64), LDS_BYTES, stream, a);
#if MK_DEBUG
    dbg_run(a, stream);
#endif
}
```

```cpp
#include <hip/hip_runtime.h>
#include <cstdio>
#include <cstdint>


#define MK_DEBUG 0
#define MK_STOP -1

namespace pg8 {
#define PG8_LAS __attribute__((address_space(3)))
typedef unsigned short bf16_t;
typedef short bf16x8 __attribute__((ext_vector_type(8)));
typedef float f32x4 __attribute__((ext_vector_type(4)));
typedef unsigned u32x4 __attribute__((ext_vector_type(4)));
constexpr int BM = 256, BK = 64, HALF = 128, HTB = HALF * BK * 2  , STAGE_BYTES = 8 * HTB, NXCD = 8, WGM = 8;

__host__ __device__ __forceinline__ int lds_byte(int r, int c) { const int st = (r >> 4) * 2 + (c >> 5), rr = r & 15, cc = c & 31, ob = rr * 64 + cc * 2; return st * 1024 + (ob ^ (((ob >> 9) & 1) << 5)); }
__host__ __device__ __forceinline__ void stage_rc(int b, int& R, int& C) { const int st = b / 1024, sb = b % 1024, swz = sb ^ (((sb >> 9) & 1) << 5); R = (st >> 1) * 16 + swz / 64; C = (st & 1) * 32 + (swz % 64) / 2; }
__host__ __device__ __forceinline__ int perm32(int rho) { const int n = rho >> 4, i = rho & 15; return 8 * (i >> 2) + 4 * n + (i & 3); }

struct Unit { int pm, pn; };
struct Gemm { const bf16_t* A; const bf16_t* Bt; int M, N, K; };

struct StaticOrder {
    int nM, nN, nwg, G, c;
    __host__ __device__ void init(int M, int N, int G_, int c_, int rows_per_tile = BM) { nM = M / rows_per_tile; nN = N / BM; nwg = nM * nN; G = G_; c = c_; }
    __host__ __device__ bool next(int i, Unit& u) const {
        const long L = (long)i * G + c; if (L >= nwg) return false;
        int wgid = (int)L; { const int q = nwg / NXCD, r = nwg % NXCD, xcd = wgid % NXCD, off = wgid / NXCD; wgid = (xcd < r ? xcd * (q + 1) : r * (q + 1) + (xcd - r) * q) + off; }
        const int nig = WGM * nN, gid = wgid / nig, fm = gid * WGM, gsz = (nM - fm) < WGM ? (nM - fm) : WGM;
        u.pm = fm + ((wgid % nig) % gsz); u.pn = (wgid % nig) / gsz; return true;
    }
    __device__ __forceinline__ void a_ready(const Unit&) const {}
    __device__ __forceinline__ void done(const Unit&) const {}
};

__device__ __forceinline__ unsigned cvt_pk_bf16(float lo, float hi) { unsigned r; asm volatile("v_cvt_pk_bf16_f32 %0, %1, %2" : "=v"(r) : "v"(lo), "v"(hi)); return r; }
typedef float f32x2 __attribute__((ext_vector_type(2)));

template <class Epi, class Sched, bool ALIGN_EPI = false, bool SP2 = false, int MF = 4>
__device__ __forceinline__ void gemm_phase(PG8_LAS unsigned char* lds, const Gemm g, const Sched& S, const Epi& E) {
    int tid_ = threadIdx.x; asm volatile("" : "+v"(tid_));
    const int tid = tid_, wid = __builtin_amdgcn_readfirstlane(tid >> 6), lane = tid & 63, wr = wid >> 2, wc = wid & 3, fr = lane & 15, fq = lane >> 4;
    const int K = g.K, nt = K / BK;
    unsigned voffA[2], voffB[2];
#pragma unroll
    for (int i = 0; i < 2; ++i) { int R, C; stage_rc(tid * 16 + i * 8192, R, C); const int Rb = Epi::PERM ? ((R & ~31) + perm32(R & 31)) : R; const int Ra = (R >= 32 * MF) ? R - 32 * MF : R;
        voffA[i] = (unsigned)(Ra * K + C) * 2u; voffB[i] = (unsigned)(Rb * K + C) * 2u; }
    const size_t kstep = (size_t)(BK * 2);
    const size_t hstepA = (size_t)(32 * MF) * K * 2, hstepB = (size_t)HALF * K * 2;
    const size_t tstepA = 2 * hstepA, tstepB = 2 * hstepB;
    const unsigned ldsw = (unsigned)wid * 1024u;
    const int aoff = lds_byte(wr * 16 * MF + fr, fq * 8), boff = lds_byte(wc * 32 + fr, fq * 8);
#define PG8_SA(b, h) (((b) * 2 + (h)) * HTB)
#define PG8_SB(b, h) ((4 + (b) * 2 + (h)) * HTB)
#define PG8_STAGE(bufoff, gbase, voff) do { _Pragma("unroll") for (int _i = 0; _i < 2; ++_i) \
        __builtin_amdgcn_global_load_lds((const unsigned*)((const char*)(gbase) + (voff)[_i]), (PG8_LAS unsigned*)(lds + (bufoff) + ldsw + _i * 8192), 16, 0, 0); } while (0)
#define PG8_LDA(dst, b, h) do { _Pragma("unroll") for (int m = 0; m < MF; ++m) _Pragma("unroll") for (int k = 0; k < 2; ++k) dst[m][k] = *(const PG8_LAS bf16x8*)(lds + PG8_SA(b, h) + aoff + m * 2048 + k * 1024); } while (0)
#define PG8_LDB(dst, b, h) do { _Pragma("unroll") for (int n = 0; n < 2; ++n) _Pragma("unroll") for (int k = 0; k < 2; ++k) dst[n][k] = *(const PG8_LAS bf16x8*)(lds + PG8_SB(b, h) + boff + n * 2048 + k * 1024); } while (0)
#define PG8_MMA(ai, bj, At, Bt) do { __builtin_amdgcn_s_setprio(1); _Pragma("unroll") for (int m = 0; m < MF; ++m) _Pragma("unroll") for (int n = 0; n < 2; ++n) _Pragma("unroll") for (int k = 0; k < 2; ++k) \
        acc[ai][bj][m][n] = __builtin_amdgcn_mfma_f32_16x16x32_bf16(Bt[n][k], At[m][k], acc[ai][bj][m][n], 0, 0, 0); __builtin_amdgcn_s_setprio(0); } while (0)
#define PG8_WAIT_V(n) asm volatile("s_waitcnt vmcnt(" #n ")" ::: "memory")
#define PG8_WAIT_L(n) asm volatile("s_waitcnt lgkmcnt(" #n ")" ::: "memory")
#define PG8_BAR __builtin_amdgcn_s_barrier()
#define PG8_SCHED __builtin_amdgcn_sched_barrier(0)
    Unit cur, nxt; int ui = 0;
    if (!S.next(0, cur)) return;
    f32x4 acc[2][2][MF][2];
#pragma unroll
    for (int a = 0; a < 2; ++a)
#pragma unroll
        for (int b = 0; b < 2; ++b)
#pragma unroll
            for (int m = 0; m < MF; ++m)
#pragma unroll
                for (int n = 0; n < 2; ++n) acc[a][b][m][n] = (f32x4){0.f, 0.f, 0.f, 0.f};
    bf16x8 At[MF][2], B0[2][2], B1[2][2];
    const char* cA = (const char*)g.A + (size_t)cur.pm * tstepA; const char* cB = (const char*)g.Bt + (size_t)cur.pn * tstepB;
    S.a_ready(cur);
    if constexpr (SP2) {
        PG8_STAGE(PG8_SB(0, 0), cB, voffB); PG8_STAGE(PG8_SB(0, 1), cB + hstepB, voffB); PG8_STAGE(PG8_SA(0, 0), cA, voffA); PG8_STAGE(PG8_SA(0, 1), cA + hstepA, voffA);
        if (wr == 1) PG8_BAR;
        PG8_WAIT_V(2); PG8_BAR;
        PG8_STAGE(PG8_SB(1, 0), cB + kstep, voffB); PG8_STAGE(PG8_SA(1, 0), cA + kstep, voffA); PG8_STAGE(PG8_SB(1, 1), cB + hstepB + kstep, voffB);
        PG8_WAIT_V(6); PG8_BAR;
    } else {
        PG8_STAGE(PG8_SB(0, 0), cB, voffB); PG8_STAGE(PG8_SA(0, 0), cA, voffA); PG8_STAGE(PG8_SB(0, 1), cB + hstepB, voffB); PG8_STAGE(PG8_SA(0, 1), cA + hstepA, voffA);
        if (wr == 1) PG8_BAR;
        PG8_WAIT_V(4); PG8_BAR;
        PG8_STAGE(PG8_SB(1, 0), cB + kstep, voffB); PG8_STAGE(PG8_SA(1, 0), cA + kstep, voffA); PG8_STAGE(PG8_SB(1, 1), cB + hstepB + kstep, voffB);
        PG8_WAIT_V(6); PG8_BAR;
    }
    for (;;) {
        const bool has_next = S.next(ui + 1, nxt);
        const char* nA = has_next ? (const char*)g.A + (size_t)nxt.pm * tstepA : cA; const char* nB = has_next ? (const char*)g.Bt + (size_t)nxt.pn * tstepB : cB;
        for (int t = 0; t < nt; t += 2) {
            const bool last = (t == nt - 2);
            const char* a1 = cA + (size_t)(t + 1) * kstep;
            const char* a2 = last ? nA : cA + (size_t)(t + 2) * kstep; const char* b2 = last ? nB : cB + (size_t)(t + 2) * kstep;
            const char* a3 = a2 + kstep; const char* b3 = b2 + kstep;
            if (last && has_next) S.a_ready(nxt);
            if constexpr (SP2) {
            PG8_LDB(B0, 0, 0); PG8_LDB(B1, 0, 1); PG8_SCHED; PG8_LDA(At, 0, 0); PG8_STAGE(PG8_SA(1, 1), a1 + hstepA, voffA);
            PG8_WAIT_V(8); PG8_WAIT_L(0); PG8_BAR; PG8_MMA(0, 0, At, B0); PG8_MMA(0, 1, At, B1); PG8_BAR; PG8_SCHED;
            PG8_LDA(At, 0, 1); PG8_STAGE(PG8_SB(0, 0), b2, voffB); PG8_STAGE(PG8_SB(0, 1), b2 + hstepB, voffB); PG8_STAGE(PG8_SA(0, 0), a2, voffA);
            PG8_WAIT_V(8); PG8_WAIT_L(0); PG8_BAR; PG8_MMA(1, 0, At, B0); PG8_MMA(1, 1, At, B1); PG8_BAR; PG8_SCHED;
            PG8_LDB(B0, 1, 0); PG8_LDB(B1, 1, 1); PG8_SCHED; PG8_LDA(At, 1, 0); PG8_STAGE(PG8_SA(0, 1), a2 + hstepA, voffA);
            PG8_WAIT_V(8); PG8_WAIT_L(0); PG8_BAR; PG8_MMA(0, 0, At, B0); PG8_MMA(0, 1, At, B1); PG8_BAR; PG8_SCHED;
            PG8_LDA(At, 1, 1); PG8_STAGE(PG8_SB(1, 0), b3, voffB); PG8_STAGE(PG8_SB(1, 1), b3 + hstepB, voffB); PG8_STAGE(PG8_SA(1, 0), a3, voffA);
            PG8_WAIT_V(8); PG8_WAIT_L(0); PG8_BAR; PG8_MMA(1, 0, At, B0); PG8_MMA(1, 1, At, B1); PG8_BAR; PG8_SCHED;
            } else {
            PG8_LDB(B0, 0, 0); PG8_SCHED; PG8_LDA(At, 0, 0); PG8_STAGE(PG8_SA(1, 1), a1 + hstepA, voffA);
            PG8_WAIT_L(8); PG8_BAR; PG8_WAIT_L(0); PG8_MMA(0, 0, At, B0); PG8_BAR; PG8_SCHED;
            PG8_LDB(B1, 0, 1); PG8_STAGE(PG8_SB(0, 0), b2, voffB);
            PG8_BAR; PG8_WAIT_L(0); PG8_MMA(0, 1, At, B1); PG8_BAR;
            PG8_LDA(At, 0, 1); PG8_STAGE(PG8_SA(0, 0), a2, voffA);
            PG8_BAR; PG8_WAIT_L(0); PG8_MMA(1, 0, At, B0); PG8_BAR; PG8_SCHED;
            PG8_STAGE(PG8_SB(0, 1), b2 + hstepB, voffB);
            PG8_WAIT_V(6); PG8_BAR; PG8_MMA(1, 1, At, B1); PG8_BAR;
            PG8_LDB(B0, 1, 0); PG8_SCHED; PG8_LDA(At, 1, 0); PG8_STAGE(PG8_SA(0, 1), a2 + hstepA, voffA);
            PG8_WAIT_L(8); PG8_BAR; PG8_WAIT_L(0); PG8_MMA(0, 0, At, B0); PG8_BAR; PG8_SCHED;
            PG8_LDB(B1, 1, 1); PG8_STAGE(PG8_SB(1, 0), b3, voffB);
            PG8_BAR; PG8_WAIT_L(0); PG8_MMA(0, 1, At, B1); PG8_BAR;
            PG8_LDA(At, 1, 1); PG8_STAGE(PG8_SA(1, 0), a3, voffA);
            PG8_BAR; PG8_WAIT_L(0); PG8_MMA(1, 0, At, B0); PG8_BAR; PG8_SCHED;
            PG8_STAGE(PG8_SB(1, 1), b3 + hstepB, voffB);
            PG8_WAIT_V(6); PG8_BAR; PG8_MMA(1, 1, At, B1); PG8_BAR;
            }
        }
        if constexpr (ALIGN_EPI) { if (wr == 0) PG8_BAR; }
        if constexpr (!Epi::AFTER_DRAIN) { E(acc, cur, wr, wc, fr, fq); S.done(cur); }
        if (!has_next) break;
#pragma unroll
        for (int a = 0; a < 2; ++a)
#pragma unroll
            for (int b = 0; b < 2; ++b)
#pragma unroll
                for (int m = 0; m < MF; ++m)
#pragma unroll
                    for (int n = 0; n < 2; ++n) acc[a][b][m][n] = (f32x4){0.f, 0.f, 0.f, 0.f};
        cur = nxt; cA = nA; cB = nB; ++ui;
        if constexpr (ALIGN_EPI) { if (wr == 1) PG8_BAR; }
    }
    PG8_WAIT_V(0);
    if constexpr (!ALIGN_EPI) { if (wr == 0) PG8_BAR; }
    PG8_BAR;
    if constexpr (Epi::AFTER_DRAIN) { E.fused(acc, cur, wr, wc, fr, fq, lds, wid, lane); S.done(cur); }
#undef PG8_SA
#undef PG8_SB
#undef PG8_STAGE
#undef PG8_LDA
#undef PG8_LDB
#undef PG8_MMA
#undef PG8_WAIT_V
#undef PG8_WAIT_L
#undef PG8_BAR
#undef PG8_SCHED
}
}

constexpr bool PG8_SP2 = true, PG8_ALIGN = true;

#define GAS __attribute__((address_space(1)))
#define LAS __attribute__((address_space(3)))
typedef unsigned short bf16;
typedef unsigned v4u __attribute__((ext_vector_type(4)));
typedef float f32x4 __attribute__((ext_vector_type(4)));
typedef short bf16x8 __attribute__((ext_vector_type(8)));
typedef GAS unsigned gu32;
typedef GAS unsigned long long gu64;
#define RLX_AGENT __ATOMIC_RELAXED, __HIP_MEMORY_SCOPE_AGENT
#define LDS_WAIT() asm volatile("s_waitcnt lgkmcnt(0)" ::: "memory")
#define VM_WAIT() asm volatile("s_waitcnt vmcnt(0)" ::: "memory")
__device__ __forceinline__ unsigned long long rt() { return __builtin_amdgcn_s_memrealtime(); }
__device__ __forceinline__ unsigned f2bf(float f) { unsigned u = __builtin_bit_cast(unsigned, f); return (u + 0x7fffu + ((u >> 16) & 1u)) >> 16; }
__device__ __forceinline__ unsigned pk2(float lo, float hi) { return f2bf(lo) | (f2bf(hi) << 16); }

#define XB_TMO      128
#define XB_XCNT(j)  (256  + 64 * (j))
#define XB_XSUB(j)  (1280 + 64 * (j))
#define XB_XGEN(j)  (2304 + 64 * (j))
#define XB_TOP      3328
#define XB_TOPGEN   3392
#define XCD_BAR_WORDS 3456
#define XB_SPIN_CAP (1u << 18)

__device__ __forceinline__ unsigned xb_ld(unsigned* p)              { return __hip_atomic_load(p, __ATOMIC_RELAXED, __HIP_MEMORY_SCOPE_AGENT); }
__device__ __forceinline__ unsigned xb_add(unsigned* p, unsigned v) { return __hip_atomic_fetch_add(p, v, __ATOMIC_RELAXED, __HIP_MEMORY_SCOPE_AGENT); }
__device__ __forceinline__ unsigned xb_xcc_id() { return (unsigned)__builtin_amdgcn_s_getreg((3 << 11) | 20) & 0xFu; }
#define XB_SPIN(cond, bar) do { unsigned _sp = 0; while (cond) { __builtin_amdgcn_s_sleep(1); \
    if ((++_sp & 255u) == 0u) { if (xb_ld(&(bar)[XB_TMO])) break; if (_sp > XB_SPIN_CAP) { atomicAdd(&(bar)[XB_TMO], 1u); break; } } } } while (0)

struct XcdBarrier {
    unsigned* bar; unsigned x;
    volatile LAS unsigned* st;
};

__device__ __forceinline__ XcdBarrier xcd_barrier_post(unsigned* bar, volatile LAS unsigned* st) {
    XcdBarrier b; b.bar = bar; b.x = xb_xcc_id(); b.st = st;
    if (threadIdx.x == 0) (void)xb_add(&bar[XB_XCNT(b.x)], 1u);
    return b;
}
__device__ __forceinline__ void xcd_barrier_complete(unsigned* bar, unsigned x, unsigned& nloc, unsigned& nx) {
    const unsigned G = gridDim.x * gridDim.y * gridDim.z;
    unsigned sum, cnt, mine, sp = 0u;
    for (;;) {
        sum = 0u; cnt = 0u; mine = 0u;
#pragma unroll
        for (unsigned j = 0; j < 16; ++j) { const unsigned c = xb_ld(&bar[XB_XCNT(j)]); sum += c; cnt += (c > 0u) ? 1u : 0u; mine = (j == x) ? c : mine; }
        if (sum == G) break;
        __builtin_amdgcn_s_sleep(1);
        if ((++sp & 255u) == 0u) { if (xb_ld(&bar[XB_TMO])) break; if (sp > XB_SPIN_CAP) { atomicAdd(&bar[XB_TMO], 1u); break; } }
    }
    nloc = mine > 0u ? mine : 1u; nx = cnt > 0u ? cnt : 1u;
}

__device__ __forceinline__ void xcd_barrier(const XcdBarrier& b) {
    asm volatile("s_waitcnt vmcnt(0)" ::: "memory");
    __syncthreads();
    if (threadIdx.x == 0) {
        unsigned* bar = b.bar;
        __builtin_amdgcn_s_waitcnt(0);
        unsigned nloc = b.st[0], nx = b.st[1];
        if (nloc == 0u) { xcd_barrier_complete(bar, b.x, nloc, nx); b.st[0] = nloc; b.st[1] = nx; }
        const unsigned old = xb_add(&bar[XB_XSUB(b.x)], 1u);
        const unsigned gen = old / nloc;
        if (old + 1u == (gen + 1u) * nloc) {
            __builtin_amdgcn_fence(__ATOMIC_RELEASE, "agent");
            asm volatile("s_waitcnt vmcnt(0)" ::: "memory");
            const unsigned og = xb_add(&bar[XB_TOP], 1u);
            const unsigned tg = og / nx;
            if (og + 1u == (tg + 1u) * nx) xb_add(&bar[XB_TOPGEN], 1u);
            else XB_SPIN(xb_ld(&bar[XB_TOPGEN]) == tg, bar);
            __builtin_amdgcn_fence(__ATOMIC_ACQUIRE, "agent");
            xb_add(&bar[XB_XGEN(b.x)], 1u);
            asm volatile("s_waitcnt vmcnt(0)" ::: "memory");
        } else {
            XB_SPIN(xb_ld(&bar[XB_XGEN(b.x)]) == gen, bar);
            __builtin_amdgcn_fence(__ATOMIC_ACQUIRE, "agent");
            asm volatile("s_waitcnt vmcnt(0)" ::: "memory");
        }
    }
    __syncthreads();
}

__device__ __forceinline__ float wave_sum(float v) {
#pragma unroll
    for (int o = 1; o < 64; o <<= 1) v += __shfl_xor(v, o);
    return v;
}
__device__ __forceinline__ void p0_transpose_item(const float* W, int K, int N, bf16* WT, int row_off, LAS float* scr, int item, int lane) {
    const int nblk = N / 32, kb = item / nblk, nb = item % nblk, k0 = 64 * kb, n0 = 32 * nb;
    float tv[32];
#pragma unroll
    for (int i = 0; i < 32; ++i) tv[i] = W[(size_t)(k0 + 2 * i + (lane >> 5)) * N + n0 + (lane & 31)];
#pragma unroll
    for (int i = 0; i < 32; ++i) scr[(2 * i + (lane >> 5)) * 33 + (lane & 31)] = tv[i];
    LDS_WAIT(); asm volatile("" ::: "memory");
    const int c = lane & 7;
#pragma unroll
    for (int j = 0; j < 4; ++j) { const int n = (lane >> 3) + 8 * j; const LAS float* s = scr + (8 * c) * 33 + n;
        v4u o; o.x = pk2(s[0 * 33], s[1 * 33]); o.y = pk2(s[2 * 33], s[3 * 33]); o.z = pk2(s[4 * 33], s[5 * 33]); o.w = pk2(s[6 * 33], s[7 * 33]);
        *(GAS v4u*)(WT + (size_t)(row_off + n0 + n) * K + k0 + 8 * c) = o; }
    LDS_WAIT(); asm volatile("" ::: "memory");
}

#ifndef MK_PROBE_ST
#define MK_PROBE_ST 0
#endif
#ifndef MK_REP0
#define MK_REP0 0
#endif
constexpr int NWAVES = 8;
constexpr int D = 1024, M_CTX = 4096, M_LAT = 8192, MROWS = 12288, INC = 6656, FF = 4096, DH = 512, HYC = 1536;
constexpr int LCTX = 256, LLAT = 1024, PAST = 256, LKLAT = 1280, KROWS = M_CTX + 8 * LKLAT;
constexpr float EPSN = 1e-6f, LAM_INIT = 0.2f;
constexpr float QSCALE = 0.125f * 1.4426950408889634f;
constexpr size_t MiB = 1u << 20;
constexpr size_t WS_CTL = 0, CTL_ZERO_BYTES = 1 * MiB;
constexpr size_t WS_WIN = 1 * MiB, WS_WA = 14 * MiB, WS_WH = 16 * MiB, WS_WO = 17 * MiB, WS_WUP = 19 * MiB, WS_WDN = 27 * MiB;
constexpr size_t WS_MODP = 232 * MiB;
constexpr size_t WS_MODF = 37 * MiB;
constexpr size_t WS_ROPE = 38 * MiB;
constexpr size_t WS_H2 = 38 * MiB + 65536;
constexpr size_t WS_FILT = 39 * MiB;
constexpr size_t WS_XN = 44 * MiB;
constexpr size_t WS_Q = 68 * MiB;
constexpr size_t WS_K = 92 * MiB;
constexpr size_t WS_V = 120 * MiB;
constexpr size_t WS_UT = 148 * MiB;
constexpr size_t WS_G = 184 * MiB;
constexpr size_t WS_UP = 68 * MiB;
constexpr size_t WS_O = 232 * MiB;
constexpr size_t WS_END = 256 * MiB;
constexpr int CW_TMO = 0, CW_CODE = 1, CW_QUEUE = 64, CW_BAR = 4096;
constexpr int DBG_WORDS = 8192, TS_WORDS = 12288;
constexpr int RING_OFF = 0, RING_BYTES = 131072, LDSCTL_OFF = RING_BYTES, MISC_OFF = LDSCTL_OFF + 320, LDS_BYTES = 147456;

struct Args { const float* in[31]; float* out; unsigned char* ws; int stop_after; int pad; };
struct Frame {
    LAS unsigned char* lds; volatile LAS unsigned* MISC; gu32* ctl;
    int tid, lane, wave, vcu, G;
    float* out; unsigned char* ws;
};
#define WSP(T, off) ((T*)(F.ws + (off)))
__device__ __forceinline__ float bf2f(bf16 h) { return __uint_as_float((unsigned)h << 16); }
__device__ __forceinline__ const float* xrow_ptr(const Frame& F, const Args& A, int row) { return row < M_CTX ? A.in[0] + (size_t)row * D : A.in[1] + (size_t)(row - M_CTX) * D; }
__device__ __forceinline__ int mod_row(int row) { return row < M_CTX ? 0 : 1 + ((row - M_CTX) >> 10); }

__device__ __forceinline__ void p0_mod_item(const Frame& F, const Args& A, LAS float* scr, int item) {
    const int cb = item >> 3, kc = item & 7, lane = F.lane, col = cb * 64 + lane, k0 = kc * 128;
    float sv0[9], sv1[9];
#pragma unroll
    for (int r = 0; r < 9; ++r) { const float* cv = (r == 0) ? A.in[5] : A.in[4] + (r - 1) * D; const float x0 = cv[k0 + lane], x1 = cv[k0 + 64 + lane];
        sv0[r] = x0 / (1.f + expf(-x0)); sv1[r] = x1 / (1.f + expf(-x1)); }
    float acc[9];
#pragma unroll
    for (int r = 0; r < 9; ++r) acc[r] = 0.f;
    const float* wp = A.in[6] + (size_t)k0 * 6144 + col;
#pragma unroll 1
    for (int kb = 0; kb < 4; ++kb, wp += 32 * 6144) { float w[32];
#pragma unroll
        for (int k = 0; k < 32; ++k) w[k] = wp[(size_t)k * 6144];
        float svr[9];
#pragma unroll
        for (int r = 0; r < 9; ++r) svr[r] = kb < 2 ? sv0[r] : sv1[r];
        const int lb = (kb & 1) * 32;
#pragma unroll
        for (int k = 0; k < 32; ++k)
#pragma unroll
            for (int r = 0; r < 9; ++r) acc[r] += __int_as_float(__builtin_amdgcn_readlane(__float_as_int(svr[r]), lb + k)) * w[k]; }
    float* mp = WSP(float, WS_MODP) + (size_t)kc * 9 * 6144 + col;
#pragma unroll
    for (int r = 0; r < 9; ++r) mp[r * 6144] = acc[r];
    (void)scr;
}
__device__ __forceinline__ void p0_cache_item(const Frame& F, const Args& A, int r) {
    const int b = r >> 8, j = r & 255; const size_t drow = (size_t)(M_CTX + b * LKLAT + j) * D;
    const GAS f32x4* sk = (const GAS f32x4*)(A.in[2] + (size_t)r * D) + F.lane; const GAS f32x4* sv = (const GAS f32x4*)(A.in[3] + (size_t)r * D) + F.lane;
    GAS unsigned long long* dk = (GAS unsigned long long*)(WSP(bf16, WS_K) + drow) + F.lane; GAS unsigned long long* dv = (GAS unsigned long long*)(WSP(bf16, WS_V) + drow) + F.lane;
#pragma unroll
    for (int q = 0; q < 4; ++q) { const f32x4 a = sk[64 * q], c = sv[64 * q];
        dk[64 * q] = (unsigned long long)pk2(a.x, a.y) | ((unsigned long long)pk2(a.z, a.w) << 32);
        dv[64 * q] = (unsigned long long)pk2(c.x, c.y) | ((unsigned long long)pk2(c.z, c.w) << 32); }
}
__device__ __forceinline__ void p0_rope_item(const Frame& F, const Args& A) {
    float* tb = WSP(float, WS_ROPE);
    for (int e = F.lane; e < 1024; e += 64) { const int pos = e >> 4, i = e & 15; const float inv = powf(10000.0f, -(float)i / 16.0f); const float ang = (float)pos * inv;
        tb[2 * e] = cosf(ang); tb[2 * e + 1] = sinf(ang); }
}
__device__ __forceinline__ void p0_filter_item(const Frame& F, const Args& A, LAS float* scr, const LAS float* wsh, int item) {
    const int lane = F.lane; const bool big = item >= 256; const int L = big ? 1024 : 256, t = big ? item - 256 : item; const float tt = (float)t / (float)(L - 1);
    const LAS float* w1s = wsh + lane; const LAS float* w2s = wsh + 33 * 64 + lane;
    if (lane < 33) { float e;
        if (lane == 0) e = tt;
        else { const int bnd = (lane - 1) & 15; const float f = 1e-4f + (float)bnd * ((15.0f - 1e-4f) / 15.0f); const float wpos = 2.0f * 3.14159265358979323846f * (float)t / (float)L; const float a = f * wpos;
            e = (lane <= 16) ? cosf(a) : -sinf(a); }
        scr[lane] = e; }
    LDS_WAIT(); asm volatile("" ::: "memory");
    const float fr = A.in[23][lane];
    float acc = A.in[19][lane];
#pragma unroll
    for (int i = 0; i < 33; ++i) acc += scr[i] * w1s[i * 64];
    scr[64 + lane] = sinf(fr * acc);
    LDS_WAIT(); asm volatile("" ::: "memory");
    float acc2 = A.in[21][lane];
#pragma unroll
    for (int i = 0; i < 64; ++i) acc2 += scr[64 + i] * w2s[i * 64];
    WSP(float, WS_H2)[(size_t)lane * 1280 + item] = sinf(fr * acc2);
    LDS_WAIT(); asm volatile("" ::: "memory");
}
typedef float f32x16t __attribute__((ext_vector_type(16)));
__device__ __forceinline__ void p1_taps_item(const Frame& F, const Args& A, int item) {
    const int lane = F.lane, r32 = lane & 31, hi = lane >> 5, cp = item & 31, pb = item >> 5; const bool big = pb >= 8; const int L = big ? 1024 : 256;
    const int t = (big ? pb - 8 : pb) * 32 + r32, pos = (big ? 256 : 0) + t, col0 = cp * 32;
    const float* wp = A.in[22] + (size_t)hi * 2048 + col0 + r32; const float* hp = WSP(const float, WS_H2) + (size_t)hi * 1280 + pos;
    f32x16t cf = f32x16t{}, cb = f32x16t{};
#pragma unroll 4
    for (int st = 0; st < 32; ++st) { const float wf = wp[(size_t)st * 4096], wb = wp[(size_t)st * 4096 + 1024], h = hp[(size_t)st * 2560];
        cf = __builtin_amdgcn_mfma_f32_32x32x2f32(wf, h, cf, 0, 0, 0); cb = __builtin_amdgcn_mfma_f32_32x32x2f32(wb, h, cb, 0, 0, 0); }
    bf16* R = WSP(bf16, WS_FILT) + (big ? (size_t)(1 * MiB / 2) : 0);
    const float d0 = logf(1e-2f) / 0.3f, d1 = logf(1e-2f) / 1.5f; const float tt = (float)t / (float)(L - 1);
#pragma unroll
    for (int r = 0; r < 16; ++r) { const int col = col0 + (r & 3) + 8 * (r >> 2) + 4 * hi, ch = col & 511, ord = col >> 9; const float dec = expf(-tt * fabsf(d0 + (d1 - d0) * (float)ch / 511.0f));
        bf16* Rc = R + ((size_t)ord * 512 + ch) * (2 * L);
        if (t == 0) { Rc[L] = (bf16)f2bf((cf[r] + cb[r]) * dec); Rc[0] = 0; } else { Rc[L - t] = (bf16)f2bf(cf[r] * dec); Rc[L + t] = (bf16)f2bf(cb[r] * dec); } }
}
__device__ __forceinline__ void p0_prologue(const Frame& F, const Args& A) {
    LAS float* scr = (LAS float*)(F.lds + RING_OFF + F.wave * 9216);
    LAS float* wsh = (LAS float*)(F.lds + RING_OFF + 8 * 9216);
    for (int i = F.tid; i < 33 * 64 + 64 * 64; i += NWAVES * 64) wsh[i] = i < 33 * 64 ? A.in[18][i] : A.in[20][i - 33 * 64];
    __syncthreads();
    const int gw = F.vcu * NWAVES + F.wave, NGW = F.G * NWAVES;
    constexpr int I_IN = (D / 64) * (INC / 32), I_A = (D / 64) * (D / 32), I_H = (DH / 64) * (D / 32);
    constexpr int N_MOD = 768, N_CACHE = 2048, N_FILT = 1280;
    if (NGW == 2048) { if (gw < N_FILT) { for (int q_ = 0; q_ <= (MK_REP0 & 1); ++q_) p0_filter_item(F, A, scr, wsh, gw); } else { for (int q_ = 0; q_ <= ((MK_REP0 >> 1) & 1); ++q_) p0_mod_item(F, A, scr, gw - N_FILT); } }
    else { for (int it = gw; it < N_FILT; it += NGW) p0_filter_item(F, A, scr, wsh, it); for (int it = gw; it < N_MOD; it += NGW) p0_mod_item(F, A, scr, it); }
    if (gw == NGW - 1) p0_rope_item(F, A);
    for (int q_ = 0; q_ <= ((MK_REP0 >> 2) & 1); ++q_) for (int it = gw; it < N_CACHE; it += NGW) p0_cache_item(F, A, it);
    for (int q_ = 0; q_ <= ((MK_REP0 >> 3) & 1); ++q_) for (int it = gw; it < I_IN + I_A + I_H; it += NGW) {
        int r = it;
        if (r < I_IN) { p0_transpose_item(A.in[10], D, INC, WSP(bf16, WS_WIN), 0, scr, r, F.lane); continue; } r -= I_IN;
        if (r < I_A) { p0_transpose_item(A.in[25], D, D, WSP(bf16, WS_WA), 0, scr, r, F.lane); continue; } r -= I_A;
        p0_transpose_item(A.in[26], DH, D, WSP(bf16, WS_WH), 0, scr, r, F.lane);
    }
}
constexpr int N_TRU = 72;
__device__ __forceinline__ void p3_transpose_unit(const Frame& F, const Args& A, int u) {
    constexpr int I_O = (D / 64) * (D / 32), I_UP = (D / 64) * (FF / 32);
    LAS float* scr = (LAS float*)(F.lds + RING_OFF + F.wave * 9216);
#pragma unroll 1
    for (int j = 0; j < 8; ++j) { int r = u * 64 + F.wave * 8 + j;
        if (r < I_O) { p0_transpose_item(A.in[27], D, D, WSP(bf16, WS_WO), 0, scr, r, F.lane); continue; } r -= I_O;
        if (r < I_UP) { p0_transpose_item(A.in[28], D, FF, WSP(bf16, WS_WUP), 0, scr, r, F.lane); continue; } r -= I_UP;
        p0_transpose_item(A.in[29], FF, D, WSP(bf16, WS_WDN), 0, scr, r, F.lane); }
}
__device__ __forceinline__ void modnorm_rows(const Frame& F, const Args& A, int which) {
    const int gw = F.vcu * NWAVES + F.wave, NGW = F.G * NWAVES, lane = F.lane;
    const float* gvec = which ? A.in[9] : A.in[8]; const int shoff = which ? 3072 : 0, scoff = which ? 4096 : 1024;
    if (which == 0) { for (int it = gw; it < 1280; it += NGW) p1_taps_item(F, A, it); }
    for (int ch = gw; ch < MROWS / 6; ch += NGW) {
        int cur = -1; f32x4 av[4], sv[4];
        for (int rr = 0; rr < 6; ++rr) { const int row = ch * 6 + rr; const int mr = mod_row(row);
            if (mr != cur) { cur = mr;
#pragma unroll
                for (int j = 0; j < 4; ++j) { const int c = 4 * lane + 256 * j; f32x4 sh, sc;
                    if (which == 0) { sh = *(const GAS f32x4*)(A.in[7] + c); sc = *(const GAS f32x4*)(A.in[7] + 1024 + c);
                        for (int kc = 0; kc < 8; ++kc) { const float* mp = WSP(float, WS_MODP) + ((size_t)kc * 9 + mr) * 6144; sh += *(const GAS f32x4*)(mp + c); sc += *(const GAS f32x4*)(mp + 1024 + c); } }
                    else { const float* mf = WSP(float, WS_MODF) + (size_t)mr * 6144; sh = *(const GAS f32x4*)(mf + shoff + c); sc = *(const GAS f32x4*)(mf + scoff + c); }
                    const f32x4 g = *(const GAS f32x4*)(gvec + c); av[j] = g * (sc + 1.0f); sv[j] = sh; } }
            const float* xr = which ? F.out + (size_t)row * D : xrow_ptr(F, A, row);
            f32x4 v[4]; float s = 0.f;
#pragma unroll
            for (int j = 0; j < 4; ++j) { v[j] = *(const GAS f32x4*)(xr + 4 * lane + 256 * j); s += (v[j].x * v[j].x + v[j].y * v[j].y) + (v[j].z * v[j].z + v[j].w * v[j].w); }
            const float rstd = 1.f / sqrtf(wave_sum(s) * (1.f / D) + EPSN);
            GAS unsigned long long* o8 = (GAS unsigned long long*)(WSP(bf16, WS_XN) + (size_t)row * D) + lane;
#pragma unroll
            for (int j = 0; j < 4; ++j) { const f32x4 y = v[j] * rstd * av[j] + sv[j]; o8[64 * j] = (unsigned long long)pk2(y.x, y.y) | ((unsigned long long)pk2(y.z, y.w) << 32); } }
    }
    if (which == 0) {
        for (int it = gw; it < 9 * 6144 / 64; it += NGW) { const int idx = it * 64 + lane, r = idx / 6144, col = idx % 6144; float a = A.in[7][col];
            for (int kc = 0; kc < 8; ++kc) a += WSP(float, WS_MODP)[((size_t)kc * 9 + r) * 6144 + col];
            WSP(float, WS_MODF)[idx] = a; } }
}
struct EpiIn {
    static constexpr bool PERM = true, AFTER_DRAIN = false;
    bf16 *Q, *Kb, *Vb, *UT, *G; float *nk, *nv; const float* rope;
    __device__ __forceinline__ void operator()(const pg8::f32x4 (&acc)[2][2][4][2], const pg8::Unit& u, int wr, int wc, int fr, int fq) const {
        using pg8::f32x4; using pg8::u32x4;
        const int pn = u.pn, pm = u.pm; const bool lat = pm >= 16;
        const int rowt = pm * 256 + wr * 64 + fr;
        if (pn < 12) {
            const int typ = pn >> 2, cb = (pn & 3) * 256 + wc * 32 + 8 * fq;
            const int lb = (pm - 16) >> 2, t0 = ((pm - 16) & 3) * 256 + wr * 64 + fr;
#pragma unroll
            for (int ai = 0; ai < 2; ++ai)
#pragma unroll
                for (int m = 0; m < 4; ++m) {
                    const int row = rowt + ai * 128 + m * 16, t = t0 + ai * 128 + m * 16;
#pragma unroll
                    for (int bj = 0; bj < 2; ++bj) {
                        f32x4 v0 = acc[ai][bj][m][0], v1 = acc[ai][bj][m][1];
                        if (lat && typ < 2) {
                            const int pos = (wc & 1) ? (t & 63) : (t >> 6);
                            const float* tb = rope + (size_t)pos * 32 + (8 * (fq & 1)) * 2;
                            const f32x4 c0 = *(const f32x4*)(tb), c1 = *(const f32x4*)(tb + 4), c2 = *(const f32x4*)(tb + 8), c3 = *(const f32x4*)(tb + 12);
                            f32x4 p0, p1;
                            p0.x = __shfl_xor(v0.x, 32); p0.y = __shfl_xor(v0.y, 32); p0.z = __shfl_xor(v0.z, 32); p0.w = __shfl_xor(v0.w, 32);
                            p1.x = __shfl_xor(v1.x, 32); p1.y = __shfl_xor(v1.y, 32); p1.z = __shfl_xor(v1.z, 32); p1.w = __shfl_xor(v1.w, 32);
                            const float sg = (fq < 2) ? -1.f : 1.f;
                            v0.x = v0.x * c0.x + sg * p0.x * c0.y; v0.y = v0.y * c0.z + sg * p0.y * c0.w; v0.z = v0.z * c1.x + sg * p0.z * c1.y; v0.w = v0.w * c1.z + sg * p0.w * c1.w;
                            v1.x = v1.x * c2.x + sg * p1.x * c2.y; v1.y = v1.y * c2.z + sg * p1.y * c2.w; v1.z = v1.z * c3.x + sg * p1.z * c3.y; v1.w = v1.w * c3.z + sg * p1.w * c3.w;
                        }
                        const int col = cb + bj * 128;
                        if (!lat && typ > 0) { float* op = (typ == 1 ? nk : nv) + (size_t)row * D + col; *(f32x4*)op = v0; *(f32x4*)(op + 4) = v1; }
                        if (typ == 0) { v0 = v0 * QSCALE; v1 = v1 * QSCALE; }
                        u32x4 w; w.x = pg8::cvt_pk_bf16(v0[0], v0[1]); w.y = pg8::cvt_pk_bf16(v0[2], v0[3]); w.z = pg8::cvt_pk_bf16(v1[0], v1[1]); w.w = pg8::cvt_pk_bf16(v1[2], v1[3]);
                        bf16* dst;
                        if (typ == 0) dst = Q + (size_t)row * D + col;
                        else { const size_t kr = lat ? (size_t)(M_CTX + lb * LKLAT + PAST + t) : (size_t)row; dst = (typ == 1 ? Kb : Vb) + kr * D + col; }
                        *(u32x4*)dst = w;
                    }
                }
        } else if (pn < 18) {
            const int cb = (pn - 12) * 256 + wc * 32 + 8 * fq;
#pragma unroll
            for (int ai = 0; ai < 2; ++ai)
#pragma unroll
                for (int m = 0; m < 4; ++m) { const int row = rowt + ai * 128 + m * 16;
#pragma unroll
                    for (int bj = 0; bj < 2; ++bj)
#pragma unroll
                        for (int n = 0; n < 2; ++n)
#pragma unroll
                            for (int e = 0; e < 4; ++e) UT[(size_t)(cb + bj * 128 + 4 * n + e) * MROWS + row] = (bf16)f2bf(acc[ai][bj][m][n][e]); }
        } else {
            const int cb = (pn - 18) * 256 + wc * 32 + 8 * fq;
#pragma unroll
            for (int ai = 0; ai < 2; ++ai)
#pragma unroll
                for (int m = 0; m < 4; ++m) { const int row = rowt + ai * 128 + m * 16;
#pragma unroll
                    for (int bj = 0; bj < 2; ++bj) { f32x4 v0 = acc[ai][bj][m][0], v1 = acc[ai][bj][m][1];
#pragma unroll
                        for (int e = 0; e < 4; ++e) { v0[e] = 1.f / (1.f + __expf(-v0[e])); v1[e] = 1.f / (1.f + __expf(-v1[e])); }
                        u32x4 w; w.x = pg8::cvt_pk_bf16(v0[0], v0[1]); w.y = pg8::cvt_pk_bf16(v0[2], v0[3]); w.z = pg8::cvt_pk_bf16(v1[0], v1[1]); w.w = pg8::cvt_pk_bf16(v1[2], v1[3]);
                        *(u32x4*)(G + (size_t)row * 2048 + cb + bj * 128) = w; } }
        }
    }
};

typedef float f32x16 __attribute__((ext_vector_type(16)));
typedef short s16x4 __attribute__((ext_vector_type(4)));
constexpr int AT_KV = 32768;
static_assert(4 * AT_KV <= RING_BYTES, "attention LDS");
__device__ __forceinline__ unsigned off_b(unsigned row, unsigned ch) { return 256u * row + 16u * (ch ^ (((row & 3u) << 2) | ((row >> 2) & 3u))); }
__device__ __forceinline__ s16x4 tr16(LAS unsigned char* p) { return __builtin_bit_cast(s16x4, __builtin_amdgcn_ds_read_tr16_b64_v4i16((LAS s16x4*)p)); }
__device__ __forceinline__ unsigned pkbf(float lo, float hi) { return pg8::cvt_pk_bf16(lo, hi); }
__device__ __forceinline__ float xh_max(float v) { auto rr = __builtin_amdgcn_permlane32_swap(__float_as_uint(v), __float_as_uint(v), false, false); return fmaxf(__uint_as_float(rr[0]), __uint_as_float(rr[1])); }
__device__ __forceinline__ float xh_sum(float v) { auto rr = __builtin_amdgcn_permlane32_swap(__float_as_uint(v), __float_as_uint(v), false, false); return __uint_as_float(rr[0]) + __uint_as_float(rr[1]); }
__device__ __forceinline__ void attn_unit(const Frame& F, const Args& A, bf16* Obuf, int qrow0, int krow0, int nt, int head) {
    int tid = F.tid; asm volatile("" : "+v"(tid));
    const int lane = tid & 63, wave = __builtin_amdgcn_readfirstlane(tid >> 6), r32 = lane & 31, hi = lane >> 5, mp = wave >> 2, qb = wave & 3;
    bf16x8 qf[4];
    { const bf16* qg = WSP(const bf16, WS_Q) + (size_t)(qrow0 + qb * 32 + r32) * D + head * 128 + mp * 64 + 8 * hi;
#pragma unroll
      for (int ds = 0; ds < 4; ++ds) qf[ds] = *(const GAS bf16x8*)(qg + 16 * ds); }
    const bf16* kg = WSP(const bf16, WS_K) + (size_t)krow0 * D + head * 128; const bf16* vg = WSP(const bf16, WS_V) + (size_t)krow0 * D + head * 128;
    const int srow = wave * 8 + (lane >> 4); const unsigned sc0 = (unsigned)(lane & 15) ^ ((((unsigned)srow & 3u) << 2) | (((unsigned)srow >> 2) & 3u)), sc1 = (unsigned)(lane & 15) ^ ((((unsigned)(srow + 4) & 3u) << 2) | (((unsigned)(srow + 4) >> 2) & 3u));
    const bf16* ks0 = kg + (size_t)srow * D + sc0 * 8; const bf16* ks1 = kg + (size_t)(srow + 4) * D + sc1 * 8;
    const bf16* vs0 = vg + (size_t)srow * D + sc0 * 8; const bf16* vs1 = vg + (size_t)(srow + 4) * D + sc1 * 8;
    LAS unsigned char* dbase = F.lds + wave * 2048;
#define AT_STAGE(tt, bufsel) do { const size_t o_ = (size_t)(tt) * 64 * D; LAS unsigned char* d_ = dbase + (bufsel) * AT_KV; \
        __builtin_amdgcn_global_load_lds((const unsigned*)(ks0 + o_), (LAS unsigned*)(d_), 16, 0, 0); __builtin_amdgcn_global_load_lds((const unsigned*)(ks1 + o_), (LAS unsigned*)(d_ + 1024), 16, 0, 0); \
        __builtin_amdgcn_global_load_lds((const unsigned*)(vs0 + o_), (LAS unsigned*)(d_ + 16384), 16, 0, 0); __builtin_amdgcn_global_load_lds((const unsigned*)(vs1 + o_), (LAS unsigned*)(d_ + 16384 + 1024), 16, 0, 0); } while (0)
    const int blk = (lane >> 4) & 1, q4 = (lane & 15) >> 2, p4 = lane & 3;
    unsigned ka[4], va[2][4];
    { const unsigned fr = (((unsigned)r32 & 3u) << 2) | (((unsigned)r32 >> 2) & 3u), g = (unsigned)(8 * mp + hi) ^ fr, c2 = (unsigned)(2 * blk + (p4 >> 1));
      const unsigned vb0 = 256u * (unsigned)(4 * hi + q4) + 16u * (c2 ^ (unsigned)hi) + 8u * (unsigned)(p4 & 1), vb1 = 256u * (unsigned)(4 * hi + q4 + 8) + 16u * (c2 ^ (unsigned)(hi + 2)) + 8u * (unsigned)(p4 & 1);
#pragma unroll
      for (int i = 0; i < 4; ++i) { ka[i] = 256u * (unsigned)r32 + 16u * (g ^ (unsigned)(2 * i)); va[0][i] = 16384u + vb0 + 64u * ((unsigned)i ^ (unsigned)q4); va[1][i] = 16384u + vb1 + 64u * ((unsigned)i ^ (unsigned)q4); } }
    AT_STAGE(0, 0); if (nt > 1) AT_STAGE(1, 1); if (nt > 2) AT_STAGE(2, 2);
    if (nt > 2) asm volatile("s_waitcnt vmcnt(4)\n\ts_barrier" ::: "memory"); else asm volatile("s_waitcnt vmcnt(0)\n\ts_barrier" ::: "memory");
    f32x16 O[4];
#pragma unroll
    for (int e = 0; e < 4; ++e) O[e] = f32x16{};
    float mrun = -1e30f, lrun = 0.f;
    f32x16 S0 = f32x16{}, S1 = f32x16{};
#pragma unroll
    for (int ds = 0; ds < 4; ++ds) { const bf16x8 k0 = *(const LAS bf16x8*)(F.lds + ka[ds]); const bf16x8 k1 = *(const LAS bf16x8*)(F.lds + ka[ds] + 8192);
        S0 = __builtin_amdgcn_mfma_f32_32x32x16_bf16(k0, qf[ds], S0, 0, 0, 0); S1 = __builtin_amdgcn_mfma_f32_32x32x16_bf16(k1, qf[ds], S1, 0, 0, 0); }
    for (int t = 0; t < nt; ++t) {
        LAS unsigned char* lk = F.lds + (t & 3) * AT_KV; LAS unsigned char* ln = F.lds + ((t + 1) & 3) * AT_KV;
        if (t + 3 < nt) AT_STAGE(t + 3, (t + 3) & 3);
        f32x16 N0 = f32x16{}, N1 = f32x16{};
        if (t + 1 < nt) {
#pragma unroll
            for (int ds = 0; ds < 4; ++ds) { const bf16x8 k0 = *(const LAS bf16x8*)(ln + ka[ds]); const bf16x8 k1 = *(const LAS bf16x8*)(ln + ka[ds] + 8192);
                N0 = __builtin_amdgcn_mfma_f32_32x32x16_bf16(k0, qf[ds], N0, 0, 0, 0); N1 = __builtin_amdgcn_mfma_f32_32x32x16_bf16(k1, qf[ds], N1, 0, 0, 0); } }
        float mx = fmaxf(S0[0], S1[0]);
#pragma unroll
        for (int r = 1; r < 16; ++r) mx = fmaxf(mx, fmaxf(S0[r], S1[r]));
        mx = xh_max(mx);
        const float mn = fmaxf(mrun, mx); const float alpha = __builtin_amdgcn_exp2f(mrun - mn);
        float rs = 0.f;
#pragma unroll
        for (int r = 0; r < 16; ++r) { S0[r] = __builtin_amdgcn_exp2f(S0[r] - mn); S1[r] = __builtin_amdgcn_exp2f(S1[r] - mn); rs += S0[r] + S1[r]; }
        mrun = mn; lrun = lrun * alpha + rs;
#pragma unroll
        for (int e = 0; e < 4; ++e) O[e] = O[e] * alpha;
        bf16x8 P[4];
#pragma unroll
        for (int s = 0; s < 2; ++s) {
            v4u a, b;
            a.x = pkbf(S0[8 * s + 0], S0[8 * s + 1]); a.y = pkbf(S0[8 * s + 2], S0[8 * s + 3]); a.z = pkbf(S0[8 * s + 4], S0[8 * s + 5]); a.w = pkbf(S0[8 * s + 6], S0[8 * s + 7]);
            b.x = pkbf(S1[8 * s + 0], S1[8 * s + 1]); b.y = pkbf(S1[8 * s + 2], S1[8 * s + 3]); b.z = pkbf(S1[8 * s + 4], S1[8 * s + 5]); b.w = pkbf(S1[8 * s + 6], S1[8 * s + 7]);
            P[0 * 2 + s] = __builtin_bit_cast(bf16x8, a); P[1 * 2 + s] = __builtin_bit_cast(bf16x8, b); }
#pragma unroll
        for (int eb = 0; eb < 4; ++eb)
#pragma unroll
            for (int kb = 0; kb < 2; ++kb)
#pragma unroll
                for (int s = 0; s < 2; ++s) {
                    const s16x4 lo = tr16(lk + va[0][eb] + (8192 * kb + 4096 * s)); const s16x4 hh = tr16(lk + va[1][eb] + (8192 * kb + 4096 * s));
                    const bf16x8 vf = (bf16x8){lo[0], lo[1], lo[2], lo[3], hh[0], hh[1], hh[2], hh[3]};
                    O[eb] = __builtin_amdgcn_mfma_f32_32x32x16_bf16(vf, P[kb * 2 + s], O[eb], 0, 0, 0); }
        S0 = N0; S1 = N1;
        if (t + 3 < nt) asm volatile("s_waitcnt vmcnt(4) lgkmcnt(0)\n\ts_barrier" ::: "memory"); else asm volatile("s_waitcnt vmcnt(0) lgkmcnt(0)\n\ts_barrier" ::: "memory");
    }
#undef AT_STAGE
    lrun = xh_sum(lrun);
    LAS float* X = (LAS float*)(F.lds + qb * 16384);
    if (mp == 1) {
        float s1 = 0.f, s2 = 0.f;
        for (int i = 0; i < 64; ++i) { s1 += A.in[11][i] * A.in[12][i]; s2 += A.in[13][i] * A.in[14][i]; }
        const float lam = expf(s1) - expf(s2) + LAM_INIT; const float sc = lam / lrun;
#pragma unroll
        for (int e = 0; e < 4; ++e)
#pragma unroll
            for (int r = 0; r < 16; ++r) X[(e * 32 + (r & 3) + 8 * (r >> 2) + 4 * hi) * 32 + r32] = O[e][r] * sc;
    }
    __syncthreads();
    if (mp == 0) {
        const float i0 = 1.f / lrun; float ss = 0.f;
#pragma unroll
        for (int e = 0; e < 4; ++e)
#pragma unroll
            for (int r = 0; r < 16; ++r) { const float o = O[e][r] * i0 - X[(e * 32 + (r & 3) + 8 * (r >> 2) + 4 * hi) * 32 + r32]; O[e][r] = o; ss += o * o; }
        ss = xh_sum(ss);
        const float rstd = (1.f - LAM_INIT) / sqrtf(ss * (1.f / 128.f) + EPSN);
        LAS unsigned char* stg = (LAS unsigned char*)X;
#pragma unroll
        for (int e = 0; e < 4; ++e)
#pragma unroll
            for (int g4 = 0; g4 < 4; ++g4) { const int e0 = e * 32 + 8 * g4 + 4 * hi; const f32x4 gg = *(const GAS f32x4*)(A.in[15] + e0);
                const unsigned w0 = pkbf(O[e][4 * g4 + 0] * rstd * gg.x, O[e][4 * g4 + 1] * rstd * gg.y), w1 = pkbf(O[e][4 * g4 + 2] * rstd * gg.z, O[e][4 * g4 + 3] * rstd * gg.w);
                *(LAS unsigned long long*)(stg + r32 * 256 + ((((unsigned)e0 >> 3) ^ ((unsigned)r32 & 15u)) << 4) + (e0 & 7) * 2) = (unsigned long long)w0 | ((unsigned long long)w1 << 32); }
        LDS_WAIT(); asm volatile("" ::: "memory");
        { bf16* og = Obuf + (size_t)(qrow0 + qb * 32) * D + head * 128;
#pragma unroll
          for (int i = 0; i < 8; ++i) { const int id = lane + 64 * i, row = id >> 4, ch = id & 15; const v4u x = *(const LAS v4u*)(stg + row * 256 + ((ch ^ (row & 15)) << 4)); *(GAS v4u*)(og + (size_t)row * D + ch * 8) = x; } }
        LDS_WAIT(); asm volatile("" ::: "memory");
    }
}

template <int L, int NB> __device__ __forceinline__ void hyena_unit(const Frame& F, const Args& A, int c) {
    constexpr int ROW0 = (L == LCTX) ? 0 : M_CTX, NTOK = NB * L, PITCH = L + 8, CP = 2 * L + 8, TW = (L / 16) / 8;
    constexpr int OFF_V = 8 * CP * 2, ARR = NB * PITCH * 2, OFF_Z = OFF_V + ARR, OFF_X1 = OFF_Z + ARR, OFF_X2 = OFF_X1 + ARR;
    static_assert(OFF_X2 + ARR <= RING_BYTES, "hyena LDS");
    int tid = F.tid; asm volatile("" : "+v"(tid));
    const int lane = tid & 63, wave = __builtin_amdgcn_readfirstlane(tid >> 6);
    LAS unsigned char* lds = F.lds;
#pragma unroll
    for (int p = 0; p < 3; ++p) {
        const bf16* src = WSP(const bf16, WS_UT) + (size_t)(p * DH + c) * MROWS + ROW0;
        const float w0 = A.in[16][p * DH + c], w1 = A.in[16][HYC + p * DH + c], w2 = A.in[16][2 * HYC + p * DH + c], bb = A.in[17][p * DH + c];
        LAS unsigned char* dst = lds + (p == 0 ? OFF_V : (p == 1 ? OFF_X1 : OFF_X2));
        for (int idx = tid; idx < NTOK / 8; idx += NWAVES * 64) { const int t8 = idx * 8, b = t8 / L, t = t8 % L;
            const v4u raw = *(const GAS v4u*)(src + t8);
            float x[10];
            x[0] = (t == 0) ? 0.f : bf2f(src[t8 - 1]); x[9] = (t + 8 == L) ? 0.f : bf2f(src[t8 + 8]);
            x[1] = __uint_as_float(raw.x << 16); x[2] = __uint_as_float(raw.x & 0xffff0000u); x[3] = __uint_as_float(raw.y << 16); x[4] = __uint_as_float(raw.y & 0xffff0000u);
            x[5] = __uint_as_float(raw.z << 16); x[6] = __uint_as_float(raw.z & 0xffff0000u); x[7] = __uint_as_float(raw.w << 16); x[8] = __uint_as_float(raw.w & 0xffff0000u);
            v4u o;
            o.x = pk2(w0 * x[0] + w1 * x[1] + w2 * x[2] + bb, w0 * x[1] + w1 * x[2] + w2 * x[3] + bb); o.y = pk2(w0 * x[2] + w1 * x[3] + w2 * x[4] + bb, w0 * x[3] + w1 * x[4] + w2 * x[5] + bb);
            o.z = pk2(w0 * x[4] + w1 * x[5] + w2 * x[6] + bb, w0 * x[5] + w1 * x[6] + w2 * x[7] + bb); o.w = pk2(w0 * x[6] + w1 * x[7] + w2 * x[8] + bb, w0 * x[7] + w1 * x[8] + w2 * x[9] + bb);
            *(LAS v4u*)(dst + (b * PITCH + t) * 2) = o; }
    }
    const float bias0 = A.in[24][c], bias1 = A.in[24][DH + c];
    const int tl = lane & 15, kg = lane >> 4, msh = (16 - tl) & 7;
#pragma unroll
    for (int ord = 0; ord < 2; ++ord) {
        { const bf16* R = WSP(const bf16, WS_FILT) + (L == LCTX ? 0 : (size_t)(MiB / 2)) + ((size_t)ord * DH + c) * (2 * L);
          for (int q = tid; q < 2 * L / 8; q += NWAVES * 64) {
              const v4u lo = *(const GAS v4u*)(R + 8 * q); v4u hi4 = (v4u){0u, 0u, 0u, 0u}; if (q + 1 < 2 * L / 8) hi4 = *(const GAS v4u*)(R + 8 * q + 8);
              const unsigned w[8] = {lo.x, lo.y, lo.z, lo.w, hi4.x, hi4.y, hi4.z, hi4.w};
#pragma unroll
              for (int m = 0; m < 8; ++m) { v4u o;
                  if (m & 1) { o.x = __builtin_amdgcn_alignbit(w[m / 2 + 1], w[m / 2], 16); o.y = __builtin_amdgcn_alignbit(w[m / 2 + 2], w[m / 2 + 1], 16); o.z = __builtin_amdgcn_alignbit(w[m / 2 + 3], w[m / 2 + 2], 16); o.w = __builtin_amdgcn_alignbit(w[m / 2 + 4], w[m / 2 + 3], 16); }
                  else { o.x = w[m / 2]; o.y = w[m / 2 + 1]; o.z = w[m / 2 + 2]; o.w = w[m / 2 + 3]; }
                  *(LAS v4u*)(lds + (m * CP + 8 * q) * 2) = o; } } }
        __syncthreads();
        pg8::f32x4 acc[TW];
#pragma unroll
        for (int i = 0; i < TW; ++i) acc[i] = (pg8::f32x4){0.f, 0.f, 0.f, 0.f};
        const LAS unsigned char* ub = lds + (ord == 0 ? OFF_V : OFF_Z) + ((lane & (NB - 1)) * PITCH + 8 * kg) * 2;
        const int tbase = wave * TW * 16;
        const LAS unsigned char* ab = lds + (msh * CP + (L - tbase - tl + 8 * kg - msh)) * 2;
        if constexpr (TW == 8) {
            bf16x8 Fw[8];
#pragma unroll
            for (int u = -7; u <= 0; ++u) Fw[u & 7] = *(const LAS bf16x8*)(ab + 32 * u);
            bf16x8 bcur = *(const LAS bf16x8*)(ub);
            for (int s4 = 0; s4 < L / 32; s4 += 4) {
#pragma unroll
                for (int j = 0; j < 4; ++j) { const int ss = s4 + j; const bf16x8 bfr = bcur;
                    if (ss + 1 < L / 32) bcur = *(const LAS bf16x8*)(ub + (ss + 1) * 64);
#pragma unroll
                    for (int i = 0; i < 8; ++i) acc[i] = __builtin_amdgcn_mfma_f32_16x16x32_bf16(Fw[(2 * j - i) & 7], bfr, acc[i], 0, 0, 0);
                    if (ss + 1 < L / 32) { Fw[(2 * j + 1) & 7] = *(const LAS bf16x8*)(ab + 32 * (2 * ss + 1)); Fw[(2 * j + 2) & 7] = *(const LAS bf16x8*)(ab + 32 * (2 * ss + 2)); } } }
        } else {
#pragma unroll 2
            for (int ss = 0; ss < L / 32; ++ss) { const bf16x8 bfr = *(const LAS bf16x8*)(ub + ss * 64);
#pragma unroll
                for (int i = 0; i < TW; ++i) { const bf16x8 afr = *(const LAS bf16x8*)(ab + (ss * 32 - 16 * i) * 2);
                    acc[i] = __builtin_amdgcn_mfma_f32_16x16x32_bf16(afr, bfr, acc[i], 0, 0, 0); } }
        }
        const int b = tl;
        if (b < NB) {
#pragma unroll
            for (int i = 0; i < TW; ++i) { const int t = tbase + 16 * i + 4 * kg; const int eo = (b * PITCH + t) * 2;
                const unsigned long long uu = *(const LAS unsigned long long*)(lds + (ord == 0 ? OFF_V : OFF_Z) + eo), gg = *(const LAS unsigned long long*)(lds + (ord == 0 ? OFF_X1 : OFF_X2) + eo);
                const float bias = ord == 0 ? bias0 : bias1; float y[4];
#pragma unroll
                for (int r = 0; r < 4; ++r) { const float uv = __uint_as_float((unsigned)((uu >> (16 * r)) & 0xffffull) << 16), gv = __uint_as_float((unsigned)((gg >> (16 * r)) & 0xffffull) << 16);
                    y[r] = gv * (acc[i][r] + uv * bias); }
                if (ord == 0) *(LAS unsigned long long*)(lds + OFF_Z + eo) = (unsigned long long)pk2(y[0], y[1]) | ((unsigned long long)pk2(y[2], y[3]) << 32);
                else *(LAS unsigned long long*)(lds + OFF_X1 + eo) = (unsigned long long)pk2(y[0], y[1]) | ((unsigned long long)pk2(y[2], y[3]) << 32); }
        }
        __syncthreads();
    }
    { bf16* dst = WSP(bf16, WS_XN) + (size_t)c * MROWS + ROW0;
      for (int idx = tid; idx < NTOK / 8; idx += NWAVES * 64) { const int t8 = idx * 8, b = t8 / L, t = t8 % L; *(GAS v4u*)(dst + t8) = *(const LAS v4u*)(lds + OFF_X1 + (b * PITCH + t) * 2); } }
}
constexpr size_t OHY_OFF = (size_t)12 * MiB;
__device__ __forceinline__ void p4_ohy_transpose_item(const Frame& F, int item) {
    const int lane = F.lane, cb = item & 7, rb = item >> 3, c0 = cb * 64, r0 = rb * 64;
    LAS bf16* tile = (LAS bf16*)(F.lds + RING_OFF + F.wave * 9216);
    const bf16* src = WSP(const bf16, WS_XN) + (size_t)c0 * MROWS + r0;
#pragma unroll
    for (int i = 0; i < 8; ++i) { const int ch = i * 8 + (lane >> 3), rc = (lane & 7) * 8; const v4u x = *(const GAS v4u*)(src + (size_t)ch * MROWS + rc);
        const unsigned w[4] = {x.x, x.y, x.z, x.w};
#pragma unroll
        for (int j = 0; j < 4; ++j) { tile[(rc + 2 * j) * 72 + ch] = (bf16)(w[j] & 0xffffu); tile[(rc + 2 * j + 1) * 72 + ch] = (bf16)(w[j] >> 16); } }
    LDS_WAIT(); asm volatile("" ::: "memory");
    bf16* dst = (bf16*)(F.ws + WS_XN + OHY_OFF) + (size_t)r0 * DH + c0;
#pragma unroll
    for (int i = 0; i < 8; ++i) { const int row = i * 8 + (lane >> 3), cc = (lane & 7) * 8; *(GAS v4u*)(dst + (size_t)row * DH + cc) = *(const LAS v4u*)(tile + row * 72 + cc); }
    LDS_WAIT(); asm volatile("" ::: "memory");
}


template <int MF> struct EpiT1 {
    static constexpr bool PERM = true, AFTER_DRAIN = false;
    const bf16* G; bf16* T1;
    __device__ __forceinline__ void operator()(const pg8::f32x4 (&acc)[2][2][MF][2], const pg8::Unit& u, int wr, int wc, int fr, int fq) const {
        using pg8::f32x4; using pg8::u32x4;
        const int row0 = u.pm * (64 * MF) + wr * (16 * MF) + fr, col0 = u.pn * 256 + wc * 32 + 8 * fq;
#pragma unroll
        for (int ai = 0; ai < 2; ++ai)
#pragma unroll
            for (int m = 0; m < MF; ++m) { const int row = row0 + ai * (32 * MF) + m * 16;
#pragma unroll
                for (int bj = 0; bj < 2; ++bj) { const int col = col0 + bj * 128; const u32x4 g = *(const u32x4*)(G + (size_t)row * 2048 + col);
                    const f32x4 v0 = acc[ai][bj][m][0], v1 = acc[ai][bj][m][1]; u32x4 w;
                    w.x = pg8::cvt_pk_bf16(v0[0] * __uint_as_float(g.x << 16), v0[1] * __uint_as_float(g.x & 0xffff0000u)); w.y = pg8::cvt_pk_bf16(v0[2] * __uint_as_float(g.y << 16), v0[3] * __uint_as_float(g.y & 0xffff0000u));
                    w.z = pg8::cvt_pk_bf16(v1[0] * __uint_as_float(g.z << 16), v1[1] * __uint_as_float(g.z & 0xffff0000u)); w.w = pg8::cvt_pk_bf16(v1[2] * __uint_as_float(g.w << 16), v1[3] * __uint_as_float(g.w & 0xffff0000u));
                    *(u32x4*)(T1 + (size_t)row * D + col) = w; } }
    }
};
template <int MF> struct EpiMerge {
    static constexpr bool PERM = true, AFTER_DRAIN = false;
    const bf16* G; const bf16* T1; bf16* MG;
    __device__ __forceinline__ void operator()(const pg8::f32x4 (&acc)[2][2][MF][2], const pg8::Unit& u, int wr, int wc, int fr, int fq) const {
        using pg8::f32x4; using pg8::u32x4;
        const int row0 = u.pm * (64 * MF) + wr * (16 * MF) + fr, col0 = u.pn * 256 + wc * 32 + 8 * fq;
#pragma unroll
        for (int ai = 0; ai < 2; ++ai)
#pragma unroll
            for (int m = 0; m < MF; ++m) { const int row = row0 + ai * (32 * MF) + m * 16;
#pragma unroll
                for (int bj = 0; bj < 2; ++bj) { const int col = col0 + bj * 128; const u32x4 g = *(const u32x4*)(G + (size_t)row * 2048 + 1024 + col); const u32x4 t = *(const u32x4*)(T1 + (size_t)row * D + col);
                    const f32x4 v0 = acc[ai][bj][m][0], v1 = acc[ai][bj][m][1]; u32x4 w;
                    w.x = pg8::cvt_pk_bf16(__uint_as_float(t.x << 16) + v0[0] * __uint_as_float(g.x << 16), __uint_as_float(t.x & 0xffff0000u) + v0[1] * __uint_as_float(g.x & 0xffff0000u));
                    w.y = pg8::cvt_pk_bf16(__uint_as_float(t.y << 16) + v0[2] * __uint_as_float(g.y << 16), __uint_as_float(t.y & 0xffff0000u) + v0[3] * __uint_as_float(g.y & 0xffff0000u));
                    w.z = pg8::cvt_pk_bf16(__uint_as_float(t.z << 16) + v1[0] * __uint_as_float(g.z << 16), __uint_as_float(t.z & 0xffff0000u) + v1[1] * __uint_as_float(g.z & 0xffff0000u));
                    w.w = pg8::cvt_pk_bf16(__uint_as_float(t.w << 16) + v1[2] * __uint_as_float(g.w << 16), __uint_as_float(t.w & 0xffff0000u) + v1[3] * __uint_as_float(g.w & 0xffff0000u));
                    *(u32x4*)(MG + (size_t)row * D + col) = w; } }
    }
};
template <int MF> struct EpiRes {
    static constexpr bool PERM = false, AFTER_DRAIN = false;
    const float* xa; const float* xb; const float* modf; int goff; float* out;
    __device__ __forceinline__ void operator()(const pg8::f32x4 (&acc)[2][2][MF][2], const pg8::Unit& u, int wr, int wc, int fr, int fq) const {
        using pg8::f32x4;
        const int row0 = u.pm * (64 * MF) + wr * (16 * MF) + fr, col0 = u.pn * 256 + wc * 32 + 4 * fq;
#pragma unroll
        for (int ai = 0; ai < 2; ++ai)
#pragma unroll
            for (int m = 0; m < MF; ++m) { const int row = row0 + ai * (32 * MF) + m * 16; const float* bp = (row < M_CTX ? xa + (size_t)row * D : xb + (size_t)(row - M_CTX) * D) + col0; float* op = out + (size_t)row * D + col0;
                const float* gp = modf + (size_t)mod_row(row) * 6144 + goff + col0;
#pragma unroll
                for (int bj = 0; bj < 2; ++bj)
#pragma unroll
                    for (int n = 0; n < 2; ++n) { const f32x4 bs = *(const f32x4*)(bp + bj * 128 + n * 16), gv = *(const f32x4*)(gp + bj * 128 + n * 16); *(f32x4*)(op + bj * 128 + n * 16) = bs + gv * acc[ai][bj][m][n]; } }
    }
};
struct EpiUp {
    static constexpr bool PERM = true, AFTER_DRAIN = false;
    bf16* UP;
    __device__ __forceinline__ void operator()(const pg8::f32x4 (&acc)[2][2][4][2], const pg8::Unit& u, int wr, int wc, int fr, int fq) const {
        using pg8::f32x4; using pg8::u32x4;
        const int row0 = u.pm * 256 + wr * 64 + fr, col0 = u.pn * 256 + wc * 32 + 8 * fq;
#pragma unroll
        for (int ai = 0; ai < 2; ++ai)
#pragma unroll
            for (int m = 0; m < 4; ++m) { const int row = row0 + ai * 128 + m * 16;
#pragma unroll
                for (int bj = 0; bj < 2; ++bj) { f32x4 v0 = acc[ai][bj][m][0], v1 = acc[ai][bj][m][1];
#pragma unroll
                    for (int e = 0; e < 4; ++e) { const float a = fmaxf(v0[e], 0.f), b = fmaxf(v1[e], 0.f); v0[e] = a * a; v1[e] = b * b; }
                    u32x4 w; w.x = pg8::cvt_pk_bf16(v0[0], v0[1]); w.y = pg8::cvt_pk_bf16(v0[2], v0[3]); w.z = pg8::cvt_pk_bf16(v1[0], v1[1]); w.w = pg8::cvt_pk_bf16(v1[2], v1[3]);
                    *(u32x4*)(UP + (size_t)row * FF + col0 + bj * 128) = w; } }
    }
};
__device__ __forceinline__ void final_norm_rows(const Frame& F, const Args& A) {
    const int gw = F.vcu * NWAVES + F.wave, NGW = F.G * NWAVES, lane = F.lane;
    f32x4 gv[4];
#pragma unroll
    for (int j = 0; j < 4; ++j) gv[j] = *(const GAS f32x4*)(A.in[30] + 4 * lane + 256 * j);
    for (int row = gw; row < MROWS; row += NGW) { float* xr = F.out + (size_t)row * D; f32x4 v[4]; float s = 0.f;
#pragma unroll
        for (int j = 0; j < 4; ++j) { v[j] = *(const GAS f32x4*)(xr + 4 * lane + 256 * j); s += (v[j].x * v[j].x + v[j].y * v[j].y) + (v[j].z * v[j].z + v[j].w * v[j].w); }
        const float rstd = 1.f / sqrtf(wave_sum(s) * (1.f / D) + EPSN);
#pragma unroll
        for (int j = 0; j < 4; ++j) *(GAS f32x4*)(xr + 4 * lane + 256 * j) = v[j] * rstd * gv[j]; }
}

#ifndef MK_DEBUG
#define MK_DEBUG 0
#endif
#ifndef MK_REP
#define MK_REP 0
#endif
#ifndef MK_REP3
#define MK_REP3 3
#endif
#define REPK(k) for (int rep_ = 0; rep_ <= ((MK_REP >> (k)) & 1); ++rep_)
__global__ void __launch_bounds__(NWAVES * 64, 2) mk_fwd(Args args) {
    extern __shared__ __attribute__((aligned(16))) unsigned char lds[];
    Frame F;
    F.lds = (LAS unsigned char*)lds; F.MISC = (volatile LAS unsigned*)(F.lds + MISC_OFF);
    F.tid = threadIdx.x; F.lane = F.tid & 63; F.wave = __builtin_amdgcn_readfirstlane(F.tid >> 6);
    F.G = gridDim.x; { const int bx = blockIdx.x; F.vcu = (F.G % 8 == 0) ? (bx % 8) * (F.G / 8) + bx / 8 : bx; }
    F.ws = args.ws; F.out = args.out; F.ctl = (gu32*)(args.ws + WS_CTL);
    const Args& A = args;
    for (int u = F.tid; u < (LDS_BYTES - LDSCTL_OFF) / 4; u += NWAVES * 64) ((LAS unsigned*)(F.lds + LDSCTL_OFF))[u] = 0u;
    __syncthreads();
    XcdBarrier bar = xcd_barrier_post((unsigned*)(F.ctl + CW_BAR), F.MISC + 8);
    const int stop = args.stop_after; int n_ts = 1;
    if (MK_DEBUG && blockIdx.x == 0 && threadIdx.x == 0) ((unsigned long long*)(F.ctl + TS_WORDS))[0] = rt();
#define GRID_BAR() do { xcd_barrier(bar); if (MK_DEBUG && blockIdx.x == 0 && threadIdx.x == 0) { ((unsigned long long*)(F.ctl + TS_WORDS))[n_ts] = rt(); } ++n_ts; } while (0)
#define STOP_IF(k) do { if (MK_DEBUG && stop == (k)) return; } while (0)
#define PHASE_BEGIN() do { int t_ = threadIdx.x; asm volatile("" : "+v"(t_)); F.tid = t_; F.lane = t_ & 63; unsigned char* w_ = args.ws; asm volatile("" : "+s"(w_)); F.ws = w_; } while (0)

    REPK(0) { PHASE_BEGIN(); p0_prologue(F, A); }
    GRID_BAR(); STOP_IF(0);
    REPK(1) { PHASE_BEGIN(); modnorm_rows(F, A, 0); }
    GRID_BAR(); STOP_IF(1);
    REPK(2) { PHASE_BEGIN();
        pg8::Gemm g{WSP(const pg8::bf16_t, WS_XN), WSP(const pg8::bf16_t, WS_WIN), MROWS, INC, D}; pg8::StaticOrder S; S.init(MROWS, INC, F.G, (int)blockIdx.x);
        EpiIn E{WSP(bf16, WS_Q), WSP(bf16, WS_K), WSP(bf16, WS_V), WSP(bf16, WS_UT), WSP(bf16, WS_G), F.out + (size_t)MROWS * D, F.out + (size_t)MROWS * D + (size_t)M_CTX * D, WSP(const float, WS_ROPE)};
        pg8::gemm_phase<EpiIn, pg8::StaticOrder, true, true>(F.lds + RING_OFF, g, S, E);
    }
    GRID_BAR(); STOP_IF(2);
    REPK(3) {
        PHASE_BEGIN();
        bf16* Obuf = WSP(bf16, WS_O);
        volatile LAS unsigned* qslot = (volatile LAS unsigned*)(F.lds + LDSCTL_OFF + 64);
        constexpr int NU = 512 + 512 + 256 + 512 + N_TRU;
        for (;;) {
            __syncthreads();
            if (F.tid == 0) *qslot = __hip_atomic_fetch_add((unsigned*)(F.ctl + CW_QUEUE + 64 * rep_), 1u, __ATOMIC_RELAXED, __HIP_MEMORY_SCOPE_AGENT);
            __syncthreads();
            const int id = __builtin_amdgcn_readfirstlane((int)*qslot);
            if (id >= NU) break;
            { int t_ = threadIdx.x; asm volatile("" : "+v"(t_)); F.tid = t_; F.lane = t_ & 63; }
            if (rep_ == 1) { if (id >= 1792) continue; const bool is_attn = id < 512 || (id >= 1024 && id < 1280); if (is_attn ? !(MK_REP3 & 1) : !(MK_REP3 & 2)) continue; }
            if (id < 512) { const int b = id >> 6, head = (id >> 3) & 7, qb = id & 7; attn_unit(F, A, Obuf, M_CTX + b * LLAT + qb * 128, M_CTX + b * LKLAT, LKLAT / 64, head); }
            else if (id < 1024) hyena_unit<LLAT, 8>(F, A, id - 512);
            else if (id < 1280) { const int j = id - 1024, s = j >> 4, head = (j >> 1) & 7, qb = j & 1; attn_unit(F, A, Obuf, s * 256 + qb * 128, s * 256, LCTX / 64, head); }
            else if (id < 1792) hyena_unit<LCTX, 16>(F, A, id - 1280);
            else p3_transpose_unit(F, A, id - 1792);
        }
    }
    GRID_BAR(); STOP_IF(3);
    REPK(4)
    { PHASE_BEGIN();
        { const int gw = F.vcu * NWAVES + F.wave, NGW = F.G * NWAVES; for (int it = gw; it < 1536; it += NGW) p4_ohy_transpose_item(F, it); }
        __syncthreads();
        pg8::StaticOrder S; S.init(MROWS, D, F.G, (int)blockIdx.x, 192);
        { pg8::Gemm g{WSP(const pg8::bf16_t, WS_O), WSP(const pg8::bf16_t, WS_WA), MROWS, D, D}; EpiT1<3> E{WSP(const bf16, WS_G), WSP(bf16, WS_V)};
          pg8::gemm_phase<EpiT1<3>, pg8::StaticOrder, true, true, 3>(F.lds + RING_OFF, g, S, E); }
        GRID_BAR();
        { pg8::Gemm g{(const pg8::bf16_t*)(F.ws + WS_XN + OHY_OFF), WSP(const pg8::bf16_t, WS_WH), MROWS, D, DH}; EpiMerge<3> E{WSP(const bf16, WS_G), WSP(const bf16, WS_V), WSP(bf16, WS_K)};
          pg8::gemm_phase<EpiMerge<3>, pg8::StaticOrder, true, true, 3>(F.lds + RING_OFF, g, S, E); }
    }
    GRID_BAR(); STOP_IF(4);
    REPK(5) { PHASE_BEGIN();
        pg8::Gemm g{WSP(const pg8::bf16_t, WS_K), WSP(const pg8::bf16_t, WS_WO), MROWS, D, D}; pg8::StaticOrder S; S.init(MROWS, D, F.G, (int)blockIdx.x, 192);
        EpiRes<3> E{A.in[0], A.in[1], WSP(const float, WS_MODF), 2048, F.out};
        pg8::gemm_phase<EpiRes<3>, pg8::StaticOrder, true, true, 3>(F.lds + RING_OFF, g, S, E);
    }
    GRID_BAR(); STOP_IF(5);
    REPK(6) { PHASE_BEGIN(); modnorm_rows(F, A, 1); }
    GRID_BAR(); STOP_IF(6);
    REPK(7) { PHASE_BEGIN();
        pg8::Gemm g{WSP(const pg8::bf16_t, WS_XN), WSP(const pg8::bf16_t, WS_WUP), MROWS, FF, D}; pg8::StaticOrder S; S.init(MROWS, FF, F.G, (int)blockIdx.x);
        EpiUp E{WSP(bf16, WS_UP)};
        pg8::gemm_phase<EpiUp, pg8::StaticOrder, true, true>(F.lds + RING_OFF, g, S, E);
    }
    GRID_BAR(); STOP_IF(7);
    { PHASE_BEGIN();
        pg8::Gemm g{WSP(const pg8::bf16_t, WS_UP), WSP(const pg8::bf16_t, WS_WDN), MROWS, D, FF}; pg8::StaticOrder S; S.init(MROWS, D, F.G, (int)blockIdx.x, 192);
        EpiRes<3> E{F.out, F.out + (size_t)M_CTX * D, WSP(const float, WS_MODF), 5120, F.out};
        pg8::gemm_phase<EpiRes<3>, pg8::StaticOrder, true, true, 3>(F.lds + RING_OFF, g, S, E);
    }
    GRID_BAR(); STOP_IF(8);
    PHASE_BEGIN(); final_norm_rows(F, A);
    if (MK_DEBUG && blockIdx.x == 0 && threadIdx.x == 0) { ((unsigned long long*)(F.ctl + TS_WORDS))[n_ts] = rt(); }

}

#if MK_DEBUG

#endif
extern "C" void kernel_launch(void* const* d_in, const int* in_sizes, int n_in, void* d_out, int out_size, void* d_ws, size_t ws_size, hipStream_t stream) {
    static int grid = 0;
    if (grid == 0) {
        if (n_in != 31 || out_size != MROWS * D + 2 * M_CTX * D || ws_size < WS_END) { fprintf(stderr, "kernel_launch: unexpected shapes (n_in %d out %d ws %zu)\n", n_in, out_size, ws_size); grid = -1; return; }
        int dev = 0, cus = 0;
        if (hipGetDevice(&dev) != hipSuccess || hipDeviceGetAttribute(&cus, hipDeviceAttributeMultiprocessorCount, dev) != hipSuccess) { grid = -1; return; }
        if (hipFuncSetAttribute((const void*)mk_fwd, hipFuncAttributeMaxDynamicSharedMemorySize, LDS_BYTES) != hipSuccess) { fprintf(stderr, "kernel_launch: hipFuncSetAttribute failed\n"); grid = -1; return; }
        int per_cu = 0;
        if (hipOccupancyMaxActiveBlocksPerMultiprocessor(&per_cu, (const void*)mk_fwd, NWAVES * 64, LDS_BYTES) != hipSuccess || per_cu < 1) { fprintf(stderr, "kernel_launch: occupancy query says %d\n", per_cu); }
        (void)hipGetLastError();
        grid = cus;
    }
    if (grid < 0) return;
    if (hipMemsetAsync((char*)d_ws + WS_CTL, 0, CTL_ZERO_BYTES, stream) != hipSuccess) return;
    Args a{};
    for (int i = 0; i < 31; ++i) a.in[i] = (const float*)d_in[i];
    a.out = (float*)d_out; a.ws = (unsigned char*)d_ws; a.stop_after = MK_STOP; a.pad = 0;
    hipLaunchKernelGGL(mk_fwd, dim3(grid), dim3(NWAVES * 64), LDS_BYTES, stream, a);
#if MK_DEBUG
    dbg_run(a, stream);
#endif
}
```
